# Optimizing an MI355X kernel written in HIP

```python
import math
import numpy as np
import jax
import jax.numpy as jnp
from jax import lax


D_MODEL = 1024
BATCH = 8
SEQ = 4096
DEPTH = 4

GRID_W = 64
CTX_LEN = 256
ROPE_THETA = 10000.0
Q_BLOCK = 128
EPS = 1e-6
ADA_SCALE = 0.2

MIX_WIDTH = D_MODEL
GROUP_WIDTH = MIX_WIDTH // 4

RET_HEADS = 4
RET_DK = GROUP_WIDTH // RET_HEADS
RET_DV = GROUP_WIDTH // RET_HEADS
RET_CHUNK = 128
DIFF_HEADS = 4
DIFF_DV = GROUP_WIDTH // DIFF_HEADS
DIFF_D = DIFF_DV // 2
GQA_HEADS = 4
GQA_KV_HEADS = 2
GQA_D = GROUP_WIDTH // GQA_HEADS
MLA_HEADS = 4
MLA_Q_RANK = 192
MLA_KV_RANK = 128
MLA_NOPE = 64
MLA_ROPE = 32
MLA_DV = GROUP_WIDTH // MLA_HEADS

IN_SPLITS = (
    RET_HEADS * RET_DK, RET_HEADS * RET_DK, RET_HEADS * RET_DV, RET_HEADS * RET_DV,
    DIFF_HEADS * 2 * DIFF_D, DIFF_HEADS * 2 * DIFF_D, DIFF_HEADS * DIFF_DV,
    GQA_HEADS * GQA_D, GQA_KV_HEADS * GQA_D, GQA_KV_HEADS * GQA_D,
    MLA_Q_RANK, MLA_KV_RANK, MLA_ROPE,
)
IN_WIDTH = sum(IN_SPLITS)

N_EXPERTS = 32
TOP_K = 4
D_FF = D_MODEL
SWIGLU_LIMIT = 7.0
SWIGLU_ALPHA = 1.702
MOE_BLOCK = 256

kernel_name = 'hybrid_parallel_heads_retention_diff_gqa_mla_moe'


def rms_norm(x, g):
    xf = x.astype(jnp.float32)
    y = xf * lax.rsqrt(jnp.mean(xf * xf, axis=-1, keepdims=True) + EPS)
    return y.astype(x.dtype) * g


def modulate(x, g, shift, scale):
    return rms_norm(x, g) * (1 + scale) + shift


def grid_rope(rows, rot_dim):
    row = jnp.repeat(jnp.arange(rows), GRID_W)
    col = jnp.tile(jnp.arange(GRID_W), rows)
    n_freq = rot_dim // 4
    inv = ROPE_THETA ** (-jnp.arange(n_freq, dtype=jnp.float32) / n_freq)
    ang = jnp.concatenate([row[:, None] * inv, col[:, None] * inv], axis=-1)
    return jnp.cos(ang), jnp.sin(ang)


def apply_rope(x, rope):
    cos, sin = rope
    half = x.shape[-1] // 2
    x1 = x[..., :half].astype(jnp.float32)
    x2 = x[..., half:].astype(jnp.float32)
    return jnp.concatenate([x1 * cos - x2 * sin, x1 * sin + x2 * cos], axis=-1).astype(x.dtype)


def split_heads(a, n_heads):
    b, s, w = a.shape
    return a.reshape(b, s, n_heads, w // n_heads).transpose(0, 2, 1, 3)


def merge_heads(o):
    b, h, s, d = o.shape
    return o.transpose(0, 2, 1, 3).reshape(b, s, h * d)


def softmax_f32(s):
    return jax.nn.softmax(s.astype(jnp.float32), axis=-1)


def sweep_query_blocks(block_fn, *qs):
    n = qs[0].shape[-2]
    nb = n // Q_BLOCK

    def to_blocks(a):
        return jnp.moveaxis(a.reshape(a.shape[:-2] + (nb, Q_BLOCK, a.shape[-1])), -3, 0)

    out = lax.map(lambda qb: block_fn(*qb), tuple(to_blocks(a) for a in qs))
    out = jnp.moveaxis(out, 0, -3)
    return out.reshape(out.shape[:-3] + (n, out.shape[-1]))


def retention_chunks(q, k, v, log_g, s0):
    b, h, s, _ = q.shape
    nc = s // RET_CHUNK
    pos = jnp.arange(RET_CHUNK, dtype=jnp.float32)
    dist = pos[:, None] - pos[None, :]
    decay = jnp.where(dist >= 0, jnp.exp(log_g[:, None, None] * jnp.maximum(dist, 0.0)), 0.0)
    xi = jnp.exp(log_g[:, None] * (pos + 1.0))[:, :, None]
    zeta = jnp.exp(log_g[:, None] * (RET_CHUNK - 1.0 - pos))[:, :, None]
    g_chunk = jnp.exp(log_g * RET_CHUNK)[:, None, None]

    def to_chunks(a):
        return jnp.moveaxis(a.reshape(b, h, nc, RET_CHUNK, a.shape[-1]), 2, 0)

    def step(state, qkv):
        qc, kc, vc = qkv
        inner = jnp.einsum('bhnd,bhmd->bhnm', qc, kc) * decay
        o = jnp.einsum('bhnm,bhme->bhne', inner, vc) + jnp.einsum('bhnd,bhde->bhne', qc, state) * xi
        state = g_chunk * state + jnp.einsum('bhmd,bhme->bhde', kc * zeta, vc)
        return state, o

    state, o = lax.scan(step, s0, (to_chunks(q), to_chunks(k), to_chunks(v)))
    o = jnp.moveaxis(o, 0, 2).reshape(b, h, s, v.shape[-1])
    return o, state


def head_group_norm(o, w, bias):
    of = o.astype(jnp.float32)
    mu = jnp.mean(of, axis=-1, keepdims=True)
    var = jnp.mean(jnp.square(of - mu), axis=-1, keepdims=True)
    return merge_heads((of - mu) * lax.rsqrt(var + EPS)) * w + bias


def retention_group(q_l, k_l, v_l, g_l, q_c, k_c, v_c, g_c, log_decay, gn_w, gn_b, rope, ctx_out):
    scale = RET_DK ** -0.5
    ql = apply_rope(split_heads(q_l, RET_HEADS), rope)
    kl = apply_rope(split_heads(k_l, RET_HEADS), rope) * scale
    vl = split_heads(v_l, RET_HEADS)
    qc = split_heads(q_c, RET_HEADS)
    kc = split_heads(k_c, RET_HEADS) * scale
    vc = split_heads(v_c, RET_HEADS)
    log_g = -jnp.exp(log_decay.astype(jnp.float32))
    zero = jnp.zeros((qc.shape[0], RET_HEADS, RET_DK, RET_DV), jnp.float32)
    flip = lambda a: jnp.flip(a, axis=2)
    oc_f, sc_f = retention_chunks(qc, kc, vc, log_g[0], zero)
    oc_b, sc_b = retention_chunks(flip(qc), flip(kc), flip(vc), log_g[1], zero)
    ol_f, _ = retention_chunks(ql, kl, vl, log_g[0], sc_f)
    ol_b, _ = retention_chunks(flip(ql), flip(kl), flip(vl), log_g[1], sc_b)

    def readout(o, g):
        return (head_group_norm(o, gn_w, gn_b) * jax.nn.silu(g)).astype(g.dtype)

    y_l = readout(ol_f + flip(ol_b), g_l)
    y_c = readout(oc_f + flip(oc_b), g_c) if ctx_out else None
    return y_l, y_c


def diff_group(q_l, k_l, v_l, q_c, k_c, v_c, lam_params, subln_w, lam_init, rope, ctx_out):
    def prep(q, k, v):
        q = split_heads(q, DIFF_HEADS)
        k = split_heads(k, DIFF_HEADS)
        return q[..., :DIFF_D], q[..., DIFF_D:], k[..., :DIFF_D], k[..., DIFF_D:], split_heads(v, DIFF_HEADS)

    q1l, q2l, k1l, k2l, vl = prep(q_l, k_l, v_l)
    q1l, q2l, k1l, k2l = (apply_rope(a, rope) for a in (q1l, q2l, k1l, k2l))
    q1c, q2c, k1c, k2c, vc = prep(q_c, k_c, v_c)
    lp = lam_params.astype(jnp.float32)
    lam = jnp.exp(jnp.sum(lp[0] * lp[1])) - jnp.exp(jnp.sum(lp[2] * lp[3])) + lam_init
    scale = DIFF_D ** -0.5

    def attend(q1, q2, k1, k2, v):
        p1 = softmax_f32(jnp.einsum('bhqd,bhkd->bhqk', q1, k1) * scale)
        p2 = softmax_f32(jnp.einsum('bhqd,bhkd->bhqk', q2, k2) * scale)
        return jnp.einsum('bhqk,bhkd->bhqd', (p1 - lam * p2).astype(v.dtype), v)

    k1a = jnp.concatenate([k1c, k1l], axis=2)
    k2a = jnp.concatenate([k2c, k2l], axis=2)
    va = jnp.concatenate([vc, vl], axis=2)

    def readout(o):
        return merge_heads(rms_norm(o, subln_w) * (1 - lam_init))

    y_l = readout(sweep_query_blocks(lambda a, b: attend(a, b, k1a, k2a, va), q1l, q2l))
    y_c = readout(attend(q1c, q2c, k1c, k2c, vc)) if ctx_out else None
    return y_l, y_c


def gqa_group(q_l, k_l, v_l, q_c, k_c, v_c, qk_norm, rope, ctx_out):
    n_rep = GQA_HEADS // GQA_KV_HEADS

    def prep(q, k, v):
        b, s, _ = q.shape
        q = q.reshape(b, s, GQA_KV_HEADS, n_rep, GQA_D).transpose(0, 2, 3, 1, 4)
        k = split_heads(k, GQA_KV_HEADS)
        return rms_norm(q, qk_norm[0]), rms_norm(k, qk_norm[1]), split_heads(v, GQA_KV_HEADS)

    ql, kl, vl = prep(q_l, k_l, v_l)
    ql, kl = apply_rope(ql, rope), apply_rope(kl, rope)
    qc, kc, vc = prep(q_c, k_c, v_c)
    scale = GQA_D ** -0.5

    def attend(q, k, v):
        p = softmax_f32(jnp.einsum('bngqd,bnkd->bngqk', q, k) * scale)
        return jnp.einsum('bngqk,bnkd->bngqd', p.astype(v.dtype), v)

    ka = jnp.concatenate([kc, kl], axis=2)
    va = jnp.concatenate([vc, vl], axis=2)

    def readout(o):
        b, _, _, s, _ = o.shape
        return o.transpose(0, 3, 1, 2, 4).reshape(b, s, GROUP_WIDTH)

    y_l = readout(sweep_query_blocks(lambda q: attend(q, ka, va), ql))
    y_c = readout(attend(qc, kc, vc)) if ctx_out else None
    return y_l, y_c


def mla_group(cq_l, ckv_l, kr_l, cq_c, ckv_c, kr_c, q_norm, kv_norm, w_uq, w_ukv, rope, ctx_out):
    def prep(cq, ckv, kr):
        q = split_heads(rms_norm(cq, q_norm) @ w_uq, MLA_HEADS)
        kv = split_heads(rms_norm(ckv, kv_norm) @ w_ukv, MLA_HEADS)
        return q[..., :MLA_NOPE], q[..., MLA_NOPE:], kv[..., :MLA_NOPE], kv[..., MLA_NOPE:], kr

    qnl, qrl, knl, vl, krl = prep(cq_l, ckv_l, kr_l)
    qrl, krl = apply_rope(qrl, rope), apply_rope(krl, rope)
    qnc, qrc, knc, vc, krc = prep(cq_c, ckv_c, kr_c)
    scale = (MLA_NOPE + MLA_ROPE) ** -0.5

    def attend(qn, qr, kn, kr, v):
        s = jnp.einsum('bhqd,bhkd->bhqk', qn, kn) + jnp.einsum('bhqr,bkr->bhqk', qr, kr)
        p = softmax_f32(s * scale)
        return jnp.einsum('bhqk,bhkd->bhqd', p.astype(v.dtype), v)

    kna = jnp.concatenate([knc, knl], axis=2)
    kra = jnp.concatenate([krc, krl], axis=1)
    va = jnp.concatenate([vc, vl], axis=2)
    y_l = merge_heads(sweep_query_blocks(lambda a, b: attend(a, b, kna, kra, va), qnl, qrl))
    y_c = merge_heads(attend(qnc, qrc, knc, krc, vc)) if ctx_out else None
    return y_l, y_c


def mixing_sublayer(h_lat, h_ctx, w_in, w_out, ret_log_decay, ret_gn_w, ret_gn_b, diff_lambda,
                    diff_subln, gqa_qk_norm, mla_q_norm, mla_kv_norm, mla_w_uq, mla_w_ukv,
                    rope64, rope32, lam_init, ctx_out):
    points = [int(p) for p in np.cumsum(IN_SPLITS)[:-1]]
    pl = jnp.split(h_lat @ w_in, points, axis=-1)
    pc = jnp.split(h_ctx @ w_in, points, axis=-1)
    ret_l, ret_c = retention_group(*pl[0:4], *pc[0:4], ret_log_decay, ret_gn_w, ret_gn_b, rope64, ctx_out)
    dif_l, dif_c = diff_group(*pl[4:7], *pc[4:7], diff_lambda, diff_subln, lam_init, rope32, ctx_out)
    gqa_l, gqa_c = gqa_group(*pl[7:10], *pc[7:10], gqa_qk_norm, rope64, ctx_out)
    mla_l, mla_c = mla_group(*pl[10:13], *pc[10:13], mla_q_norm, mla_kv_norm, mla_w_uq, mla_w_ukv,
                             rope32, ctx_out)
    y_l = jnp.concatenate([ret_l, dif_l, gqa_l, mla_l], axis=-1) @ w_out
    y_c = jnp.concatenate([ret_c, dif_c, gqa_c, mla_c], axis=-1) @ w_out if ctx_out else None
    return y_l, y_c


def moe_ffn(h, w_r, b_r, w1, b1, w2, b2):
    n_tok, d = h.shape
    logits = (h @ w_r + b_r).astype(jnp.float32)
    top_logit, top_idx = lax.top_k(logits, TOP_K)
    gates = jax.nn.softmax(top_logit, axis=-1)
    n_assign = n_tok * TOP_K
    n_blocks = -(-n_assign // MOE_BLOCK) + N_EXPERTS
    e_flat = top_idx.reshape(-1)
    order = jnp.argsort(e_flat)
    e_sorted = e_flat[order]
    counts = jnp.bincount(e_flat, length=N_EXPERTS)
    starts = jnp.cumsum(counts) - counts
    padded = (counts + MOE_BLOCK - 1) // MOE_BLOCK * MOE_BLOCK
    pad_ends = jnp.cumsum(padded)
    dest = pad_ends[e_sorted] - padded[e_sorted] + jnp.arange(n_assign) - starts[e_sorted]
    src_tok = jnp.full((n_blocks * MOE_BLOCK,), n_tok, jnp.int32).at[dest].set((order // TOP_K).astype(jnp.int32))
    row_gate = jnp.zeros((n_blocks * MOE_BLOCK,), jnp.float32).at[dest].set(gates.reshape(-1)[order])
    block_expert = jnp.minimum(
        jnp.searchsorted(pad_ends, jnp.arange(n_blocks) * MOE_BLOCK, side='right'), N_EXPERTS - 1)
    x_rows = jnp.take(h, src_tok, axis=0, mode='fill', fill_value=0).reshape(n_blocks, MOE_BLOCK, d)

    def expert_block(args):
        xb, e = args
        z = xb @ w1[e] + b1[e]
        glu = jnp.minimum(z[:, ::2], SWIGLU_LIMIT)
        lin = jnp.clip(z[:, 1::2], -SWIGLU_LIMIT, SWIGLU_LIMIT)
        return (glu * jax.nn.sigmoid(SWIGLU_ALPHA * glu) * (lin + 1)) @ w2[e] + b2[e]

    y_rows = lax.map(expert_block, (x_rows, block_expert)).reshape(n_blocks * MOE_BLOCK, d)
    out = jnp.zeros((n_tok, d), jnp.float32).at[src_tok].add(y_rows * row_gate[:, None], mode='drop')
    return out.astype(h.dtype)


def setup_inputs(seed: int = 0) -> dict:
    key = jax.random.key(seed)
    ks = jax.random.split(key, 25)
    f32 = jnp.float32

    def normal(k, shape, scale):
        return jax.random.normal(k, shape, f32) * scale

    def gain(k, shape):
        return 1.0 + 0.02 * jax.random.normal(k, shape, f32)

    base_decay = jnp.log(-jnp.log(1.0 - 2.0 ** (-5.0 - jnp.arange(RET_HEADS, dtype=f32))))
    return {
        'x': normal(ks[0], (BATCH, SEQ, D_MODEL), 1.0),
        'c': normal(ks[1], (BATCH, D_MODEL), 1.0),
        'ctx': normal(ks[2], (BATCH, CTX_LEN, D_MODEL), 1.0),
        'c_ctx': normal(ks[3], (D_MODEL,), 1.0),
        'ada_w': normal(ks[4], (DEPTH, D_MODEL, 6 * D_MODEL), ADA_SCALE * D_MODEL ** -0.5),
        'ada_b': normal(ks[5], (DEPTH, 6 * D_MODEL), 0.01),
        'norm_g': gain(ks[6], (DEPTH, 4, D_MODEL)),
        'w_in': normal(ks[7], (DEPTH, D_MODEL, IN_WIDTH), D_MODEL ** -0.5),
        'w_out': normal(ks[8], (DEPTH, MIX_WIDTH, D_MODEL), MIX_WIDTH ** -0.5),
        'ret_log_decay': base_decay + normal(ks[9], (DEPTH, 2, RET_HEADS), 0.05),
        'ret_gn_w': gain(ks[10], (DEPTH, GROUP_WIDTH)),
        'ret_gn_b': normal(ks[11], (DEPTH, GROUP_WIDTH), 0.01),
        'diff_lambda': normal(ks[12], (DEPTH, 4, DIFF_D), 0.1),
        'diff_subln': gain(ks[13], (DEPTH, DIFF_DV)),
        'gqa_qk_norm': gain(ks[14], (DEPTH, 2, GQA_D)),
        'mla_q_norm': gain(ks[15], (DEPTH, MLA_Q_RANK)),
        'mla_kv_norm': gain(ks[16], (DEPTH, MLA_KV_RANK)),
        'mla_w_uq': normal(ks[17], (DEPTH, MLA_Q_RANK, MLA_HEADS * (MLA_NOPE + MLA_ROPE)), MLA_Q_RANK ** -0.5),
        'mla_w_ukv': normal(ks[18], (DEPTH, MLA_KV_RANK, MLA_HEADS * (MLA_NOPE + MLA_DV)), MLA_KV_RANK ** -0.5),
        'router_w': normal(ks[19], (DEPTH, D_MODEL, N_EXPERTS), D_MODEL ** -0.5),
        'router_b': normal(ks[20], (DEPTH, N_EXPERTS), 0.01),
        'exp_w1': normal(ks[21], (DEPTH, N_EXPERTS, D_MODEL, 2 * D_FF), D_MODEL ** -0.5),
        'exp_b1': normal(ks[22], (DEPTH, N_EXPERTS, 2 * D_FF), 0.01),
        'exp_w2': normal(ks[23], (DEPTH, N_EXPERTS, D_FF, D_MODEL), D_FF ** -0.5),
        'exp_b2': normal(ks[24], (DEPTH, N_EXPERTS, D_MODEL), 0.01),
    }


def reference(x, c, ctx, c_ctx, ada_w, ada_b, norm_g, w_in, w_out, ret_log_decay, ret_gn_w, ret_gn_b,
              diff_lambda, diff_subln, gqa_qk_norm, mla_q_norm, mla_kv_norm, mla_w_uq, mla_w_ukv,
              router_w, router_b, exp_w1, exp_b1, exp_w2, exp_b2):
    b, s, d = x.shape
    n_ctx = ctx.shape[1]
    ROWS = s // GRID_W
    rope64 = grid_rope(ROWS, RET_DK)
    rope32 = grid_rope(ROWS, DIFF_D)
    silu_c = jax.nn.silu(c)
    silu_cc = jax.nn.silu(c_ctx)
    for l in range(DEPTH):
        last = l == DEPTH - 1
        sh_a, sc_a, g_a, sh_f, sc_f, g_f = jnp.split((silu_c @ ada_w[l] + ada_b[l])[:, None, :], 6, axis=-1)
        csh_a, csc_a, cg_a, csh_f, csc_f, cg_f = jnp.split(silu_cc @ ada_w[l] + ada_b[l], 6, axis=-1)
        lam_init = 0.8 - 0.6 * math.exp(-0.3 * l)
        h_lat = modulate(x, norm_g[l, 0], sh_a, sc_a)
        h_ctx = modulate(ctx, norm_g[l, 0], csh_a, csc_a)
        y_lat, y_ctx = mixing_sublayer(h_lat, h_ctx, w_in[l], w_out[l], ret_log_decay[l], ret_gn_w[l],
                                       ret_gn_b[l], diff_lambda[l], diff_subln[l], gqa_qk_norm[l],
                                       mla_q_norm[l], mla_kv_norm[l], mla_w_uq[l], mla_w_ukv[l],
                                       rope64, rope32, lam_init, not last)
        x = x + g_a * rms_norm(y_lat, norm_g[l, 1])
        moe_params = (router_w[l], router_b[l], exp_w1[l], exp_b1[l], exp_w2[l], exp_b2[l])
        if last:
            h = modulate(x, norm_g[l, 2], sh_f, sc_f)
            y = moe_ffn(h.reshape(b * s, d), *moe_params).reshape(b, s, d)
            x = x + g_f * rms_norm(y, norm_g[l, 3])
        else:
            ctx = ctx + cg_a * rms_norm(y_ctx, norm_g[l, 1])
            h_lat = modulate(x, norm_g[l, 2], sh_f, sc_f).reshape(b * s, d)
            h_ctx = modulate(ctx, norm_g[l, 2], csh_f, csc_f).reshape(b * n_ctx, d)
            y = moe_ffn(jnp.concatenate([h_lat, h_ctx], axis=0), *moe_params)
            x = x + g_f * rms_norm(y[:b * s].reshape(b, s, d), norm_g[l, 3])
            ctx = ctx + cg_f * rms_norm(y[b * s:].reshape(b, n_ctx, d), norm_g[l, 3])
    return x
```

```cpp
#include <hip/hip_runtime.h>
#include <stdint.h>
#include <stdio.h>

#ifndef MK_LAUNCHES
#define MK_LAUNCHES 1
#endif
#ifndef DUP_MASK
#define DUP_MASK 0
#endif
#define DUP(k) (((DUP_MASK) >> (k)) & 1)

#define DI __device__ __forceinline__
#define LAS __attribute__((address_space(3)))
typedef unsigned short bf16_t;
typedef short bf16x8 __attribute__((ext_vector_type(8)));
typedef short s16x4 __attribute__((ext_vector_type(4)));
typedef short v4i16_t __attribute__((ext_vector_type(4)));
typedef float f32x2 __attribute__((ext_vector_type(2)));
typedef float f32x4 __attribute__((ext_vector_type(4)));
typedef float f32x16 __attribute__((ext_vector_type(16)));
typedef unsigned u32x2 __attribute__((ext_vector_type(2)));
typedef unsigned u32x4 __attribute__((ext_vector_type(4)));
typedef __bf16 bf16x2v __attribute__((ext_vector_type(2)));

constexpr int DM = 1024, NB = 8, SEQ = 4096, NCTX = 256, SP = SEQ + NCTX, T = NB * SP, NL = 4;
constexpr int NIN = 2656, NP = 3584, NG1 = 2816;
constexpr int NE = 32, DFF2 = 2048;
constexpr int C_RQ = 0, C_RK = 256, C_RV = 512, C_RG = 768, C_DQ = 1024, C_DK = 1280, C_DV = 1536, C_GQ = 1792, C_GK = 2048, C_GV = 2176,
              C_MCQ = 2304, C_MCKV = 2496, C_MKR = 2624, C_MQE = 2656, C_MKVE = 3040, C_END = 3552;
constexpr int NCHUNK = SP / 256;
constexpr int ACT_ROWS = 4 * T + NE * 256;
constexpr float EPS = 1e-6f;
constexpr float LOG2E = 1.4426950408889634f;
constexpr int NTHR = 512;
constexpr int LDS_BYTES = 147456;
constexpr int LDS_XB = LDS_BYTES - 16;

constexpr size_t AL(size_t x) { return (x + 255) & ~(size_t)255; }
constexpr size_t WS_CTL = 0, CTL_BYTES = 65536;
constexpr size_t CTL_GCUR = 16384;
constexpr size_t WS_MOD = WS_CTL + CTL_BYTES;
constexpr size_t WS_TAB = WS_MOD + AL((size_t)NL * 9 * 6144 * 4);
constexpr size_t TAB_R64 = 0, TAB_R32 = 8192, TAB_LAM = 12288;
constexpr size_t WS_WUQ = WS_TAB + 16384;
constexpr size_t WS_WUKV = WS_WUQ + AL((size_t)NL * 384 * 192 * 2);
constexpr size_t WS_WIN = WS_WUKV + AL((size_t)NL * 512 * 128 * 2);
constexpr size_t WS_WOUT = WS_WIN + (size_t)NL * NP * DM * 2;
constexpr size_t WS_W1 = WS_WOUT + (size_t)NL * DM * DM * 2;
constexpr size_t WS_W2 = WS_W1 + (size_t)NL * NE * DFF2 * DM;
constexpr size_t WS_H8 = WS_W2 + (size_t)NL * NE * DM * DM;
constexpr size_t WS_XS = WS_H8 + (size_t)T * DM;
constexpr size_t WS_H = WS_XS + (size_t)T * DM * 4;
constexpr size_t WS_P = WS_H + (size_t)T * DM * 2;
constexpr size_t WS_QRET = WS_P + (size_t)T * NP * 2;
constexpr size_t WS_KRET = WS_QRET + (size_t)T * 256 * 2;
constexpr size_t WS_QD = WS_KRET + (size_t)T * 256 * 2;
constexpr size_t WS_KD = WS_QD + (size_t)T * 256 * 2;
constexpr size_t WS_QG = WS_KD + (size_t)T * 256 * 2;
constexpr size_t WS_KG = WS_QG + (size_t)T * 256 * 2;
constexpr size_t WS_QM = WS_KG + (size_t)T * 128 * 2;
constexpr size_t WS_KM = WS_QM + (size_t)T * 384 * 2;
constexpr size_t WS_VM = WS_KM + (size_t)T * 384 * 2;
constexpr size_t WS_UST = WS_VM + (size_t)T * 256 * 2;
constexpr size_t WS_YC = WS_UST + (size_t)NB * 4 * NCHUNK * 2 * 4096 * 4;
constexpr size_t WS_YO = WS_YC + (size_t)T * DM * 2;
constexpr size_t WS_LIST = WS_YO + (size_t)T * DM * 2;
constexpr size_t WS_RSLOT = WS_LIST + (size_t)NE * T * 4;
constexpr size_t WS_RGATE = WS_RSLOT + (size_t)T * 16;
constexpr size_t WS_ACT = WS_RGATE + (size_t)T * 16;
constexpr size_t WS_YR = WS_ACT + (size_t)ACT_ROWS * DM;
constexpr size_t WS_END = WS_YR + (size_t)ACT_ROWS * DM * 2;

#define XB_TMO      128
#define XB_XCNT(j)  (256  + 64 * (j))
#define XB_XSUB(j)  (1280 + 64 * (j))
#define XB_XGEN(j)  (2304 + 64 * (j))
#define XB_TOP      3328
#define XB_TOPGEN   3392
#define XCD_BAR_WORDS 3456
#define XB_SPIN_CAP (1u << 18)

__device__ __forceinline__ unsigned xb_ld(unsigned* p)              { return __hip_atomic_load(p, __ATOMIC_RELAXED, __HIP_MEMORY_SCOPE_AGENT); }
__device__ __forceinline__ unsigned xb_add(unsigned* p, unsigned v) { return __hip_atomic_fetch_add(p, v, __ATOMIC_RELAXED, __HIP_MEMORY_SCOPE_AGENT); }
__device__ __forceinline__ unsigned xb_xcc_id() { return (unsigned)__builtin_amdgcn_s_getreg((3 << 11) | 20) & 0xFu; }
#define XB_SPIN(cond, bar) do { unsigned _sp = 0; while (cond) { __builtin_amdgcn_s_sleep(1); \
    if ((++_sp & 255u) == 0u) { if (xb_ld(&(bar)[XB_TMO])) break; if (_sp > XB_SPIN_CAP) { atomicAdd(&(bar)[XB_TMO], 1u); break; } } } } while (0)

struct XcdBarrier { unsigned* bar; unsigned x; volatile LAS unsigned* st; };

__device__ __forceinline__ XcdBarrier xcd_barrier_post(unsigned* bar, volatile LAS unsigned* st) {
    XcdBarrier b; b.bar = bar; b.x = xb_xcc_id(); b.st = st;
    if (threadIdx.x == 0) (void)xb_add(&bar[XB_XCNT(b.x)], 1u);
    return b;
}
__device__ __forceinline__ void xcd_barrier_complete(unsigned* bar, unsigned x, unsigned& nloc, unsigned& nx) {
    const unsigned G = gridDim.x * gridDim.y * gridDim.z;
    unsigned sum, cnt, mine, sp = 0u;
    for (;;) {
        sum = 0u; cnt = 0u; mine = 0u;
#pragma unroll
        for (unsigned j = 0; j < 16; ++j) { const unsigned c = xb_ld(&bar[XB_XCNT(j)]); sum += c; cnt += (c > 0u) ? 1u : 0u; mine = (j == x) ? c : mine; }
        if (sum == G) break;
        __builtin_amdgcn_s_sleep(1);
        if ((++sp & 255u) == 0u) { if (xb_ld(&bar[XB_TMO])) break; if (sp > XB_SPIN_CAP) { atomicAdd(&bar[XB_TMO], 1u); break; } }
    }
    nloc = mine > 0u ? mine : 1u; nx = cnt > 0u ? cnt : 1u;
}
__device__ __forceinline__ void xcd_barrier(const XcdBarrier& b) {
    asm volatile("s_waitcnt vmcnt(0)" ::: "memory");
    __syncthreads();
    if (threadIdx.x == 0) {
        unsigned* bar = b.bar;
        __builtin_amdgcn_s_waitcnt(0);
        unsigned nloc = b.st[0], nx = b.st[1];
        if (nloc == 0u) { xcd_barrier_complete(bar, b.x, nloc, nx); b.st[0] = nloc; b.st[1] = nx; }
        const unsigned old = xb_add(&bar[XB_XSUB(b.x)], 1u);
        const unsigned gen = old / nloc;
        if (old + 1u == (gen + 1u) * nloc) {
            __builtin_amdgcn_fence(__ATOMIC_RELEASE, "agent");
            asm volatile("s_waitcnt vmcnt(0)" ::: "memory");
            const unsigned og = xb_add(&bar[XB_TOP], 1u);
            const unsigned tg = og / nx;
            if (og + 1u == (tg + 1u) * nx) xb_add(&bar[XB_TOPGEN], 1u);
            else XB_SPIN(xb_ld(&bar[XB_TOPGEN]) == tg, bar);
            __builtin_amdgcn_fence(__ATOMIC_ACQUIRE, "agent");
            xb_add(&bar[XB_XGEN(b.x)], 1u);
            asm volatile("s_waitcnt vmcnt(0)" ::: "memory");
        } else {
            XB_SPIN(xb_ld(&bar[XB_XGEN(b.x)]) == gen, bar);
            __builtin_amdgcn_fence(__ATOMIC_ACQUIRE, "agent");
            asm volatile("s_waitcnt vmcnt(0)" ::: "memory");
        }
    }
    __syncthreads();
}

DI float bf2f(unsigned short x) { return __uint_as_float((unsigned)x << 16); }
DI float bflo(unsigned u) { return __uint_as_float(u << 16); }
DI float bfhi(unsigned u) { return __uint_as_float(u & 0xffff0000u); }
DI unsigned pk2(float lo, float hi) { f32x2 v = {lo, hi}; bf16x2v b = __builtin_convertvector(v, bf16x2v); return __builtin_bit_cast(unsigned, b); }
constexpr float S_W8 = 256.0f, S_H8 = 16.0f, S_A8 = 4.0f, S_Y8 = 16.0f;
DI unsigned pk4_fp8(float a, float b, float c, float d) { int v = __builtin_amdgcn_cvt_pk_fp8_f32(a, b, 0, false); v = __builtin_amdgcn_cvt_pk_fp8_f32(c, d, v, true); return (unsigned)v; }
DI unsigned pk2_fp8(float a, float b) { return (unsigned)__builtin_amdgcn_cvt_pk_fp8_f32(a, b, 0, false) & 0xffffu; }
DI float sat8(float x, float lim) { return fminf(fmaxf(x, -lim), lim); }
DI float opq(float c) { asm volatile("" : "+v"(c)); return c; }
DI float opq_s(float c) { asm volatile("" : "+s"(c)); return c; }
DI void ld4(const bf16_t* p, float (&o)[4]) { const u32x2 u = *(const u32x2*)p; o[0] = bflo(u.x); o[1] = bfhi(u.x); o[2] = bflo(u.y); o[3] = bfhi(u.y); }
DI void st4(bf16_t* p, const float (&v)[4]) { u32x2 u; u.x = pk2(v[0], v[1]); u.y = pk2(v[2], v[3]); *(u32x2*)p = u; }
DI void ld8(const bf16_t* p, float (&o)[8]) { const u32x4 u = *(const u32x4*)p; o[0] = bflo(u.x); o[1] = bfhi(u.x); o[2] = bflo(u.y); o[3] = bfhi(u.y); o[4] = bflo(u.z); o[5] = bfhi(u.z); o[6] = bflo(u.w); o[7] = bfhi(u.w); }
DI void st8(bf16_t* p, const float (&v)[8]) { u32x4 u; u.x = pk2(v[0], v[1]); u.y = pk2(v[2], v[3]); u.z = pk2(v[4], v[5]); u.w = pk2(v[6], v[7]); *(u32x4*)p = u; }
template <int CTRL> DI float dpp_f(float v) { return __int_as_float(__builtin_amdgcn_update_dpp(0, __float_as_int(v), CTRL, 0xf, 0xf, true)); }
DI float sum8_dpp(float v) { v += dpp_f<0xB1>(v); v += dpp_f<0x4E>(v); v += dpp_f<0x141>(v); return v; }
DI float xor32_f(float v) { auto rr = __builtin_amdgcn_permlane32_swap(__float_as_uint(v), __float_as_uint(v), false, false); return __uint_as_float((threadIdx.x & 32) ? rr[0] : rr[1]); }
DI float wave_sum(float v) {
    v = sum8_dpp(v); v += dpp_f<0x140>(v);
    const float r0 = __int_as_float(__builtin_amdgcn_readlane(__float_as_int(v), 0)), r1 = __int_as_float(__builtin_amdgcn_readlane(__float_as_int(v), 16));
    const float r2 = __int_as_float(__builtin_amdgcn_readlane(__float_as_int(v), 32)), r3 = __int_as_float(__builtin_amdgcn_readlane(__float_as_int(v), 48));
    return (r0 + r1) + (r2 + r3);
}
DI float silu(float x) { return x / (1.0f + __expf(-x)); }
#define MFMA32(a, b, c) __builtin_amdgcn_mfma_f32_32x32x16_bf16((a), (b), (c), 0, 0, 0)
DI f32x16 mfma32_c(bf16x8 a, bf16x8 b, const f32x16& c) { f32x16 d; asm("v_mfma_f32_32x32x16_bf16 %0, %1, %2, %3" : "=&v"(d) : "v"(a), "v"(b), "v"(c)); return d; }
DI int crow(int reg, int h) { return (reg & 3) + 8 * (reg >> 2) + 4 * h; }
DI s16x4 trread(LAS unsigned char* p) { return __builtin_bit_cast(s16x4, __builtin_amdgcn_ds_read_tr16_b64_v4i16((LAS v4i16_t*)p)); }

struct Args { const float* in[25]; float* out; unsigned char* ws; int ph_lo, ph_hi; };
enum { I_X = 0, I_C, I_CTX, I_CCTX, I_ADAW, I_ADAB, I_NORMG, I_WIN, I_WOUT, I_RLD, I_RGNW, I_RGNB, I_DLAM, I_DSUB, I_GQKN, I_MQN, I_MKVN, I_MUQ, I_MUKV,
       I_RW, I_RB, I_EW1, I_EB1, I_EW2, I_EB2 };


DI int otid() { int t = threadIdx.x; asm volatile("" : "+v"(t)); return t; }
DI int obx() { int b = blockIdx.x; asm volatile("" : "+s"(b)); return b; }
#define CAS __attribute__((address_space(4)))
DI const CAS char* karg_base() { const CAS char* ka = (const CAS char*)__builtin_amdgcn_kernarg_segment_ptr(); asm volatile("" : "+s"(ka)); return ka; }
DI const float* kin(int i) { return *(const float* const CAS*)(karg_base() + 8 * i); }
DI float* kout() { return *(float* const CAS*)(karg_base() + 200); }
DI unsigned char* kws() { return *(unsigned char* const CAS*)(karg_base() + 208); }

DI unsigned char* wso(unsigned char* ws, size_t off) { asm volatile("" : "+s"(off)); return ws + off; }

DI const float* input_row(const Args& a, int row) {
    const int b = row / SP, pos = row - b * SP;
    return pos < NCTX ? kin(I_CTX) + ((size_t)b * NCTX + pos) * DM : kin(I_X) + ((size_t)b * SEQ + (pos - NCTX)) * DM;
}

DI void tconv_unit(const float* __restrict__ src, int ldn, int nvalid, bf16_t* __restrict__ dst, int k0, int n0) {
    const int tid_ = otid(), lane = tid_ & 63, w = __builtin_amdgcn_readfirstlane(tid_ >> 6);
    const int n = n0 + w * 64 + lane;
    if (n < nvalid) {
        const float* s = src + (size_t)k0 * ldn + n;
        float v[64];
#pragma unroll
        for (int j = 0; j < 64; ++j) v[j] = s[(size_t)j * ldn];
        bf16_t* d = dst + (size_t)n * DM + k0;
#pragma unroll
        for (int j = 0; j < 8; ++j) {
            u32x4 o; o.x = pk2(v[8 * j], v[8 * j + 1]); o.y = pk2(v[8 * j + 2], v[8 * j + 3]); o.z = pk2(v[8 * j + 4], v[8 * j + 5]); o.w = pk2(v[8 * j + 6], v[8 * j + 7]);
            *(u32x4*)(d + 8 * j) = o;
        }
    }
}

constexpr int CV_PITCH = 136;
DI void tconv_unit8(const float* __restrict__ src, int ldn, uint8_t* __restrict__ dst, int k0, int n0, LAS unsigned char* lds) {
    const int tid_ = otid(), lane = tid_ & 63, w = __builtin_amdgcn_readfirstlane(tid_ >> 6);
#pragma unroll 1
    for (int hf = 0; hf < 2; ++hf) {
        const float* sp = src + (size_t)(k0 + 64 * hf + 8 * w) * ldn + n0 + lane * 4;
        f32x4 v[32];
#pragma unroll
        for (int j = 0; j < 32; ++j) v[j] = *(const f32x4*)(sp + (size_t)(j >> 2) * ldn + (j & 3) * 256);
        __builtin_amdgcn_sched_barrier(0);
        LAS unsigned char* lp = lds + (4 * lane) * CV_PITCH + 64 * hf + 8 * w;
#pragma unroll
        for (int q = 0; q < 4; ++q)
#pragma unroll
            for (int c = 0; c < 4; ++c) {
                u32x2 o;
                o.x = pk4_fp8(v[0 + q][c] * S_W8, v[4 + q][c] * S_W8, v[8 + q][c] * S_W8, v[12 + q][c] * S_W8);
                o.y = pk4_fp8(v[16 + q][c] * S_W8, v[20 + q][c] * S_W8, v[24 + q][c] * S_W8, v[28 + q][c] * S_W8);
                *(LAS u32x2*)(lp + (256 * q + c) * CV_PITCH) = o;
            }
    }
    __syncthreads();
    {
        const int t = otid(), r0 = t >> 3, ch = t & 7;
        uint8_t* dp = dst + (size_t)(n0 + r0) * DM + k0 + ch * 16;
        const LAS unsigned char* lp = lds + r0 * CV_PITCH + ch * 16;
#pragma unroll 4
        for (int p = 0; p < 16; ++p) {
            const u32x2 x = *(const LAS u32x2*)(lp + p * 64 * CV_PITCH), y = *(const LAS u32x2*)(lp + p * 64 * CV_PITCH + 8);
            *(u32x4*)(dp + (size_t)p * 64 * DM) = (u32x4){x.x, x.y, y.x, y.y};
        }
    }
    __syncthreads();
}

DI void conv_experts(int l, LAS unsigned char* lds) {
    constexpr int U_W1 = NE * 8 * 2, U_W2 = NE * 8;
    unsigned char* ws = kws();
    __syncthreads();
    for (int v = obx(); v < U_W1 + U_W2; v += gridDim.x) {
        if (v < U_W1) { const int e = v / 16, r = v % 16, kt = r / 2, nt = r % 2;
            tconv_unit8(kin(I_EW1) + ((size_t)l * NE + e) * DM * DFF2, DFF2, (uint8_t*)(wso(ws, WS_W1)) + ((size_t)l * NE + e) * DFF2 * DM, kt * 128, nt * 1024, lds); }
        else { const int v2 = v - U_W1, e = v2 / 8, kt = v2 % 8;
            tconv_unit8(kin(I_EW2) + ((size_t)l * NE + e) * DM * DM, DM, (uint8_t*)(wso(ws, WS_W2)) + ((size_t)l * NE + e) * DM * DM, kt * 128, 0, lds); }
    }
}

DI void p0_prologue(const Args& a, LAS unsigned char* lds) {
    const int tid = otid(), lane = tid & 63, w = __builtin_amdgcn_readfirstlane(tid >> 6), G = gridDim.x, bx = obx();
    unsigned char* ws = kws();
    {
        constexpr int U_WIN = 16 * 6, U_WOUT = 16 * 2, U_L = U_WIN + U_WOUT;
        for (int u = bx; u < NL * U_L; u += G) {
            const int l = u / U_L; int v = u - l * U_L;
            if (v < U_WIN) { const int kt = v / 6, nt = v % 6;
                tconv_unit(kin(I_WIN) + (size_t)l * DM * NIN, NIN, NIN, (bf16_t*)(wso(ws, WS_WIN)) + (size_t)l * NP * DM, kt * 64, nt * 512); continue; }
            v -= U_WIN;
            { const int kt = v / 2, nt = v % 2;
                tconv_unit(kin(I_WOUT) + (size_t)l * DM * DM, DM, DM, (bf16_t*)(wso(ws, WS_WOUT)) + (size_t)l * DM * DM, kt * 64, nt * 512); }
        }
    }
    {
        LAS float* sv = (LAS float*)lds;
        LAS float* red = (LAS float*)(lds + 9 * 1024 * 4);
        for (int i = tid; i < 9 * 1024; i += NTHR) { const int v = i >> 10, k = i & 1023; const float c = v < 8 ? kin(I_C)[v * DM + k] : kin(I_CCTX)[k]; sv[i] = silu(c); }
        __syncthreads();
        for (int it = bx; it < NL * 64; it += G) {
            const int l = it >> 6, n0 = (it & 63) * 96;
            const float* wp = kin(I_ADAW) + (size_t)l * DM * 6144 + (size_t)(w * 128) * 6144 + n0 + (lane < 48 ? lane : 47) * 2;
            f32x2 acc[9];
#pragma unroll
            for (int v = 0; v < 9; ++v) acc[v] = (f32x2){0.f, 0.f};
#pragma unroll 1
            for (int kb = 0; kb < 128; kb += 64) {
                f32x2 wv[64];
#pragma unroll
                for (int j = 0; j < 64; ++j) wv[j] = *(const f32x2*)(wp + (size_t)(kb + j) * 6144);
                __builtin_amdgcn_sched_barrier(0);
                LAS float* sk = sv + w * 128 + kb;
#pragma unroll
                for (int j = 0; j < 64; j += 2)
#pragma unroll
                    for (int v = 0; v < 9; ++v) { const f32x2 s2 = *(LAS f32x2*)(sk + v * 1024 + j); acc[v] += wv[j] * s2.x; acc[v] += wv[j + 1] * s2.y; }
            }
            if (lane < 48) {
#pragma unroll
                for (int v = 0; v < 9; ++v) *(LAS f32x2*)(red + (w * 9 + v) * 96 + lane * 2) = acc[v]; }
            __syncthreads();
            for (int i = tid; i < 9 * 96; i += NTHR) {
                const int v = i / 96, c = i - v * 96; float s_ = 0.f;
#pragma unroll
                for (int ww = 0; ww < 8; ++ww) s_ += red[(ww * 9 + v) * 96 + c];
                ((float*)(wso(ws, WS_MOD)))[((size_t)l * 9 + v) * 6144 + n0 + c] = s_ + kin(I_ADAB)[l * 6144 + n0 + c];
            }
            __syncthreads();
        }
    }
    __syncthreads();
    {
        constexpr int NQ = NL * 384 * 24, NKV = NL * 512 * 16;
        for (int i = bx * NTHR + tid; i < NQ + NKV; i += G * NTHR) {
            const bool isq = i < NQ; const int j = isq ? i : i - NQ;
            const int K = isq ? 192 : 128, N = isq ? 384 : 512, k8 = j % (K / 8), n = (j / (K / 8)) % N, l = j / ((K / 8) * N);
            const float* wu = (isq ? kin(I_MUQ) : kin(I_MUKV)) + (size_t)l * K * N + n; const float* nr = (isq ? kin(I_MQN) : kin(I_MKVN)) + l * K;
            float v[8];
#pragma unroll
            for (int q = 0; q < 8; ++q) v[q] = wu[(size_t)(k8 * 8 + q) * N] * nr[k8 * 8 + q];
            bf16_t* dq = (bf16_t*)(wso(ws, WS_WUQ)); bf16_t* dkv = (bf16_t*)(wso(ws, WS_WUKV));
            st8((isq ? dq : dkv) + ((size_t)l * N + n) * K + k8 * 8, v);
        }
    }
    for (int r = bx; r < NL * (NG1 - NIN); r += G) { const int l = r / (NG1 - NIN), rr = r % (NG1 - NIN); ((unsigned*)((bf16_t*)(wso(ws, WS_WIN)) + ((size_t)l * NP + NIN + rr) * DM))[tid] = 0u; }
    if (bx == G - 1) {
        f32x2* r64 = (f32x2*)(wso(ws, WS_TAB) + TAB_R64); f32x2* r32 = (f32x2*)(wso(ws, WS_TAB) + TAB_R32);
        for (int i = tid; i < 64 * 16; i += NTHR) { const int p = i >> 4, f = i & 15; const float inv = powf(10000.0f, -(float)f / 16.0f); const float ang = (float)p * inv; r64[i] = (f32x2){cosf(ang), sinf(ang)}; }
        for (int i = tid; i < 64 * 8; i += NTHR) { const int p = i >> 3, f = i & 7; const float inv = powf(10000.0f, -(float)f / 8.0f); const float ang = (float)p * inv; r32[i] = (f32x2){cosf(ang), sinf(ang)}; }
        if (tid < NL) {
            const float* lp = kin(I_DLAM) + tid * 4 * 32; float s1 = 0.f, s2 = 0.f;
            for (int i = 0; i < 32; ++i) { s1 += lp[i] * lp[32 + i]; s2 += lp[64 + i] * lp[96 + i]; }
            const float lam_init = 0.8f - 0.6f * expf(-0.3f * (float)tid);
            ((float*)(wso(ws, WS_TAB) + TAB_LAM))[tid] = expf(s1) - expf(s2) + lam_init;
        }
    }
}

struct Row16 { f32x4 v[4]; };
DI Row16 ld_f32row(const float* p, int lane) { Row16 r;
#pragma unroll
    for (int i = 0; i < 4; ++i) r.v[i] = *(const f32x4*)(p + i * 256 + lane * 4);
    return r; }
DI void st_f32row(float* p, int lane, const Row16& r) {
#pragma unroll
    for (int i = 0; i < 4; ++i) *(f32x4*)(p + i * 256 + lane * 4) = r.v[i]; }
DI Row16 ld_bf16row(const bf16_t* p, int lane) { Row16 r;
#pragma unroll
    for (int i = 0; i < 4; ++i) { const u32x2 u = *(const u32x2*)(p + i * 256 + lane * 4); r.v[i] = (f32x4){bflo(u.x), bfhi(u.x), bflo(u.y), bfhi(u.y)}; }
    return r; }
DI void st_bf16row(bf16_t* p, int lane, const Row16& r) {
#pragma unroll
    for (int i = 0; i < 4; ++i) { u32x2 u; u.x = pk2(r.v[i][0], r.v[i][1]); u.y = pk2(r.v[i][2], r.v[i][3]); *(u32x2*)(p + i * 256 + lane * 4) = u; } }
DI float row_ss(const Row16& r) { float s = 0.f;
#pragma unroll
    for (int i = 0; i < 4; ++i) s += r.v[i][0] * r.v[i][0] + r.v[i][1] * r.v[i][1] + r.v[i][2] * r.v[i][2] + r.v[i][3] * r.v[i][3];
    return wave_sum(s); }
typedef const __attribute__((address_space(1))) f32x4* gv4p;
DI Row16 modulate_row(const Row16& x, const float* g, const float* shift, const float* scale, int lane) {
    f32x4 gv[4], sh[4], sc[4];
#pragma unroll
    for (int i = 0; i < 4; ++i) { gv[i] = *(gv4p)(g + i * 256 + lane * 4); sh[i] = *(gv4p)(shift + i * 256 + lane * 4); sc[i] = *(gv4p)(scale + i * 256 + lane * 4); }
    const float rstd = rsqrtf(row_ss(x) * (1.0f / DM) + opq(EPS)); Row16 h;
#pragma unroll
    for (int i = 0; i < 4; ++i) h.v[i] = x.v[i] * rstd * gv[i] * (sc[i] + 1.0f) + sh[i];
    return h; }

DI void p_norm0(const Args& a) {
    const int tid = otid(), lane = tid & 63, w = __builtin_amdgcn_readfirstlane(tid >> 6);
    const float* mod = (const float*)(wso(kws(), WS_MOD));
    for (int row = obx() * 8 + w; row < T; row += gridDim.x * 8) {
        const int b = row / SP, pos = row - b * SP; const float* m = mod + (size_t)(pos < NCTX ? 8 : b) * 6144;
        const Row16 x = ld_f32row(input_row(a, row), lane);
        const Row16 h = modulate_row(x, kin(I_NORMG), m, m + 1024, lane);
        st_bf16row((bf16_t*)(wso(kws(), WS_H)) + (size_t)row * DM, lane, h);
    }
}

constexpr int RA_WR = 0, RA_WRP = 1028, RA_SCR = 32 * RA_WRP * 4  , RA_SCRW = 320, RA_RECE = RA_SCR + 8 * RA_SCRW, RA_RECG = RA_RECE + 2176,
              RA_CNT = RA_RECG + 2176, RA_BASE = RA_CNT + 128, RA_RB = RA_BASE + 128, RA_CC = RA_RB + 128, RA_CB = RA_CC + 4096, RA_END = RA_CB + 4096;
static_assert(RA_END <= LDS_XB, "lds");
constexpr int ROWS_PER_BLK = 136;

struct RowAIn { Row16 x; u32x2 y[4]; };
DI RowAIn rowA_load(const Args& a, int l, int row, int lane) {
    RowAIn r; unsigned char* ws = kws();
    if (l == 0) r.x = ld_f32row(input_row(a, row), lane);
    else { const bf16_t* xp = (const bf16_t*)(wso(ws, WS_XS)) + (size_t)row * DM;
#pragma unroll
        for (int i = 0; i < 4; ++i) { const u32x2 u = *(const u32x2*)(xp + i * 256 + lane * 4); r.x.v[i] = (f32x4){__uint_as_float(u.x), __uint_as_float(u.y), 0.f, 0.f}; } }
    const bf16_t* yp = (const bf16_t*)(wso(ws, WS_YO)) + (size_t)row * DM;
#pragma unroll
    for (int i = 0; i < 4; ++i) r.y[i] = *(const u32x2*)(yp + i * 256 + lane * 4);
    return r;
}
DI void rowA_route(int lane, LAS float* scr, bool present, bool valid, int rlq, LAS int* rece, LAS float* recg, LAS int* cnt) {
    if (!present) return;
    if (!valid) { if (lane < 4) rece[rlq * 4 + lane] = -1; return; }
    asm volatile("" ::: "memory");
    const int e_own = lane >> 1;
    const float logit = scr[e_own];
    int rank = 0;
#pragma unroll
    for (int e4 = 0; e4 < 8; ++e4) { const f32x4 o = *(LAS f32x4*)(scr + 4 * e4);
#pragma unroll
        for (int j = 0; j < 4; ++j) rank += (o[j] > logit || (o[j] == logit && 4 * e4 + j < e_own)) ? 1 : 0; }
    if ((lane & 1) == 0 && rank < 4) { scr[32 + rank] = logit; scr[36 + rank] = __int_as_float(e_own); }
    asm volatile("" ::: "memory");
    const f32x4 tv = *(LAS f32x4*)(scr + 32);
    const float e0 = 1.0f, e1 = __expf(tv[1] - tv[0]), e2 = __expf(tv[2] - tv[0]), e3 = __expf(tv[3] - tv[0]), inv = 1.0f / (e0 + e1 + e2 + e3);
    if (lane < 4) {
        const int e = __float_as_int(scr[36 + lane]);
        const float g = (lane == 0 ? e0 : lane == 1 ? e1 : lane == 2 ? e2 : e3) * inv;
        const int lp = __hip_atomic_fetch_add(&cnt[e], 1, __ATOMIC_RELAXED, __HIP_MEMORY_SCOPE_WORKGROUP);
        rece[rlq * 4 + lane] = (e << 16) | lp; recg[rlq * 4 + lane] = g;
    }
    asm volatile("" ::: "memory");
}
DI void p_rowA(const Args& a, int l, LAS unsigned char* lds, bool dry = false) {
    const int tid = otid(), lane = tid & 63, w = __builtin_amdgcn_readfirstlane(tid >> 6);
    const bool last = (l == NL - 1);
    unsigned char* ws = kws();
    LAS float* wr = (LAS float*)(lds + RA_WR);
    LAS float* scr = (LAS float*)(lds + RA_SCR + w * RA_SCRW);
    LAS int* rece = (LAS int*)(lds + RA_RECE); LAS float* recg = (LAS float*)(lds + RA_RECG);
    LAS int* cnt = (LAS int*)(lds + RA_CNT); LAS int* base = (LAS int*)(lds + RA_BASE);
    {   const float* rw = kin(I_RW) + (size_t)l * DM * NE;
#pragma unroll 1
        for (int i0 = 0; i0 < DM * NE; i0 += 16 * NTHR) { float t[16];
#pragma unroll
            for (int j = 0; j < 16; ++j) t[j] = rw[i0 + j * NTHR + tid];
#pragma unroll
            for (int j = 0; j < 16; ++j) { const int i = i0 + j * NTHR + tid; wr[(i & 31) * RA_WRP + (i >> 5)] = t[j]; } }
        if (tid < 32) { cnt[tid] = 0; ((LAS float*)(lds + RA_RB))[tid] = kin(I_RB)[l * NE + tid]; }
    }
    __syncthreads();
    const float* mod = (const float*)(wso(ws, WS_MOD)) + (size_t)l * 9 * 6144;
    const float* ng = kin(I_NORMG) + (size_t)l * 4 * DM;
    LAS float* rb = (LAS float*)(lds + RA_RB);
    int* gcur = (int*)(wso(ws, WS_CTL) + (dry ? 49152 : CTL_GCUR)) + l * NE * (dry ? 16 : 64);
    const int gstride = dry ? 16 : 64;
    bf16_t* XSo = (bf16_t*)(ws + (dry ? WS_ACT : WS_XS)); uint8_t* Ho = (uint8_t*)(ws + (dry ? WS_YR : WS_H8));
    unsigned char* LSo = ws + (dry ? WS_YR + ((size_t)100 << 20) : WS_LIST);
    for (int chunk = obx(); chunk * ROWS_PER_BLK < T; chunk += gridDim.x) {
        const int row0 = chunk * ROWS_PER_BLK;
        Row16 cA;
        LAS float* cCl = (LAS float*)(lds + RA_CC); LAS float* cBl = (LAS float*)(lds + RA_CB);
        const bool cctx = (row0 % SP) < NCTX;
        {   const float* mL = mod + (size_t)(cctx ? 8 : row0 / SP) * 6144;
#pragma unroll
            for (int i = 0; i < 4; ++i) { const int o = i * 256 + lane * 4;
                cA.v[i] = *(const f32x4*)(mL + 2048 + o) * *(const f32x4*)(ng + DM + o); }
            __syncthreads();
            if (tid < 256) *(LAS f32x4*)(cCl + tid * 4) = *(const f32x4*)(mL + 3072 + tid * 4);
            else *(LAS f32x4*)(cBl + (tid - 256) * 4) = *(const f32x4*)(ng + 2 * DM + (tid - 256) * 4) * (*(const f32x4*)(mL + 4096 + (tid - 256) * 4) + 1.0f);
            __syncthreads(); }
        RowAIn cur[2];
        cur[0] = rowA_load(a, l, row0 + w, lane); cur[1] = rowA_load(a, l, row0 + w + 8, lane);
#pragma unroll 1
        for (int rl = w; rl < ROWS_PER_BLK; rl += 16) {
            const bool two = rl + 8 < ROWS_PER_BLK;
            RowAIn nxt[2];
            {   const int n0 = rl + 16 < ROWS_PER_BLK ? rl + 16 : rl, n1 = rl + 24 < ROWS_PER_BLK ? rl + 24 : n0;
                nxt[0] = rowA_load(a, l, row0 + n0, lane); nxt[1] = rowA_load(a, l, row0 + n1, lane); }
            asm volatile("" : "+s"(ng), "+s"(mod));
            Row16 h[2]; bool valid[2];
#pragma unroll
            for (int q = 0; q < 2; ++q) {
                const int rlq = rl + 8 * q, row = row0 + (q == 0 || two ? rlq : rl), b = row / SP, pos = row - b * SP; const bool isctx = pos < NCTX;
                valid[q] = (q == 0 || two) && !(last && isctx);
                const float* m = mod + (size_t)(isctx ? 8 : b) * 6144;
                Row16 x = cur[q].x, y;
                if (l != 0) {
#pragma unroll
                    for (int i = 0; i < 4; ++i) { const unsigned u0 = __float_as_uint(cur[q].x.v[i][0]), u1 = __float_as_uint(cur[q].x.v[i][1]); x.v[i] = (f32x4){bflo(u0), bfhi(u0), bflo(u1), bfhi(u1)}; } }
#pragma unroll
                for (int i = 0; i < 4; ++i) y.v[i] = (f32x4){bflo(cur[q].y[i].x), bfhi(cur[q].y[i].x), bflo(cur[q].y[i].y), bfhi(cur[q].y[i].y)};
                const float rstd = rsqrtf(row_ss(y) * (1.0f / DM) + opq(EPS));
                if (isctx != cctx) {
#pragma unroll
                    for (int i = 0; i < 4; ++i) { const f32x4 g1 = *(gv4p)(ng + DM + i * 256 + lane * 4), ga = *(gv4p)(m + 2048 + i * 256 + lane * 4);
                        x.v[i] = x.v[i] + ga * (y.v[i] * rstd * g1); }
                    h[q] = modulate_row(x, ng + 2 * DM, m + 3072, m + 4096, lane);
                } else {
#pragma unroll
                    for (int i = 0; i < 4; ++i) x.v[i] = x.v[i] + cA.v[i] * (y.v[i] * rstd);
                    const float rs2 = rsqrtf(row_ss(x) * (1.0f / DM) + opq(EPS));
#pragma unroll
                    for (int i = 0; i < 4; ++i) h[q].v[i] = x.v[i] * rs2 * *(LAS f32x4*)(cBl + i * 256 + lane * 4) + *(LAS f32x4*)(cCl + i * 256 + lane * 4);
                }
                if (valid[q]) { st_bf16row(XSo + (size_t)row * DM, lane, x);
#pragma unroll
                    for (int i = 0; i < 4; ++i) { const float lim = opq(448.0f); *(unsigned*)(Ho + (size_t)row * DM + i * 256 + lane * 4) = pk4_fp8(sat8(h[q].v[i][0] * S_H8, lim), sat8(h[q].v[i][1] * S_H8, lim), sat8(h[q].v[i][2] * S_H8, lim), sat8(h[q].v[i][3] * S_H8, lim)); } }
                __builtin_amdgcn_sched_barrier(0);
            }
            LAS float* scr1 = scr + 40;
#pragma unroll 1
            for (int c = 0; c < 4; ++c) {
                float v0[8], v1[8];
                LAS float* wc_ = wr + (8 * c) * RA_WRP + lane * 4;
#pragma unroll
                for (int e = 0; e < 8; ++e) { f32x2 s0 = {0.f, 0.f}, s1 = {0.f, 0.f};
#pragma unroll
                    for (int i = 0; i < 4; ++i) { const f32x4 wv = *(LAS f32x4*)(wc_ + e * RA_WRP + i * 256);
                        const f32x2 wa = {wv[0], wv[1]}, wb = {wv[2], wv[3]};
                        s0 = __builtin_elementwise_fma((f32x2){h[0].v[i][0], h[0].v[i][1]}, wa, s0); s0 = __builtin_elementwise_fma((f32x2){h[0].v[i][2], h[0].v[i][3]}, wb, s0);
                        s1 = __builtin_elementwise_fma((f32x2){h[1].v[i][0], h[1].v[i][1]}, wa, s1); s1 = __builtin_elementwise_fma((f32x2){h[1].v[i][2], h[1].v[i][3]}, wb, s1); }
                    v0[e] = s0.x + s0.y; v1[e] = s1.x + s1.y;
                    if (e & 1) __builtin_amdgcn_sched_barrier(0); }
#pragma unroll
                for (int e = 0; e < 4; ++e) { const bool up = lane & 32;
                    { const float snd = up ? v0[e] : v0[e + 4], keep = up ? v0[e + 4] : v0[e]; v0[e] = keep + xor32_f(snd); }
                    { const float snd = up ? v1[e] : v1[e + 4], keep = up ? v1[e + 4] : v1[e]; v1[e] = keep + xor32_f(snd); } }
#pragma unroll
                for (int e = 0; e < 2; ++e) { const bool up = lane & 16;
                    { const float snd = up ? v0[e] : v0[e + 2], keep = up ? v0[e + 2] : v0[e]; v0[e] = keep + __shfl_xor(snd, 16); }
                    { const float snd = up ? v1[e] : v1[e + 2], keep = up ? v1[e + 2] : v1[e]; v1[e] = keep + __shfl_xor(snd, 16); } }
                { const bool up = lane & 8;
                    { const float snd = up ? v0[0] : v0[1], keep = up ? v0[1] : v0[0]; v0[0] = keep + __shfl_xor(snd, 8); }
                    { const float snd = up ? v1[0] : v1[1], keep = up ? v1[1] : v1[0]; v1[0] = keep + __shfl_xor(snd, 8); } }
                float a0 = v0[0], a1 = v1[0];
                a0 = sum8_dpp(a0); a1 = sum8_dpp(a1);
                if ((lane & 7) == 0) { const int e = 8 * c + (lane >> 3); const float bv = rb[e]; scr[e] = a0 + bv; scr1[e] = a1 + bv; }
            }
            rowA_route(lane, scr, true, valid[0], rl, rece, recg, cnt);
            rowA_route(lane, scr1, two, valid[1], rl + 8, rece, recg, cnt);
            cur[0] = nxt[0]; cur[1] = nxt[1];
        }
        __syncthreads();
        if (tid < 32) { const int c = cnt[tid]; base[tid] = c ? atomicAdd(&gcur[tid * gstride], c) : 0; }
        __syncthreads();
        for (int i = tid; i < ROWS_PER_BLK * 4; i += NTHR) {
            const int ep = rece[i]; if (ep < 0) continue;
            const int e = ep >> 16, row = row0 + (i >> 2), posn = base[e] + (ep & 0xffff);
            ((int*)LSo)[(size_t)e * T + posn] = row;
            ((unsigned*)(LSo + (WS_RSLOT - WS_LIST)))[(size_t)row * 4 + (i & 3)] = ((unsigned)e << 24) | (unsigned)posn;
            ((float*)(LSo + (WS_RGATE - WS_LIST)))[(size_t)row * 4 + (i & 3)] = recg[i];
        }
        __syncthreads();
        if (tid < 32) cnt[tid] = 0;
        __syncthreads();
    }
}

constexpr int MOE_TST = 140416, MOE_CNT = MOE_TST + 256, MOE_TE = MOE_CNT + 128, MOE_TE_MAX = 640;
static_assert(MOE_TE + MOE_TE_MAX * 4 <= LDS_XB && 4 * T / 256 + NE <= MOE_TE_MAX, "lds");
DI void moe_tables(const Args& a, int l, LAS unsigned char* lds) {
    LAS int* tst = (LAS int*)(lds + MOE_TST); LAS int* cn = (LAS int*)(lds + MOE_CNT); LAS int* te = (LAS int*)(lds + MOE_TE);
    const int tid = otid();
    if (tid < NE) { const int* gcur = (const int*)(wso(kws(), WS_CTL) + CTL_GCUR) + (l * NE + tid) * 64; cn[tid] = __hip_atomic_load(gcur, __ATOMIC_RELAXED, __HIP_MEMORY_SCOPE_AGENT); }
    __syncthreads();
    if (tid == 0) { int s = 0; for (int e = 0; e < NE; ++e) { tst[e] = s; s += (cn[e] + 255) >> 8; } tst[NE] = s; }
    __syncthreads();
    if (tid < NE) { const int t1 = tst[tid + 1]; for (int rt = tst[tid]; rt < t1; ++rt) te[rt] = tid; }
    __syncthreads();
}

struct RowBIdx { u32x4 s; f32x4 g; };
struct RowBIn { unsigned y[4][4]; u32x2 x[4]; f32x4 g; };
DI RowBIdx rowB_idx(int row) { RowBIdx r; unsigned char* ws = kws(); r.s = *(const u32x4*)(wso(ws, WS_RSLOT) + (size_t)row * 16); r.g = *(const f32x4*)(wso(ws, WS_RGATE) + (size_t)row * 16); return r; }
DI RowBIn rowB_load(const RowBIdx& ix, int row, int lane, LAS int* tst) {
    RowBIn r; unsigned char* ws = kws();
#pragma unroll
    for (int k = 0; k < 4; ++k) {
        const unsigned s = ix.s[k]; const int e = (s >> 24) & 31, posn = s & 0xffffff; const size_t slot = (size_t)tst[e] * 256 + posn;
        const uint8_t* yp = (const uint8_t*)(wso(ws, WS_YR)) + slot * DM;
#pragma unroll
        for (int i = 0; i < 4; ++i) r.y[k][i] = *(const unsigned*)(yp + i * 256 + lane * 4);
    }
    { const bf16_t* xp = (const bf16_t*)(wso(ws, WS_XS)) + (size_t)row * DM;
#pragma unroll
      for (int i = 0; i < 4; ++i) r.x[i] = *(const u32x2*)(xp + i * 256 + lane * 4); }
    r.g = ix.g;
    return r;
}
DI void p_rowB(const Args& a, int l, LAS unsigned char* lds, bool dry = false) {
    const int tid = otid(), lane = tid & 63, w = __builtin_amdgcn_readfirstlane(tid >> 6);
    const bool last = (l == NL - 1);
    unsigned char* ws = kws();
    moe_tables(a, l, lds);
    LAS int* tst = (LAS int*)(lds + MOE_TST);
    const float* mod = (const float*)(wso(ws, WS_MOD)) + (size_t)l * 9 * 6144;
    const float* ng = kin(I_NORMG) + (size_t)l * 4 * DM;
    for (int chunk = obx(); chunk * ROWS_PER_BLK < T; chunk += gridDim.x) {
        const int row0 = chunk * ROWS_PER_BLK, b = row0 / SP;
        Row16 dA, dB, dC;
        const bool cctx = (row0 % SP) < NCTX;
        {   const float* mL = mod + (size_t)(cctx ? 8 : b) * 6144;
#pragma unroll
            for (int i = 0; i < 4; ++i) { const int o = i * 256 + lane * 4;
                dA.v[i] = *(const f32x4*)(mL + 5120 + o) * *(const f32x4*)(ng + 3 * DM + o);
                if (!last) { dB.v[i] = *(const f32x4*)(ng + 4 * DM + o) * (*(const f32x4*)(mL + 9 * 6144 + 1024 + o) + 1.0f); dC.v[i] = *(const f32x4*)(mL + 9 * 6144 + o); }
                else { dB.v[i] = (f32x4){0.f, 0.f, 0.f, 0.f}; dC.v[i] = dB.v[i]; } } }
        const int rend = row0 + ROWS_PER_BLK;
        int row = row0 + w;
#define RB_SKIP(r) do { while ((r) < rend && last && ((r) % SP) < NCTX) (r) += 8; } while (0)
        RB_SKIP(row);
        int row1 = row + 8; RB_SKIP(row1);
        int row2 = row1 + 8; RB_SKIP(row2);
        RowBIdx ix1, ix2; RowBIn cur, nxt;
        if (row < rend) { const RowBIdx ix0 = rowB_idx(row); cur = rowB_load(ix0, row, lane, tst); }
        if (row1 < rend) ix1 = rowB_idx(row1);
#pragma unroll 1
        while (row < rend) {
            if (row2 < rend) ix2 = rowB_idx(row2);
            if (row1 < rend) nxt = rowB_load(ix1, row1, lane, tst);
            const int pos = row - b * SP; const bool isctx = pos < NCTX;
            Row16 y;
#pragma unroll
            for (int i = 0; i < 4; ++i) y.v[i] = (f32x4){0.f, 0.f, 0.f, 0.f};
#pragma unroll
            for (int k = 0; k < 4; ++k) {
                const float g = cur.g[k] * (1.0f / S_Y8);
#pragma unroll
                for (int i = 0; i < 4; ++i) { const f32x2 lo = __builtin_amdgcn_cvt_pk_f32_fp8((int)cur.y[k][i], false), hi = __builtin_amdgcn_cvt_pk_f32_fp8((int)cur.y[k][i], true); y.v[i] = y.v[i] + (f32x4){lo.x, lo.y, hi.x, hi.y} * g; }
            }
            const float rstd = rsqrtf(row_ss(y) * (1.0f / DM) + opq(EPS));
            Row16 x, h;
#pragma unroll
            for (int i = 0; i < 4; ++i) x.v[i] = (f32x4){bflo(cur.x[i].x), bfhi(cur.x[i].x), bflo(cur.x[i].y), bfhi(cur.x[i].y)};
            if (isctx != cctx) {
                const float* m = mod + (size_t)(isctx ? 8 : b) * 6144;
#pragma unroll
                for (int i = 0; i < 4; ++i) { const f32x4 g3 = *(const f32x4*)(ng + 3 * DM + i * 256 + lane * 4), gf = *(const f32x4*)(m + 5120 + i * 256 + lane * 4);
                    x.v[i] = x.v[i] + gf * (y.v[i] * rstd * g3); }
                if (!last) { const float* m2 = m + 9 * 6144; h = modulate_row(x, ng + 4 * DM, m2, m2 + 1024, lane); }
            } else {
#pragma unroll
                for (int i = 0; i < 4; ++i) x.v[i] = x.v[i] + dA.v[i] * (y.v[i] * rstd);
                if (!last) { const float rs2 = rsqrtf(row_ss(x) * (1.0f / DM) + opq(EPS));
#pragma unroll
                    for (int i = 0; i < 4; ++i) h.v[i] = x.v[i] * rs2 * dB.v[i] + dC.v[i]; }
            }
            if (last) { st_f32row((dry ? (float*)(wso(ws, WS_ACT)) : kout()) + ((size_t)b * SEQ + (pos - NCTX)) * DM, lane, x); }
            else {
                st_bf16row((bf16_t*)(ws + (dry ? WS_ACT : WS_XS)) + (size_t)row * DM, lane, x);
                st_bf16row((bf16_t*)(ws + (dry ? WS_ACT + ((size_t)160 << 20) : WS_H)) + (size_t)row * DM, lane, h);
            }
            row = row1; row1 = row2; row2 = row2 + 8; RB_SKIP(row2);
            cur = nxt; ix1 = ix2;
        }
#undef RB_SKIP
    }
}

namespace gm {
constexpr int BK = 64, HALF = 128, HTB = HALF * BK * 2, NT = DM / BK;
DI int lds_byte(int r, int c) { const int st = (r >> 4) * 2 + (c >> 5), rr = r & 15, cc = c & 31, ob = rr * 64 + cc * 2; return st * 1024 + (ob ^ (((ob >> 9) & 1) << 5)); }
DI void stage_rc(int b, int& R, int& C) { const int st = b / 1024, sb = b % 1024, swz = sb ^ (((sb >> 9) & 1) << 5); R = (st >> 1) * 16 + swz / 64; C = (st & 1) * 32 + (swz % 64) / 2; }

DI int perm32(int rho) { const int n = rho >> 4, i = rho & 15; return 8 * (i >> 2) + 4 * n + (i & 3); }
typedef f32x4 Acc[2][2][4][2];

#define G_SA(b, h) (shm + ((b) * 2 + (h)) * HTB)
#define G_SB(b, h) (shm + (4 + (b) * 2 + (h)) * HTB)
#define G_STAGE(P, BASE, OFF, kt) do { _Pragma("unroll") for (int _i = 0; _i < 2; ++_i) \
    __builtin_amdgcn_global_load_lds((const unsigned*)((BASE) + (OFF)[_i] + (kt) * BK), (LAS unsigned*)((P) + wbase + _i * 8192), 16, 0, 0); } while (0)
#define G_LDA(dst, b, h) _Pragma("unroll") for (int m = 0; m < 4; ++m) _Pragma("unroll") for (int k = 0; k < 2; ++k) \
    dst[m][k] = *(LAS bf16x8*)(G_SA(b, h) + lds_byte(wr * 64 + m * 16 + fr, k * 32 + fq * 8))
#define G_LDB(dst, b, h) _Pragma("unroll") for (int n = 0; n < 2; ++n) _Pragma("unroll") for (int k = 0; k < 2; ++k) \
    dst[n][k] = *(LAS bf16x8*)(G_SB(b, h) + lds_byte(wc * 32 + n * 16 + fr, k * 32 + fq * 8))
#define G_MMA(ai, bj, At, Bx) do { __builtin_amdgcn_s_setprio(1); \
    _Pragma("unroll") for (int m = 0; m < 4; ++m) _Pragma("unroll") for (int n = 0; n < 2; ++n) _Pragma("unroll") for (int k = 0; k < 2; ++k) \
      acc[ai][bj][m][n] = __builtin_amdgcn_mfma_f32_16x16x32_bf16(Bx[n][k], At[m][k], acc[ai][bj][m][n], 0, 0, 0); \
    __builtin_amdgcn_s_setprio(0); } while (0)
#define G_WAITV(n) asm volatile("s_waitcnt vmcnt(" #n ")" ::: "memory")
#define G_WAITL(n) asm volatile("s_waitcnt lgkmcnt(" #n ")" ::: "memory")
#define G_BAR __builtin_amdgcn_s_barrier()
#define G_SCHED __builtin_amdgcn_sched_barrier(0)

struct UnitSrc { const bf16_t* A; const bf16_t* Bt; const float* bias; unsigned aoff[2][2]; };
#define G_STA(b, h, kt) do { _Pragma("unroll") for (int _i = 0; _i < 2; ++_i) \
    __builtin_amdgcn_global_load_lds((const unsigned*)(u.A + (GATHER ? u.aoff[h][_i] : (unsigned)((h) * HALF * DM) + toff[_i]) + (kt) * BK), (LAS unsigned*)(G_SA(b, h) + wbase + _i * 8192), 16, 0, 0); } while (0)
#define G_STB(b, h, kt) do { _Pragma("unroll") for (int _i = 0; _i < 2; ++_i) \
    __builtin_amdgcn_global_load_lds((const unsigned*)(u.Bt + (unsigned)((h) * HALF * DM) + tofb[_i] + (kt) * BK), (LAS unsigned*)(G_SB(b, h) + wbase + _i * 8192), 16, 0, 0); } while (0)
template <bool GATHER>
DI void gemm_head(LAS unsigned char* shm, const UnitSrc& u) {
    const int tid = otid(), wbase = __builtin_amdgcn_readfirstlane(tid >> 6) * 1024;
    unsigned toff[2], tofb[2]; { int r_, c_; stage_rc(tid * 16, r_, c_); toff[0] = r_ * DM + c_; tofb[0] = ((r_ & ~31) | perm32(r_ & 31)) * DM + c_; stage_rc(tid * 16 + 8192, r_, c_); toff[1] = r_ * DM + c_; tofb[1] = ((r_ & ~31) | perm32(r_ & 31)) * DM + c_; }
    G_STB(0, 0, 0); G_STA(0, 0, 0); G_STB(0, 1, 0); G_STA(0, 1, 0);
    G_STB(1, 0, 1); G_STA(1, 0, 1); G_STB(1, 1, 1);
}
template <bool GATHER>
DI void gemm_mainloop(LAS unsigned char* shm, const UnitSrc& u, Acc& acc) {
    const int tid = otid(), wbase = __builtin_amdgcn_readfirstlane(tid >> 6) * 1024;
    unsigned toff[2], tofb[2]; { int r_, c_; stage_rc(tid * 16, r_, c_); toff[0] = r_ * DM + c_; tofb[0] = ((r_ & ~31) | perm32(r_ & 31)) * DM + c_; stage_rc(tid * 16 + 8192, r_, c_); toff[1] = r_ * DM + c_; tofb[1] = ((r_ & ~31) | perm32(r_ & 31)) * DM + c_; }
    int wid = tid >> 6, lane = tid & 63, wr = wid >> 2, wc = wid & 3, fr = lane & 15, fq = lane >> 4;
    {   f32x4 bv[2][2];
#pragma unroll
        for (int i1 = 0; i1 < 2; ++i1)
#pragma unroll
            for (int i3 = 0; i3 < 2; ++i3) bv[i1][i3] = u.bias ? *(const f32x4*)(u.bias + i1 * 128 + wc * 32 + fq * 8 + i3 * 4) : (f32x4){0.f, 0.f, 0.f, 0.f};
#pragma unroll
        for (int i0 = 0; i0 < 2; ++i0)
#pragma unroll
            for (int i1 = 0; i1 < 2; ++i1)
#pragma unroll
                for (int i2 = 0; i2 < 4; ++i2)
#pragma unroll
                    for (int i3 = 0; i3 < 2; ++i3) acc[i0][i1][i2][i3] = bv[i1][i3];
    }
    bf16x8 At[4][2], B0[2][2], B1[2][2];
    G_WAITV(0);
    if (wr == 1) G_BAR;
    G_BAR; G_BAR;
#pragma unroll 1
    for (int t = 0; t < NT - 2; t += 2) {
        G_LDB(B0, 0, 0); G_SCHED; G_LDA(At, 0, 0); G_STA(1, 1, t + 1);
        G_WAITL(8); G_BAR; G_WAITL(0); G_MMA(0, 0, At, B0); G_BAR; G_SCHED;
        G_LDB(B1, 0, 1); G_STB(0, 0, t + 2);
        G_BAR; G_WAITL(0); G_MMA(0, 1, At, B1); G_BAR;
        G_LDA(At, 0, 1); G_STA(0, 0, t + 2);
        G_BAR; G_WAITL(0); G_MMA(1, 0, At, B0); G_BAR; G_SCHED;
        G_STB(0, 1, t + 2);
        G_WAITV(6); G_BAR; G_MMA(1, 1, At, B1); G_BAR;
        G_LDB(B0, 1, 0); G_SCHED; G_LDA(At, 1, 0); G_STA(0, 1, t + 2);
        G_WAITL(8); G_BAR; G_WAITL(0); G_MMA(0, 0, At, B0); G_BAR; G_SCHED;
        G_LDB(B1, 1, 1); G_STB(1, 0, t + 3);
        G_BAR; G_WAITL(0); G_MMA(0, 1, At, B1); G_BAR;
        G_LDA(At, 1, 1); G_STA(1, 0, t + 3);
        G_BAR; G_WAITL(0); G_MMA(1, 0, At, B0); G_BAR; G_SCHED;
        G_STB(1, 1, t + 3);
        G_WAITV(6); G_BAR; G_MMA(1, 1, At, B1); G_BAR;
    }
    { G_LDB(B0, 0, 0); G_WAITV(0); G_LDA(At, 0, 0); G_STA(1, 1, NT - 1);
      G_BAR; G_WAITL(0); G_MMA(0, 0, At, B0); G_BAR;
      G_LDB(B1, 0, 1); G_BAR; G_WAITL(0); G_MMA(0, 1, At, B1); G_BAR;
      G_LDA(At, 0, 1); G_WAITV(4); G_BAR; G_WAITL(0); G_MMA(1, 0, At, B0); G_MMA(1, 1, At, B1); G_BAR; }
    { G_LDB(B0, 1, 0); G_LDA(At, 1, 0); G_WAITV(2); G_BAR; G_WAITL(0); G_MMA(0, 0, At, B0); G_BAR;
      G_LDB(B1, 1, 1); G_WAITV(0); G_BAR; G_WAITL(0); G_MMA(0, 1, At, B1); G_BAR;
      G_LDA(At, 1, 1); G_BAR; G_WAITL(0); G_MMA(1, 0, At, B0); G_MMA(1, 1, At, B1); G_BAR; }
    if (wr == 0) G_BAR;
}
typedef int v8i32 __attribute__((ext_vector_type(8)));
struct UnitSrc8 { const uint8_t* A; const uint8_t* Bt; const float* bias; float bscale; unsigned aoff[2][2]; };
constexpr int NT8 = DM / 128;
#define G_STA8(b, h, kt) do { _Pragma("unroll") for (int _i = 0; _i < 2; ++_i) \
    __builtin_amdgcn_global_load_lds((const unsigned*)(u.A + (GATHER ? u.aoff[h][_i] : (unsigned)((h) * HALF * DM) + toff[_i]) + (kt) * 128), (LAS unsigned*)(G_SA(b, h) + wbase + _i * 8192), 16, 0, 0); } while (0)
#define G_STB8(b, h, kt) do { _Pragma("unroll") for (int _i = 0; _i < 2; ++_i) \
    __builtin_amdgcn_global_load_lds((const unsigned*)(u.Bt + (unsigned)((h) * HALF * DM) + tofb[_i] + (kt) * 128), (LAS unsigned*)(G_SB(b, h) + wbase + _i * 8192), 16, 0, 0); } while (0)
DI v8i32 cat8(u32x4 a, u32x4 b) { v8i32 r; r[0] = a.x; r[1] = a.y; r[2] = a.z; r[3] = a.w; r[4] = b.x; r[5] = b.y; r[6] = b.z; r[7] = b.w; return r; }
#define G_LDA8(dst, b, h) _Pragma("unroll") for (int m = 0; m < 4; ++m) \
    dst[m] = cat8(*(LAS u32x4*)(G_SA(b, h) + lds_byte(wr * 64 + m * 16 + fr, 8 * fq)), *(LAS u32x4*)(G_SA(b, h) + lds_byte(wr * 64 + m * 16 + fr, 32 + 8 * fq)))
#define G_LDB8(dst, b, h) _Pragma("unroll") for (int n = 0; n < 2; ++n) \
    dst[n] = cat8(*(LAS u32x4*)(G_SB(b, h) + lds_byte(wc * 32 + n * 16 + fr, 8 * fq)), *(LAS u32x4*)(G_SB(b, h) + lds_byte(wc * 32 + n * 16 + fr, 32 + 8 * fq)))
#define G_MMA8(ai, bj, At, Bx) do { __builtin_amdgcn_s_setprio(1); \
    _Pragma("unroll") for (int m = 0; m < 4; ++m) _Pragma("unroll") for (int n = 0; n < 2; ++n) \
      asm volatile("v_mfma_scale_f32_16x16x128_f8f6f4 %0, %1, %2, %0, %3, %3 op_sel_hi:[0,0,0]" : "+v"(acc[ai][bj][m][n]) : "v"(Bx[n]), "v"(At[m]), "v"(one8)); \
    __builtin_amdgcn_s_setprio(0); } while (0)
template <bool GATHER>
DI void gemm_head8(LAS unsigned char* shm, const UnitSrc8& u) {
    const int tid = otid(), wbase = __builtin_amdgcn_readfirstlane(tid >> 6) * 1024;
    unsigned toff[2], tofb[2]; { int r_, c_; stage_rc(tid * 16, r_, c_); toff[0] = r_ * DM + 2 * c_; tofb[0] = ((r_ & ~31) | perm32(r_ & 31)) * DM + 2 * c_; stage_rc(tid * 16 + 8192, r_, c_); toff[1] = r_ * DM + 2 * c_; tofb[1] = ((r_ & ~31) | perm32(r_ & 31)) * DM + 2 * c_; }
    G_STB8(0, 0, 0); G_STA8(0, 0, 0); G_STB8(0, 1, 0); G_STA8(0, 1, 0);
    G_STB8(1, 0, 1); G_STA8(1, 0, 1); G_STB8(1, 1, 1);
}
constexpr int G_BIAS8 = 139264;
template <bool GATHER>
DI void gemm_mainloop8(LAS unsigned char* shm, const UnitSrc8& u, Acc& acc) {
    const int tid = otid(), wbase = __builtin_amdgcn_readfirstlane(tid >> 6) * 1024;
    unsigned toff[2], tofb[2]; { int r_, c_; stage_rc(tid * 16, r_, c_); toff[0] = r_ * DM + 2 * c_; tofb[0] = ((r_ & ~31) | perm32(r_ & 31)) * DM + 2 * c_; stage_rc(tid * 16 + 8192, r_, c_); toff[1] = r_ * DM + 2 * c_; tofb[1] = ((r_ & ~31) | perm32(r_ & 31)) * DM + 2 * c_; }
    int wid = tid >> 6, lane = tid & 63, wr = wid >> 2, wc = wid & 3, fr = lane & 15, fq = lane >> 4;
    v8i32 At[4], B0[2], B1[2];
    int one8 = 0x7F7F7F7F; asm volatile("" : "+v"(one8));
    G_WAITV(0);
    if (wr == 1) G_BAR;
    G_BAR;
    {   f32x4 bv[2][2];
#pragma unroll
        for (int i1 = 0; i1 < 2; ++i1)
#pragma unroll
            for (int i3 = 0; i3 < 2; ++i3) bv[i1][i3] = *(LAS f32x4*)(shm + G_BIAS8 + (i1 * 128 + wc * 32 + fq * 8 + i3 * 4) * 4);
#pragma unroll
        for (int i0 = 0; i0 < 2; ++i0)
#pragma unroll
            for (int i1 = 0; i1 < 2; ++i1)
#pragma unroll
                for (int i2 = 0; i2 < 4; ++i2)
#pragma unroll
                    for (int i3 = 0; i3 < 2; ++i3) acc[i0][i1][i2][i3] = bv[i1][i3];
    }
    G_BAR;
#pragma unroll 1
    for (int t = 0; t < NT8 - 2; t += 2) {
        G_LDB8(B0, 0, 0); G_SCHED; G_LDA8(At, 0, 0); G_STA8(1, 1, t + 1);
        G_WAITL(8); G_BAR; G_WAITL(0); G_MMA8(0, 0, At, B0); G_BAR; G_SCHED;
        G_LDB8(B1, 0, 1); G_STB8(0, 0, t + 2);
        G_BAR; G_WAITL(0); G_MMA8(0, 1, At, B1); G_BAR;
        G_LDA8(At, 0, 1); G_STA8(0, 0, t + 2);
        G_BAR; G_WAITL(0); G_MMA8(1, 0, At, B0); G_BAR; G_SCHED;
        G_STB8(0, 1, t + 2);
        G_WAITV(6); G_BAR; G_MMA8(1, 1, At, B1); G_BAR;
        G_LDB8(B0, 1, 0); G_SCHED; G_LDA8(At, 1, 0); G_STA8(0, 1, t + 2);
        G_WAITL(8); G_BAR; G_WAITL(0); G_MMA8(0, 0, At, B0); G_BAR; G_SCHED;
        G_LDB8(B1, 1, 1); G_STB8(1, 0, t + 3);
        G_BAR; G_WAITL(0); G_MMA8(0, 1, At, B1); G_BAR;
        G_LDA8(At, 1, 1); G_STA8(1, 0, t + 3);
        G_BAR; G_WAITL(0); G_MMA8(1, 0, At, B0); G_BAR; G_SCHED;
        G_STB8(1, 1, t + 3);
        G_WAITV(6); G_BAR; G_MMA8(1, 1, At, B1); G_BAR;
    }
    { G_LDB8(B0, 0, 0); G_WAITV(0); G_LDA8(At, 0, 0); G_STA8(1, 1, NT8 - 1);
      G_BAR; G_WAITL(0); G_MMA8(0, 0, At, B0); G_BAR;
      G_LDB8(B1, 0, 1); G_BAR; G_WAITL(0); G_MMA8(0, 1, At, B1); G_BAR;
      G_LDA8(At, 0, 1); G_WAITV(4); G_BAR; G_WAITL(0); G_MMA8(1, 0, At, B0); G_MMA8(1, 1, At, B1); G_BAR; }
    { G_LDB8(B0, 1, 0); G_LDA8(At, 1, 0); G_WAITV(2); G_BAR; G_WAITL(0); G_MMA8(0, 0, At, B0); G_BAR;
      G_LDB8(B1, 1, 1); G_WAITV(0); G_BAR; G_WAITL(0); G_MMA8(0, 1, At, B1); G_BAR;
      G_LDA8(At, 1, 1); G_BAR; G_WAITL(0); G_MMA8(1, 0, At, B0); G_MMA8(1, 1, At, B1); G_BAR; }
    if (wr == 0) G_BAR;
}
#define G_EPI(epi, acc) do { const int tz_ = otid(); (epi)((acc), tz_ >> 8, (tz_ >> 6) & 3, tz_ & 15, (tz_ & 63) >> 4); } while (0)
DI int launder_s(int v) { asm volatile("" : "+s"(v)); return v; }

struct EpiBf16 {
    bf16_t* O; int ldo; int rbase, cbase; float scale;
    DI void operator()(const Acc& acc, int wr, int wc, int fr, int fq) const {
#pragma unroll
        for (int ai = 0; ai < 2; ++ai)
#pragma unroll
            for (int m = 0; m < 4; ++m) {
                bf16_t* rp = O + (size_t)(rbase + ai * 128 + wr * 64 + m * 16 + fr) * ldo + cbase + wc * 32 + fq * 8;
#pragma unroll
                for (int bj = 0; bj < 2; ++bj) {
                    const f32x4 v0 = acc[ai][bj][m][0] * scale, v1 = acc[ai][bj][m][1] * scale;
                    u32x4 o; o.x = pk2(v0[0], v0[1]); o.y = pk2(v0[2], v0[3]); o.z = pk2(v1[0], v1[1]); o.w = pk2(v1[2], v1[3]);
                    *(u32x4*)(rp + bj * 128) = o;
                }
            }
    }
};
struct EpiFp8 {
    uint8_t* O; int ldo; int rbase, cbase; float scale;
    DI void operator()(const Acc& acc, int wr, int wc, int fr, int fq) const {
#pragma unroll
        for (int ai = 0; ai < 2; ++ai)
#pragma unroll
            for (int m = 0; m < 4; ++m) {
                uint8_t* rp = O + (size_t)(rbase + ai * 128 + wr * 64 + m * 16 + fr) * ldo + cbase + wc * 32 + fq * 8;
#pragma unroll
                for (int bj = 0; bj < 2; ++bj) {
                    const f32x4 v0 = acc[ai][bj][m][0] * scale, v1 = acc[ai][bj][m][1] * scale;
                    const float lim = opq_s(448.0f);
#define SAT_(x) __builtin_amdgcn_fmed3f((x), -lim, lim)
                    u32x2 o; o.x = pk4_fp8(SAT_(v0[0]), SAT_(v0[1]), SAT_(v0[2]), SAT_(v0[3])); o.y = pk4_fp8(SAT_(v1[0]), SAT_(v1[1]), SAT_(v1[2]), SAT_(v1[3]));
#undef SAT_
                    *(u32x2*)(rp + bj * 128) = o;
                }
            }
    }
};
struct EpiSwiglu8 {
    uint8_t* O; int rbase, cbase;
    DI void operator()(const Acc& acc, int wr, int wc, int fr, int fq) const {
#pragma unroll
        for (int ai = 0; ai < 2; ++ai)
#pragma unroll
            for (int m = 0; m < 4; ++m) {
                uint8_t* rp = O + (size_t)(rbase + ai * 128 + wr * 64 + m * 16 + fr) * DM + ((cbase + wc * 32 + fq * 8) >> 1);
#pragma unroll
                for (int bj = 0; bj < 2; ++bj) {
                    float av[4];
#pragma unroll
                    for (int n = 0; n < 2; ++n) {
                        const f32x4 z = acc[ai][bj][m][n] * (1.0f / (S_H8 * S_W8));
                        const float c7 = opq_s(7.0f);
                        const float g0 = __builtin_fminf(z[0], c7), l0 = __builtin_amdgcn_fmed3f(z[1], -c7, c7), g1 = __builtin_fminf(z[2], c7), l1 = __builtin_amdgcn_fmed3f(z[3], -c7, c7);
                        av[2 * n] = g0 * __builtin_amdgcn_rcpf(1.0f + __builtin_amdgcn_exp2f(-1.702f * LOG2E * g0)) * __builtin_fmaf(l0, S_A8, S_A8);
                        av[2 * n + 1] = g1 * __builtin_amdgcn_rcpf(1.0f + __builtin_amdgcn_exp2f(-1.702f * LOG2E * g1)) * __builtin_fmaf(l1, S_A8, S_A8);
                    }
                    *(unsigned*)(rp + bj * 64) = pk4_fp8(av[0], av[1], av[2], av[3]);
                }
            }
    }
};
}

template <int WHICH>
DI void dense_unit(int u, bool skipctx, int& pm, int& pn) {
    constexpr int N = WHICH == 0 ? NG1 : DM, nN = N / 256;
    const int nM = skipctx ? NB * 16 : T / 256;
    const int grp = u / (8 * nN), rem = u - grp * 8 * nN, gsz = (nM - grp * 8) < 8 ? (nM - grp * 8) : 8;
    pm = grp * 8 + rem % gsz; pn = rem / gsz;
    if (skipctx) pm += pm / 16 + 1;
}
template <int WHICH>
DI void dense_src(int l, int u, bool skipctx, gm::UnitSrc& s) {
    constexpr int N = WHICH == 0 ? NG1 : DM, NROW = WHICH == 0 ? NP : DM;
    int pm, pn; dense_unit<WHICH>(u, skipctx, pm, pn);
    unsigned char* ws = kws();
    s.A = (const bf16_t*)(ws + (WHICH == 0 ? WS_H : WS_YC)) + (size_t)pm * 256 * DM;
    s.Bt = (const bf16_t*)(ws + (WHICH == 0 ? WS_WIN : WS_WOUT)) + ((size_t)l * NROW + pn * 256) * DM; s.bias = nullptr;
}
template <int WHICH>
DI void p_gemm_dense(int l, LAS unsigned char* lds) {
    constexpr int N = WHICH == 0 ? NG1 : DM, LDO = WHICH == 0 ? NP : DM, nN = N / 256;
    const bool skipctx = (WHICH == 1) && (l == NL - 1);
    const int nU = (skipctx ? NB * 16 : T / 256) * nN, G = gridDim.x;
    int u = obx();
    gm::UnitSrc cur{};
    if (u < nU) { dense_src<WHICH>(l, u, skipctx, cur); gm::gemm_head<false>(lds, cur); }
#pragma unroll 1
    while (u < nU) {
        gm::Acc acc;
        gm::gemm_mainloop<false>(lds, cur, acc);
        const int un = u + G;
        if (un < nU) { dense_src<WHICH>(l, un, skipctx, cur); gm::gemm_head<false>(lds, cur); }
        {   const int u2 = gm::launder_s(u); int pm, pn; dense_unit<WHICH>(u2, skipctx, pm, pn);
            const bool qtile = WHICH == 0 && (pn == C_RQ / 256 || pn == C_DQ / 256 || pn == C_GQ / 256);
            const size_t obase = WHICH == 1 ? WS_YO : !qtile ? WS_P : pn == C_RQ / 256 ? WS_QRET : pn == C_DQ / 256 ? WS_QD : WS_QG;
            gm::EpiBf16 epi{(bf16_t*)(kws() + obase), qtile ? 256 : LDO, pm * 256, qtile ? 0 : pn * 256, 1.0f};
            G_EPI(epi, acc);
        }
        u = un;
    }
    __syncthreads();
}

template <int WHICH> DI bool moe_unit(int u, int ntiles, int& rt, int& pn) {
    const int x = u & 7, v = u >> 3;
    if (WHICH == 1) { pn = 4 * (x & 1) + (v & 3); rt = 4 * (v >> 2) + (x >> 1); }
    else { pn = v & 3; rt = 8 * (v >> 2) + x; }
    return rt < ntiles;
}
template <int WHICH>
DI void moe_ptrs(int l, int rt, int pn, LAS unsigned char* lds, gm::UnitSrc8& s) {
    LAS int* te = (LAS int*)(lds + MOE_TE);
    const int e = te[rt];
    unsigned char* ws = kws();
    if (WHICH == 1) { s.A = (const uint8_t*)(wso(ws, WS_H8)); s.Bt = (const uint8_t*)(wso(ws, WS_W1)) + (((size_t)l * NE + e) * DFF2 + pn * 256) * DM; s.bias = kin(I_EB1) + ((size_t)l * NE + e) * DFF2 + pn * 256; s.bscale = S_H8 * S_W8; }
    else { s.A = (const uint8_t*)(wso(ws, WS_ACT)) + (size_t)rt * 256 * DM; s.Bt = (const uint8_t*)(wso(ws, WS_W2)) + (((size_t)l * NE + e) * DM + pn * 256) * DM; s.bias = kin(I_EB2) + ((size_t)l * NE + e) * DM + pn * 256; s.bscale = S_A8 * S_W8; }
}
DI u32x4 moe_gather(int rt, LAS unsigned char* lds) {
    LAS int* tst = (LAS int*)(lds + MOE_TST); LAS int* cn = (LAS int*)(lds + MOE_CNT); LAS int* te = (LAS int*)(lds + MOE_TE);
    const int e = te[rt], tz = otid();
    int r_[2], c_[2]; gm::stage_rc(tz * 16, r_[0], c_[0]); gm::stage_rc(tz * 16 + 8192, r_[1], c_[1]);
    const int* list = (const int*)(wso(kws(), WS_LIST)) + (size_t)e * T; const int c = cn[e], p0 = (rt - tst[e]) * 256;
    u32x4 o;
    { const int p = p0 + r_[0]; o.x = (unsigned)list[p < c ? p : 0]; }
    { const int p = p0 + r_[1]; o.y = (unsigned)list[p < c ? p : 0]; }
    { const int p = p0 + 128 + r_[0]; o.z = (unsigned)list[p < c ? p : 0]; }
    { const int p = p0 + 128 + r_[1]; o.w = (unsigned)list[p < c ? p : 0]; }
    return o;
}
DI u32x4 moe_gather_fix(u32x4 raw) {
    const int tz = otid(); int r_[2], c_[2]; gm::stage_rc(tz * 16, r_[0], c_[0]); gm::stage_rc(tz * 16 + 8192, r_[1], c_[1]);
    u32x4 o; o.x = raw.x * DM + 2 * c_[0]; o.y = raw.y * DM + 2 * c_[1]; o.z = raw.z * DM + 2 * c_[0]; o.w = raw.w * DM + 2 * c_[1];
    return o;
}
template <int WHICH>
DI void p_gemm_moe(const Args& a, int l, LAS unsigned char* lds) {
    moe_tables(a, l, lds);
    LAS int* tst = (LAS int*)(lds + MOE_TST);
    const int tid = otid();
    LAS u32x4* aslot = (LAS u32x4*)(lds + 131072) + tid;
    LAS f32x4* bslot = (LAS f32x4*)(lds + gm::G_BIAS8) + (tid & 63);
    const int ntiles = tst[NE], nU = WHICH == 1 ? ((ntiles + 3) >> 2) * 32 : ((ntiles + 7) >> 3) * 32, G = gridDim.x;
    int u = obx(), rt = 0, pn = 0;
    while (u < nU && !moe_unit<WHICH>(u, ntiles, rt, pn)) u += G;
    int un = u + G, rtn = 0, pnn = 0;
    while (un < nU && !moe_unit<WHICH>(un, ntiles, rtn, pnn)) un += G;
    gm::UnitSrc8 cur{};
    if (u < nU) {
        moe_ptrs<WHICH>(l, rt, pn, lds, cur);
        if (WHICH == 1) { const u32x4 g = moe_gather_fix(moe_gather(rt, lds)); cur.aoff[0][0] = g.x; cur.aoff[0][1] = g.y; cur.aoff[1][0] = g.z; cur.aoff[1][1] = g.w; }
        gm::gemm_head8<(WHICH == 1)>(lds, cur);
        if (tid < 64) *bslot = *(const f32x4*)(cur.bias + tid * 4) * cur.bscale;
        if (WHICH == 1 && un < nU) *aslot = moe_gather_fix(moe_gather(rtn, lds));
    }
#pragma unroll 1
    while (u < nU) {
        gm::Acc acc;
        gm::gemm_mainloop8<(WHICH == 1)>(lds, cur, acc);
        int unn = un + G, rtnn = 0, pnnn = 0;
        while (unn < nU && !moe_unit<WHICH>(unn, ntiles, rtnn, pnnn)) unn += G;
        u32x4 gnn = {0u, 0u, 0u, 0u}; f32x4 bn = {0.f, 0.f, 0.f, 0.f};
        if (un < nU) {
            moe_ptrs<WHICH>(l, rtn, pnn, lds, cur);
            if (WHICH == 1) { const u32x4 g = *((LAS u32x4*)(lds + 131072) + otid()); cur.aoff[0][0] = g.x; cur.aoff[0][1] = g.y; cur.aoff[1][0] = g.z; cur.aoff[1][1] = g.w; }
            gm::gemm_head8<(WHICH == 1)>(lds, cur);
            { const int t2 = otid(); if (t2 < 64) bn = *(const f32x4*)(cur.bias + t2 * 4); }
            if (WHICH == 1 && unn < nU) gnn = moe_gather(rtnn, lds);
        }
        __builtin_amdgcn_sched_barrier(0);
        {   const int u2 = gm::launder_s(u); int rt2, pn2; moe_unit<WHICH>(u2, ntiles, rt2, pn2);
            if (WHICH == 1) { gm::EpiSwiglu8 epi{(uint8_t*)(wso(kws(), WS_ACT)), rt2 * 256, pn2 * 256}; G_EPI(epi, acc); }
            else { gm::EpiFp8 epi{(uint8_t*)(wso(kws(), WS_YR)), DM, rt2 * 256, pn2 * 256, S_Y8 / (S_A8 * S_W8)}; G_EPI(epi, acc); }
        }
        __builtin_amdgcn_sched_barrier(0);
        { const int t2 = otid(); if (un < nU && t2 < 64) *((LAS f32x4*)(lds + gm::G_BIAS8) + t2) = bn * cur.bscale;
          if (WHICH == 1 && unn < nU) *((LAS u32x4*)(lds + 131072) + t2) = moe_gather_fix(gnn); }
        u = un; un = unn; rtn = rtnn; pnn = pnnn;
    }
    __syncthreads();
}


struct PrepRaw { u32x2 d4[4]; };
DI void un4(const u32x2& u, float (&o)[4]) { o[0] = bflo(u.x); o[1] = bfhi(u.x); o[2] = bflo(u.y); o[3] = bfhi(u.y); }
DI void un8(const u32x4& u, float (&o)[8]) { o[0] = bflo(u.x); o[1] = bfhi(u.x); o[2] = bflo(u.y); o[3] = bfhi(u.y); o[4] = bflo(u.z); o[5] = bfhi(u.z); o[6] = bflo(u.w); o[7] = bfhi(u.w); }
DI int prep_src64(int hl) { return hl < 4 ? C_RK + hl * 64 : hl < 6 ? C_GK + (hl - 4) * 64 : 0; }
DI int prep_src32(int ml) { return ml < 8 ? C_DK + ml * 32 : ml < 12 ? C_MQE + (ml - 8) * 96 + 64 : ml < 13 ? C_MKR : 0; }
DI PrepRaw prep_load(int row, int lane) {
    PrepRaw r; const bf16_t* P = (const bf16_t*)(wso(kws(), WS_P)) + (size_t)row * NP;
    { const int src = prep_src64(lane >> 3), aa = lane & 7; r.d4[0] = *(const u32x2*)(P + src + 4 * aa); r.d4[1] = *(const u32x2*)(P + src + 32 + 4 * aa); }
    { const int src = prep_src32(lane >> 2), aa = lane & 3; r.d4[2] = *(const u32x2*)(P + src + 4 * aa); r.d4[3] = *(const u32x2*)(P + src + 16 + 4 * aa); }
    return r;
}
constexpr int MU_PITCH = 656, MU_ROWS = 144;
constexpr int MU_RS = MU_ROWS * MU_PITCH;
static_assert(MU_RS + MU_ROWS * 8 <= 102400, "lds");
constexpr int PREP_TAB = 102400, PREP_R32 = PREP_TAB + 8192, PREP_QN = PREP_R32 + 4096;
DI void prep_compute(int row, int rloc, int lane, const PrepRaw& raw, LAS unsigned char* lds) {
    unsigned char* ws = kws();
    const int b = row / SP, pos = row - b * SP; const bool lat = pos >= NCTX;
    const int s = lat ? pos - NCTX : 0, gr = s >> 6, gc = s & 63;
    LAS f32x2* r64 = (LAS f32x2*)(lds + PREP_TAB); LAS f32x2* r32 = (LAS f32x2*)(lds + PREP_R32); LAS float* qnl = (LAS float*)(lds + PREP_QN);
    const float rqs = ((LAS float*)(lds + MU_RS))[rloc * 2];
    {
        const int hl = lane >> 3, aa = lane & 7;
        const bool act = hl < 6;
        bf16_t* dst = nullptr; float scale = 1.0f; int nrm = -1;
        if (hl < 4) { dst = (bf16_t*)(wso(ws, WS_KRET)) + (size_t)row * 256 + hl * 64; scale = 0.125f; }
        else if (hl < 6) { dst = (bf16_t*)(wso(ws, WS_KG)) + (size_t)row * 128 + (hl - 4) * 64; nrm = 1; }
        float x1[4], x2[4]; un4(raw.d4[0], x1); un4(raw.d4[1], x2);
        float ss = 0.f;
#pragma unroll
        for (int j = 0; j < 4; ++j) ss += x1[j] * x1[j] + x2[j] * x2[j];
        ss += __shfl_xor(ss, 1); ss += __shfl_xor(ss, 2); ss += __shfl_xor(ss, 4);
        if (nrm >= 0) {
            const float rs = rsqrtf(ss * (1.0f / 64.0f) + opq(EPS)); LAS float* qn = qnl + nrm * 64;
#pragma unroll
            for (int j = 0; j < 4; ++j) { x1[j] *= rs * qn[4 * aa + j]; x2[j] *= rs * qn[32 + 4 * aa + j]; }
        }
        if (lat) {
            LAS f32x2* tb = r64 + (aa < 4 ? gr : gc) * 16 + ((4 * aa) & 15);
#pragma unroll
            for (int j = 0; j < 4; ++j) { const f32x2 cs = tb[j]; const float y1 = x1[j] * cs.x - x2[j] * cs.y, y2 = x1[j] * cs.y + x2[j] * cs.x; x1[j] = y1; x2[j] = y2; }
        }
#pragma unroll
        for (int j = 0; j < 4; ++j) { x1[j] *= scale; x2[j] *= scale; }
        if (act) { st4(dst + 4 * aa, x1); st4(dst + 32 + 4 * aa, x2); }
    }
    {
        const int ml = lane >> 2, aa = lane & 3;
        const bool act = ml < 13;
        float scale = 1.0f;
        if (ml >= 8 && ml < 12) scale = rqs;
        float x1[4], x2[4]; un4(raw.d4[2], x1); un4(raw.d4[3], x2);
        if (lat) {
            LAS f32x2* tb = r32 + (aa < 2 ? gr : gc) * 8 + ((4 * aa) & 7);
#pragma unroll
            for (int j = 0; j < 4; ++j) { const f32x2 cs = tb[j]; const float y1 = x1[j] * cs.x - x2[j] * cs.y, y2 = x1[j] * cs.y + x2[j] * cs.x; x1[j] = y1; x2[j] = y2; }
        }
#pragma unroll
        for (int j = 0; j < 4; ++j) { x1[j] *= scale; x2[j] *= scale; }
        if (act) {
            if (ml < 8) { bf16_t* d = (bf16_t*)(wso(ws, WS_KD)) + (size_t)row * 256 + ml * 32; st4(d + 4 * aa, x1); st4(d + 16 + 4 * aa, x2); }
            else if (ml < 12) { bf16_t* d = (bf16_t*)(wso(ws, WS_QM)) + (size_t)row * 384 + (ml - 8) * 96 + 64; st4(d + 4 * aa, x1); st4(d + 16 + 4 * aa, x2); }
            else { bf16_t* d = (bf16_t*)(wso(ws, WS_KM)) + (size_t)row * 384 + 64;
#pragma unroll
                for (int hh = 0; hh < 4; ++hh) { st4(d + hh * 96 + 4 * aa, x1); st4(d + hh * 96 + 16 + 4 * aa, x2); } }
        }
    }
}

DI void st8l(LAS unsigned char* p, const float (&v)[8]) { u32x4 u; u.x = pk2(v[0], v[1]); u.y = pk2(v[2], v[3]); u.z = pk2(v[4], v[5]); u.w = pk2(v[6], v[7]); *(LAS u32x4*)p = u; }
constexpr int R1_V = 0, R1_KF = 32768, R1_KB = 65536;
DI void r1_item(const Args& a, int l, int item, LAS unsigned char* lds) {
    const int tid = otid(), lane = tid & 63, w = __builtin_amdgcn_readfirstlane(tid >> 6);
    unsigned char* ws = kws();
    const int hd = item & 3, cj = (item >> 2) % NCHUNK, b = (item >> 2) / NCHUNK;
    const int row0 = b * SP + cj * 256;
    const float lgf = -__expf(kin(I_RLD)[l * 8 + hd]) * LOG2E, lgb = -__expf(kin(I_RLD)[l * 8 + 4 + hd]) * LOG2E;
    {
        const int m = tid >> 1, half = tid & 1;
        const bf16_t* P = (const bf16_t*)(wso(ws, WS_P)) + (size_t)(row0 + m) * NP;
        float x1[16], x2[16];
        { float t[8];
          ld8(P + C_RK + hd * 64 + 16 * half, t);
#pragma unroll
          for (int j = 0; j < 8; ++j) x1[j] = t[j];
          ld8(P + C_RK + hd * 64 + 16 * half + 8, t);
#pragma unroll
          for (int j = 0; j < 8; ++j) x1[8 + j] = t[j];
          ld8(P + C_RK + hd * 64 + 32 + 16 * half, t);
#pragma unroll
          for (int j = 0; j < 8; ++j) x2[j] = t[j];
          ld8(P + C_RK + hd * 64 + 32 + 16 * half + 8, t);
#pragma unroll
          for (int j = 0; j < 8; ++j) x2[8 + j] = t[j]; }
        if (cj > 0) {
            const int s = (cj - 1) * 256 + m, gr = s >> 6, gc = s & 63;
            const f32x2* tb = (const f32x2*)(wso(ws, WS_TAB) + TAB_R64) + (half ? gc : gr) * 16;
#pragma unroll
            for (int j = 0; j < 16; ++j) { const f32x2 cs = tb[j]; const float y1 = x1[j] * cs.x - x2[j] * cs.y, y2 = x1[j] * cs.y + x2[j] * cs.x; x1[j] = y1; x2[j] = y2; }
        }
        const float zf = 0.125f * __builtin_amdgcn_exp2f(lgf * (float)(255 - m)), zb = 0.125f * __builtin_amdgcn_exp2f(lgb * (float)m);
        float o[8];
#pragma unroll
        for (int q = 0; q < 2; ++q) {
#pragma unroll
            for (int j = 0; j < 8; ++j) o[j] = x1[8 * q + j] * zf;
            st8l(lds + R1_KF + m * 128 + (16 * half + 8 * q) * 2, o);
#pragma unroll
            for (int j = 0; j < 8; ++j) o[j] = x2[8 * q + j] * zf;
            st8l(lds + R1_KF + m * 128 + (32 + 16 * half + 8 * q) * 2, o);
#pragma unroll
            for (int j = 0; j < 8; ++j) o[j] = x1[8 * q + j] * zb;
            st8l(lds + R1_KB + m * 128 + (16 * half + 8 * q) * 2, o);
#pragma unroll
            for (int j = 0; j < 8; ++j) o[j] = x2[8 * q + j] * zb;
            st8l(lds + R1_KB + m * 128 + (32 + 16 * half + 8 * q) * 2, o);
        }
#pragma unroll
        for (int q = 0; q < 4; ++q) *(LAS u32x4*)(lds + R1_V + m * 128 + half * 64 + q * 16) = *(const u32x4*)(P + C_RV + hd * 64 + half * 32 + q * 8);
    }
    __syncthreads();
    {
        const int dir = w >> 2, eb = (w >> 1) & 1, db = w & 1;
        const int i16 = lane & 15, q = i16 >> 2, p = i16 & 3, g = (lane >> 4) & 1, h = lane >> 5, r = lane & 31;
        LAS unsigned char* vb = lds + R1_V + (8 * h + q) * 128 + (32 * eb + 16 * g + 4 * p) * 2;
        LAS unsigned char* kb = lds + (dir ? R1_KB : R1_KF) + (8 * h + q) * 128 + (32 * db + 16 * g + 4 * p) * 2;
        f32x16 acc;
#pragma unroll
        for (int i = 0; i < 16; ++i) acc[i] = 0.f;
#pragma unroll
        for (int s = 0; s < 16; ++s) {
            const s16x4 alo = trread(vb + s * 2048), ahi = trread(vb + s * 2048 + 512);
            const s16x4 blo = trread(kb + s * 2048), bhi = trread(kb + s * 2048 + 512);
            const bf16x8 av = __builtin_shufflevector(alo, ahi, 0, 1, 2, 3, 4, 5, 6, 7), bv = __builtin_shufflevector(blo, bhi, 0, 1, 2, 3, 4, 5, 6, 7);
            acc = MFMA32(av, bv, acc);
        }
        float* U = (float*)(wso(ws, WS_UST)) + ((((size_t)b * 4 + hd) * NCHUNK + cj) * 2 + dir) * 4096;
#pragma unroll
        for (int i = 0; i < 16; ++i) U[(32 * eb + crow(i, h)) * 64 + 32 * db + r] = acc[i];
    }
    __syncthreads();
}

template <int KS  >
DI void mla_up_tile(const bf16x8 (&bf)[KS], LAS unsigned char* ain  , LAS unsigned char* lds, bf16_t* out  , int ldo, int sel, int row0, int fr, int fq) {
#pragma unroll 3
    for (int rt = 0; rt < MU_ROWS / 16; ++rt) {
        LAS unsigned char* ap = ain + (16 * rt + fr) * MU_PITCH + 16 * fq;
        f32x4 acc = {0.f, 0.f, 0.f, 0.f};
#pragma unroll
        for (int ks = 0; ks < KS; ++ks) acc = __builtin_amdgcn_mfma_f32_16x16x32_bf16(bf[ks], *(LAS bf16x8*)(ap + 64 * ks), acc, 0, 0, 0);
        const float sc = sel < 0 ? 1.0f : ((LAS float*)(lds + MU_RS))[(16 * rt + fr) * 2 + sel];
        if (16 * rt + fr < ROWS_PER_BLK) { const float v[4] = {acc[0] * sc, acc[1] * sc, acc[2] * sc, acc[3] * sc}; st4(out + (size_t)(row0 + 16 * rt + fr) * ldo + 4 * fq, v); }
    }
}
DI void prep_mla_up(int l, int row0, LAS unsigned char* lds) {
    const int tid = otid(), lane = tid & 63, w = __builtin_amdgcn_readfirstlane(tid >> 6), fr = lane & 15, fq = lane >> 4;
    unsigned char* ws = kws();
    bf16_t* P = (bf16_t*)(wso(ws, WS_P));
    for (int i = tid; i < MU_ROWS * 40; i += NTHR) {
        const int r = i / 40, c = i - r * 40, row = row0 + r < T ? row0 + r : T - 1;
        *(LAS u32x4*)(lds + r * MU_PITCH + c * 16) = *(const u32x4*)(P + (size_t)row * NP + C_MCQ + c * 8);
    }
    __syncthreads();
    if (tid < 2 * MU_ROWS) {
        const int r = tid >> 1, kv = tid & 1; LAS unsigned char* p = lds + r * MU_PITCH + kv * 384; float ss = 0.f;
        for (int c = 0; c < (kv ? 16 : 24); ++c) { float v[8]; const u32x4 t_ = *(LAS u32x4*)(p + c * 16); un8(t_, v);
#pragma unroll
            for (int j = 0; j < 8; ++j) ss += v[j] * v[j]; }
        ((LAS float*)(lds + MU_RS))[tid] = kv ? rsqrtf(ss * (1.0f / 128.0f) + opq(EPS)) : rsqrtf(ss * (1.0f / 192.0f) + opq(EPS)) * (0.10206207261596575f * LOG2E);
    }
    __syncthreads();
    const bf16_t* Wq = (const bf16_t*)(wso(ws, WS_WUQ)) + (size_t)l * 384 * 192; const bf16_t* Wkv = (const bf16_t*)(wso(ws, WS_WUKV)) + (size_t)l * 512 * 128;
    bf16x8 bq[3][6], bkv[4][4];
#pragma unroll
    for (int j = 0; j < 3; ++j)
#pragma unroll
        for (int ks = 0; ks < 6; ++ks) bq[j][ks] = *(const bf16x8*)(Wq + (size_t)((3 * w + j) * 16 + fr) * 192 + 32 * ks + 8 * fq);
#pragma unroll
    for (int j = 0; j < 4; ++j)
#pragma unroll
        for (int ks = 0; ks < 4; ++ks) bkv[j][ks] = *(const bf16x8*)(Wkv + (size_t)((4 * w + j) * 16 + fr) * 128 + 32 * ks + 8 * fq);
#pragma unroll
    for (int j = 0; j < 3; ++j) { const int n0 = (3 * w + j) * 16, hh = n0 / 96, wi = n0 - hh * 96; const bool rope = wi >= 64;
        bf16_t* qm = (bf16_t*)(wso(ws, WS_QM)) + n0; bf16_t* pq = P + C_MQE + n0;
        mla_up_tile<6>(bq[j], lds, lds, rope ? pq : qm, rope ? NP : 384, rope ? -1 : 0, row0, fr, fq); }
#pragma unroll
    for (int j = 0; j < 4; ++j) { const int n0 = (4 * w + j) * 16, hh = n0 >> 7, wi = n0 & 127; const bool isv = wi >= 64;
        bf16_t* km = (bf16_t*)(wso(ws, WS_KM)) + hh * 96 + wi; bf16_t* vm = (bf16_t*)(wso(ws, WS_VM)) + hh * 64 + (wi - 64);
        mla_up_tile<4>(bkv[j], lds + 384, lds, isv ? vm : km, isv ? 256 : 384, 1, row0, fr, fq); }
}

DI void p_prep(const Args& a, int l, LAS unsigned char* lds) {
    const int tid = otid(), lane = tid & 63, w = __builtin_amdgcn_readfirstlane(tid >> 6);
    {
        const float* tab = (const float*)(wso(kws(), WS_TAB));
        for (int i = tid; i < 3072; i += NTHR) ((LAS float*)(lds + PREP_TAB))[i] = tab[i];
        if (tid < 128) ((LAS float*)(lds + PREP_QN))[tid] = kin(I_GQKN)[l * 128 + tid];
    }
    for (int chunk = obx(); chunk * ROWS_PER_BLK < T; chunk += gridDim.x) {
        const int row0 = chunk * ROWS_PER_BLK;
        prep_mla_up(l, row0, lds);
        asm volatile("s_waitcnt vmcnt(0)" ::: "memory");
        __syncthreads();
        int row = row0 + w;
        PrepRaw cur, nxt;
        cur = prep_load(row, lane);
#pragma unroll 1
        while (row < row0 + ROWS_PER_BLK) {
            const int rn = row + 8;
            if (rn < row0 + ROWS_PER_BLK) nxt = prep_load(rn, lane);
            prep_compute(row, row - row0, lane, cur, lds);
            cur = nxt; row = rn;
        }
    }
    __syncthreads();
    for (int it = obx(); it < NB * NCHUNK * 4; it += gridDim.x) r1_item(a, l, it, lds);
}

enum { M_DIFF = 0, M_MLA = 1, M_GQA = 2, M_RET = 3 };
constexpr int AT_RING = 4, AT_KSLOT = 12288, AT_VSLOT = 8192, AT_K0 = 0, AT_K1 = AT_KSLOT, AT_V0 = AT_RING * AT_KSLOT, AT_V1 = AT_V0 + AT_VSLOT, AT_SF = AT_V0 + AT_RING * AT_VSLOT, AT_SB = AT_SF + 9216, AT_END = AT_SB + 9216;
static_assert(AT_END <= 131072, "lds");
struct AttnP {
    const bf16_t* Q; int ldq; const bf16_t* K; int ldk; const bf16_t* V; int ldv; bf16_t* O;
    int qrow0, krow0, ntiles;
    float lam, oml; const float* subln;
    const float* qnw;
    const bf16_t* gate; const float* gnw; const float* gnb; float l2gf, l2gb; const float* ust; int cj;
};
template <int ST> DI bf16x8 pack8(const f32x16& s) {
    u32x4 u; u.x = pk2(s[8 * ST], s[8 * ST + 1]); u.y = pk2(s[8 * ST + 2], s[8 * ST + 3]); u.z = pk2(s[8 * ST + 4], s[8 * ST + 5]); u.w = pk2(s[8 * ST + 6], s[8 * ST + 7]);
    return __builtin_bit_cast(bf16x8, u);
}
constexpr float SM_THR = 8.0f;
struct SmState { float m, l; f32x16 negm; };
DI void sm_init(SmState& st) { st.m = 0.f; st.l = 0.f;
#pragma unroll
    for (int i = 0; i < 16; ++i) st.negm[i] = 0.f; }
#define MX3(a, b, c) __builtin_fmaxf(__builtin_fmaxf((a), (b)), (c))
DI float sm_rowmax(const f32x16& s0, const f32x16& s1) {
    float a = MX3(s0[0], s0[1], s1[0]), b = MX3(s0[2], s0[3], s1[1]); a = MX3(a, s1[2], s1[3]);
#pragma unroll
    for (int r = 4; r < 16; r += 4) { a = MX3(a, s0[r], s0[r + 1]); b = MX3(b, s0[r + 2], s0[r + 3]); a = MX3(a, s1[r], s1[r + 1]); b = MX3(b, s1[r + 2], s1[r + 3]); }
    const float mx = __builtin_fmaxf(a, b);
    auto rr = __builtin_amdgcn_permlane32_swap(__float_as_uint(mx), __float_as_uint(mx), false, false);
    return __builtin_fmaxf(__uint_as_float(rr[0]), __uint_as_float(rr[1]));
}
DI void sm_move(float mx, bool first, SmState& st, f32x16& o0, f32x16& o1, f32x16& s0, f32x16& s1) {
    const float d = first ? mx : __builtin_fmaxf(mx, 0.f), alpha = first ? 0.f : __builtin_amdgcn_exp2f(-d);
    st.m += d; st.l *= alpha;
    const float nm = -st.m;
#pragma unroll
    for (int i = 0; i < 16; ++i) { o0[i] *= alpha; o1[i] *= alpha; s0[i] -= d; s1[i] -= d; st.negm[i] = nm; }
}
DI void sm_exp_pack(f32x16& s0, f32x16& s1, SmState& st, bf16x8 (&pf)[4]) {
    float a0 = 0.f, a1 = 0.f;
#pragma unroll
    for (int i = 0; i < 16; i += 2) {
        s0[i] = __builtin_amdgcn_exp2f(s0[i]); s0[i + 1] = __builtin_amdgcn_exp2f(s0[i + 1]); s1[i] = __builtin_amdgcn_exp2f(s1[i]); s1[i + 1] = __builtin_amdgcn_exp2f(s1[i + 1]);
        a0 += s0[i]; a1 += s0[i + 1]; asm("" : "+v"(a0), "+v"(a1)); a0 += s1[i]; a1 += s1[i + 1]; asm("" : "+v"(a0), "+v"(a1));
    }
    st.l += a0 + a1;
    pf[0] = pack8<0>(s0); pf[1] = pack8<1>(s0); pf[2] = pack8<0>(s1); pf[3] = pack8<1>(s1);
}
DI void pv_packed(LAS unsigned char* vlane, const bf16x8 (&pf)[4], f32x16& o0, f32x16& o1) {
#pragma unroll
    for (int ks = 0; ks < 4; ++ks) {
        { const s16x4 lo = trread(vlane + ks * 1024), hi = trread(vlane + ks * 1024 + 512);
          o0 = MFMA32(__builtin_shufflevector(lo, hi, 0, 1, 2, 3, 4, 5, 6, 7), pf[ks], o0); }
        { const s16x4 lo = trread(vlane + 4096 + ks * 1024), hi = trread(vlane + 4096 + ks * 1024 + 512);
          o1 = MFMA32(__builtin_shufflevector(lo, hi, 0, 1, 2, 3, 4, 5, 6, 7), pf[ks], o1); }
    }
}
DI void pv_tile(LAS unsigned char* vlane, const f32x16& p0, const f32x16& p1, f32x16& o0, f32x16& o1) {
    bf16x8 pf[4]; pf[0] = pack8<0>(p0); pf[1] = pack8<1>(p0); pf[2] = pack8<0>(p1); pf[3] = pack8<1>(p1);
    pv_packed(vlane, pf, o0, o1);
}

struct AttnLane { int lane, w, r, h, nq, sdst, klane_off, vlane_off; };
DI AttnLane attn_lane() {
    AttnLane L; const int tid = otid();
    L.lane = tid & 63; L.w = __builtin_amdgcn_readfirstlane(tid >> 6); L.r = L.lane & 31; L.h = L.lane >> 5; L.nq = 32 * L.w + L.r;
    L.sdst = L.w * 1024 + L.lane * 16; L.klane_off = L.h * 1024 + L.r * 16;
    const int i16 = L.lane & 15; L.vlane_off = (4 * L.h + (i16 >> 2)) * 64 + (16 * ((L.lane >> 4) & 1) + 4 * (i16 & 3)) * 2;
    return L;
}

template <int NDC, int NCH  >
DI void attn_pass(LAS unsigned char* lds, const AttnP& a, const AttnLane& L, const bf16x8* qf, int kc0, f32x16& o0, f32x16& o1, SmState& st) {
    constexpr int NLD = (NCH == 12) ? 3 : 2;
    const int w = L.w, lane = L.lane;
    const bf16_t* ksrc = a.K + (size_t)(a.krow0 + lane) * a.ldk + w * 8;
    const bf16_t* ksrc2 = a.K + (size_t)(a.krow0 + lane) * a.ldk + (w < 4 ? 8 + w : w) * 8;
    const bf16_t* vsrc = a.V + (size_t)(a.krow0 + 16 * (w & 3) + (lane >> 2)) * a.ldv + (w >> 2) * 32 + (lane & 3) * 8;
    const size_t kstep = (size_t)64 * a.ldk, vstep = (size_t)64 * a.ldv;
    const unsigned lds0 = (unsigned)(uintptr_t)lds + (unsigned)(w * 1024);
#define AP_GLDS(g, ldsb) do { unsigned sv_; asm volatile("s_mov_b32 %0, m0\n\ts_mov_b32 m0, %2\n\ts_nop 0\n\tglobal_load_lds_dwordx4 %1, off\n\ts_mov_b32 m0, %0" \
        : "=&s"(sv_) : "v"(g), "s"((unsigned)__builtin_amdgcn_readfirstlane(ldsb)) : "memory"); } while (0)
#define AP_DK(j) do { const unsigned sl_ = lds0 + AT_K0 + (unsigned)(((j) % AT_RING) * AT_KSLOT); \
        AP_GLDS(ksrc + (size_t)(j) * kstep, sl_); \
        if (NCH == 12) AP_GLDS(ksrc2 + (size_t)(j) * kstep, sl_ + (w < 4 ? 8192u : 0u)); } while (0)
#define AP_DV(j) do { AP_GLDS(vsrc + (size_t)(j) * vstep, lds0 + AT_V0 + (unsigned)(((j) % AT_RING) * AT_VSLOT)); } while (0)
#define AP_WAITBAR(N) do { asm volatile("s_waitcnt vmcnt(%0) lgkmcnt(0)" :: "n"(N) : "memory"); __builtin_amdgcn_s_barrier(); asm volatile("" ::: "memory"); } while (0)
#define AP_KF(j) do { LAS unsigned char* kb_ = lds + AT_K0 + ((j) % AT_RING) * AT_KSLOT + L.klane_off + kc0 * 1024; \
        _Pragma("unroll") for (int dc = 0; dc < NDC; ++dc) { kf[2 * dc] = *(LAS bf16x8*)(kb_ + dc * 2048); kf[2 * dc + 1] = *(LAS bf16x8*)(kb_ + dc * 2048 + 512); } } while (0)
#define AP_VF(j) do { LAS unsigned char* vb_ = lds + AT_V0 + ((j) % AT_RING) * AT_VSLOT + L.vlane_off; \
        _Pragma("unroll") for (int ks = 0; ks < 4; ++ks) { \
            { const s16x4 lo = trread(vb_ + ks * 1024), hi = trread(vb_ + ks * 1024 + 512); vf[2 * ks] = __builtin_shufflevector(lo, hi, 0, 1, 2, 3, 4, 5, 6, 7); } \
            { const s16x4 lo = trread(vb_ + 4096 + ks * 1024), hi = trread(vb_ + 4096 + ks * 1024 + 512); vf[2 * ks + 1] = __builtin_shufflevector(lo, hi, 0, 1, 2, 3, 4, 5, 6, 7); } } } while (0)
#define AP_QK(S0, S1) do { S0 = mfma32_c(kf[0], qf[0], st.negm); S1 = mfma32_c(kf[1], qf[0], st.negm); \
        _Pragma("unroll") for (int dc = 1; dc < NDC; ++dc) { S0 = MFMA32(kf[2 * dc], qf[dc], S0); S1 = MFMA32(kf[2 * dc + 1], qf[dc], S1); } } while (0)
    sm_init(st);
#pragma unroll
    for (int i = 0; i < 16; ++i) { o0[i] = 0.f; o1[i] = 0.f; }
    AP_DK(0);
#pragma unroll
    for (int j = 0; j < AT_RING - 1; ++j) { AP_DK(j + 1); AP_DV(j); }
    AP_WAITBAR((AT_RING - 2) * NLD);
    f32x16 sc0, sc1;
    { bf16x8 kf[2 * NDC]; AP_KF(0); AP_QK(sc0, sc1); }
    sm_move(sm_rowmax(sc0, sc1), true, st, o0, o1, sc0, sc1);
    AP_WAITBAR((AT_RING - 2) * NLD);
#define AP_STEP(t, SC0, SC1, SN0, SN1) do { \
        AP_DK((t) + AT_RING); AP_DV((t) + AT_RING - 1); \
        bf16x8 kf[2 * NDC], vf[8]; \
        AP_KF((t) + 1); AP_VF(t); \
        __builtin_amdgcn_sched_barrier(0); \
        bf16x8 pf[4]; \
        AP_QK(SN0, SN1);                                  \
        sm_exp_pack(SC0, SC1, st, pf);                    \
        __builtin_amdgcn_sched_barrier(0); \
        _Pragma("unroll") for (int ks = 0; ks < 4; ++ks) { o0 = MFMA32(vf[2 * ks], pf[ks], o0); o1 = MFMA32(vf[2 * ks + 1], pf[ks], o1); } \
        const float mx_ = sm_rowmax(SN0, SN1); \
        if ((t) + 1 < a.ntiles && __any(mx_ > SM_THR)) sm_move(mx_, false, st, o0, o1, SN0, SN1); \
        AP_WAITBAR((AT_RING - 2) * NLD); } while (0)
    f32x16 sd0, sd1;
#pragma unroll 1
    for (int t = 0; t < a.ntiles; t += 2) {
        AP_STEP(t, sc0, sc1, sd0, sd1);
        AP_STEP(t + 1, sd0, sd1, sc0, sc1);
    }
#undef AP_STEP
    AP_WAITBAR(0);
#undef AP_GLDS
#undef AP_DK
#undef AP_DV
#undef AP_WAITBAR
#undef AP_KF
#undef AP_VF
#undef AP_QK
}

template <int MODE>
DI void attn_q_fix(bf16x8 (&qf)[4], int row, int h, const float* qnw) {
    float x[4][8];
#pragma unroll
    for (int dc = 0; dc < 4; ++dc) { const u32x4 u = __builtin_bit_cast(u32x4, qf[dc]); un8(u, x[dc]); }
    const int b = row / SP, pos = row - b * SP; const bool lat = pos >= NCTX; const int s_ = lat ? pos - NCTX : 0, gr = s_ >> 6, gc = s_ & 63;
    unsigned char* ws = kws();
    if (MODE == M_GQA) {
        float ss = 0.f;
#pragma unroll
        for (int dc = 0; dc < 4; ++dc)
#pragma unroll
            for (int j = 0; j < 8; ++j) ss += x[dc][j] * x[dc][j];
        ss += xor32_f(ss);
        const float rs = rsqrtf(ss * (1.0f / 64.0f) + opq(EPS));
#pragma unroll
        for (int dc = 0; dc < 4; ++dc) { const f32x4 w0 = *(gv4p)(qnw + 16 * dc + 8 * h), w1 = *(gv4p)(qnw + 16 * dc + 8 * h + 4);
#pragma unroll
            for (int j = 0; j < 4; ++j) { x[dc][j] *= rs * w0[j]; x[dc][4 + j] *= rs * w1[j]; } }
    }
    if (MODE == M_DIFF) {
        if (lat) { const float* tb = (const float*)(wso(ws, WS_TAB) + TAB_R32) + ((h == 0 ? gr : gc) * 8) * 2;
            f32x4 t[4];
#pragma unroll
            for (int q = 0; q < 4; ++q) t[q] = *(gv4p)(tb + 4 * q);
#pragma unroll
            for (int j = 0; j < 8; ++j) { const float c_ = t[j >> 1][2 * (j & 1)], s2 = t[j >> 1][2 * (j & 1) + 1];
#pragma unroll
                for (int m = 0; m < 4; m += 2) { const float y1 = x[m][j] * c_ - x[m + 1][j] * s2, y2 = x[m][j] * s2 + x[m + 1][j] * c_; x[m][j] = y1; x[m + 1][j] = y2; } } }
    } else {
        if (lat) {
            f32x4 t[2][4];
#pragma unroll
            for (int dc = 0; dc < 2; ++dc) { const float* tb = (const float*)(wso(ws, WS_TAB) + TAB_R64) + ((dc == 0 ? gr : gc) * 16 + 8 * h) * 2;
#pragma unroll
                for (int q = 0; q < 4; ++q) t[dc][q] = *(gv4p)(tb + 4 * q); }
#pragma unroll
            for (int dc = 0; dc < 2; ++dc)
#pragma unroll
                for (int j = 0; j < 8; ++j) { const float c_ = t[dc][j >> 1][2 * (j & 1)], s2 = t[dc][j >> 1][2 * (j & 1) + 1];
                    const float y1 = x[dc][j] * c_ - x[dc + 2][j] * s2, y2 = x[dc][j] * s2 + x[dc + 2][j] * c_; x[dc][j] = y1; x[dc + 2][j] = y2; } }
    }
    const float scale = MODE == M_DIFF ? 0.17677669529663687f * LOG2E : MODE == M_GQA ? 0.125f * LOG2E : 1.0f;
#pragma unroll
    for (int dc = 0; dc < 4; ++dc) { u32x4 u; u.x = pk2(x[dc][0] * scale, x[dc][1] * scale); u.y = pk2(x[dc][2] * scale, x[dc][3] * scale); u.z = pk2(x[dc][4] * scale, x[dc][5] * scale); u.w = pk2(x[dc][6] * scale, x[dc][7] * scale);
        qf[dc] = __builtin_bit_cast(bf16x8, u); }
}

template <int MODE>
DI void attn_unit(LAS unsigned char* lds, const AttnP& a) {
    const AttnLane L = attn_lane();
    const int lane = L.lane, w = L.w, r = L.r, h = L.h, nq = L.nq;
    bf16_t* orow = a.O + (size_t)(a.qrow0 + nq) * DM;
    const bf16_t* qrow = a.Q + (size_t)(a.qrow0 + nq) * a.ldq + 8 * h;
    if (MODE == M_GQA || MODE == M_MLA) {
        constexpr int NDC = (MODE == M_MLA) ? 6 : 4;
        bf16x8 qf[NDC];
#pragma unroll
        for (int dc = 0; dc < NDC; ++dc) qf[dc] = *(const bf16x8*)(qrow + 16 * dc);
        if constexpr (MODE == M_GQA) attn_q_fix<M_GQA>(qf, a.qrow0 + nq, h, a.qnw);
        f32x16 o0, o1; SmState st;
        attn_pass<NDC, (MODE == M_MLA ? 12 : 8)>(lds, a, L, qf, 0, o0, o1, st);
        const float lt = st.l + __shfl_xor(st.l, 32), inv = 1.0f / lt;
#pragma unroll
        for (int g4 = 0; g4 < 4; ++g4) {
            const float v0[4] = {o0[4 * g4] * inv, o0[4 * g4 + 1] * inv, o0[4 * g4 + 2] * inv, o0[4 * g4 + 3] * inv};
            const float v1[4] = {o1[4 * g4] * inv, o1[4 * g4 + 1] * inv, o1[4 * g4 + 2] * inv, o1[4 * g4 + 3] * inv};
            st4(orow + 8 * g4 + 4 * h, v0); st4(orow + 32 + 8 * g4 + 4 * h, v1);
        }
    } else if (MODE == M_DIFF) {
        bf16x8 qf[4];
#pragma unroll
        for (int dc = 0; dc < 4; ++dc) qf[dc] = *(const bf16x8*)(qrow + 16 * dc);
        attn_q_fix<M_DIFF>(qf, a.qrow0 + nq, h, nullptr);
        f32x16 p0, p1, o0, o1; SmState st;
        attn_pass<2, 8>(lds, a, L, qf, 0, p0, p1, st);
        { const float i1 = 1.0f / (st.l + __shfl_xor(st.l, 32));
#pragma unroll
          for (int i = 0; i < 16; ++i) { p0[i] *= i1; p1[i] *= i1; } }
        attn_pass<2, 8>(lds, a, L, qf + 2, 4, o0, o1, st);
        const float i2 = a.lam / (st.l + __shfl_xor(st.l, 32));
        float ss = 0.f;
#pragma unroll
        for (int i = 0; i < 16; ++i) { o0[i] = p0[i] - o0[i] * i2; o1[i] = p1[i] - o1[i] * i2; ss += o0[i] * o0[i] + o1[i] * o1[i]; }
        ss += __shfl_xor(ss, 32);
        const float rs = rsqrtf(ss * (1.0f / 64.0f) + opq(EPS)) * a.oml;
#pragma unroll
        for (int g4 = 0; g4 < 4; ++g4) {
            const int e0 = 8 * g4 + 4 * h; const f32x4 w0 = *(const f32x4*)(a.subln + e0), w1 = *(const f32x4*)(a.subln + 32 + e0);
            const float v0[4] = {o0[4 * g4] * rs * w0[0], o0[4 * g4 + 1] * rs * w0[1], o0[4 * g4 + 2] * rs * w0[2], o0[4 * g4 + 3] * rs * w0[3]};
            const float v1[4] = {o1[4 * g4] * rs * w1[0], o1[4 * g4 + 1] * rs * w1[1], o1[4 * g4 + 2] * rs * w1[2], o1[4 * g4 + 3] * rs * w1[3]};
            st4(orow + e0, v0); st4(orow + 32 + e0, v1);
        }
    } else {
        bf16x8 qf[4];
#pragma unroll
        for (int dc = 0; dc < 4; ++dc) qf[dc] = *(const bf16x8*)(qrow + 16 * dc);
        attn_q_fix<M_RET>(qf, a.qrow0 + nq, h, nullptr);
        const bf16_t* ksrc = a.K + (size_t)(a.krow0 + lane) * a.ldk + w * 8;
        const bf16_t* vsrc = a.V + (size_t)(a.krow0 + 16 * (w & 3) + (lane >> 2)) * a.ldv + (w >> 2) * 32 + (lane & 3) * 8;
        const size_t kstep = (size_t)64 * a.ldk, vstep = (size_t)64 * a.ldv;
        u32x4 kr0, vr;
#define AT_GLOAD(t) do { kr0 = *(const u32x4*)(ksrc + (size_t)(t) * kstep); vr = *(const u32x4*)(vsrc + (size_t)(t) * vstep); } while (0)
#define AT_LSTORE(buf) do { *(LAS u32x4*)(lds + ((buf) ? AT_K1 : AT_K0) + L.sdst) = kr0; *(LAS u32x4*)(lds + ((buf) ? AT_V1 : AT_V0) + L.sdst) = vr; } while (0)
        AT_GLOAD(0);
        f32x16 o0, o1;
#pragma unroll
        for (int i = 0; i < 16; ++i) { o0[i] = 0.f; o1[i] = 0.f; }
        if (a.cj > 0) {
            const float gf256 = __builtin_amdgcn_exp2f(256.0f * a.l2gf), gb256 = __builtin_amdgcn_exp2f(256.0f * a.l2gb);
            const int tid = w * 64 + lane, e = tid >> 3, d0 = (tid & 7) * 8;
            float sf[8], sb[8];
#pragma unroll
            for (int j = 0; j < 8; ++j) { sf[j] = 0.f; sb[j] = 0.f; }
            for (int i = 0; i < a.cj; ++i) { const float* u = a.ust + ((size_t)i * 2 + 0) * 4096 + e * 64 + d0; const f32x4 u0 = *(const f32x4*)u, u1 = *(const f32x4*)(u + 4);
#pragma unroll
                for (int j = 0; j < 4; ++j) { sf[j] = sf[j] * gf256 + u0[j]; sf[4 + j] = sf[4 + j] * gf256 + u1[j]; } }
            { const float* u = a.ust + ((size_t)0 * 2 + 1) * 4096 + e * 64 + d0; const f32x4 u0 = *(const f32x4*)u, u1 = *(const f32x4*)(u + 4);
#pragma unroll
                for (int j = 0; j < 4; ++j) { sb[j] = u0[j]; sb[4 + j] = u1[j]; } }
            for (int i = NCHUNK - 1; i > a.cj; --i) { const float* u = a.ust + ((size_t)i * 2 + 1) * 4096 + e * 64 + d0; const f32x4 u0 = *(const f32x4*)u, u1 = *(const f32x4*)(u + 4);
#pragma unroll
                for (int j = 0; j < 4; ++j) { sb[j] = sb[j] * gb256 + u0[j]; sb[4 + j] = sb[4 + j] * gb256 + u1[j]; } }
            st8l(lds + AT_SF + e * 144 + d0 * 2, sf); st8l(lds + AT_SB + e * 144 + d0 * 2, sb);
        }
        AT_LSTORE(0);
        __syncthreads();
        if (a.cj > 0) {
            f32x16 af0, af1, ab0, ab1;
#pragma unroll
            for (int i = 0; i < 16; ++i) { af0[i] = 0.f; af1[i] = 0.f; ab0[i] = 0.f; ab1[i] = 0.f; }
#pragma unroll
            for (int dc = 0; dc < 4; ++dc) {
                const bf16x8 f0 = *(LAS bf16x8*)(lds + AT_SF + r * 144 + (16 * dc + 8 * h) * 2), f1 = *(LAS bf16x8*)(lds + AT_SF + (32 + r) * 144 + (16 * dc + 8 * h) * 2);
                const bf16x8 b0 = *(LAS bf16x8*)(lds + AT_SB + r * 144 + (16 * dc + 8 * h) * 2), b1 = *(LAS bf16x8*)(lds + AT_SB + (32 + r) * 144 + (16 * dc + 8 * h) * 2);
                af0 = MFMA32(f0, qf[dc], af0); af1 = MFMA32(f1, qf[dc], af1); ab0 = MFMA32(b0, qf[dc], ab0); ab1 = MFMA32(b1, qf[dc], ab1);
            }
            const float xf = __builtin_amdgcn_exp2f(a.l2gf * (float)(nq + 1)), xb = __builtin_amdgcn_exp2f(a.l2gb * (float)(256 - nq));
#pragma unroll
            for (int i = 0; i < 16; ++i) { o0[i] = xf * af0[i] + xb * ab0[i]; o1[i] = xf * af1[i] + xb * ab1[i]; }
        }
#pragma unroll 1
        for (int t = 0; t < a.ntiles; ++t) {
            const int buf = t & 1;
            if (t + 1 < a.ntiles) AT_GLOAD(t + 1);
            LAS unsigned char* kb = lds + (buf ? AT_K1 : AT_K0) + L.klane_off;
            LAS unsigned char* vb = lds + (buf ? AT_V1 : AT_V0) + L.vlane_off;
            f32x16 s0, s1;
#pragma unroll
            for (int i = 0; i < 16; ++i) { s0[i] = 0.f; s1[i] = 0.f; }
#pragma unroll
            for (int dc = 0; dc < 4; ++dc) { s0 = MFMA32(*(LAS bf16x8*)(kb + dc * 2048), qf[dc], s0); s1 = MFMA32(*(LAS bf16x8*)(kb + dc * 2048 + 512), qf[dc], s1); }
#pragma unroll
            for (int i = 0; i < 16; ++i) {
                const int mk = 64 * t + crow(i, h);
                { const int dlt = nq - mk; const float d = dlt > 0 ? __builtin_amdgcn_exp2f(a.l2gf * (float)dlt) : (dlt < 0 ? __builtin_amdgcn_exp2f(a.l2gb * (float)(-dlt)) : 2.0f); s0[i] *= d; }
                { const int dlt = nq - mk - 32; const float d = dlt > 0 ? __builtin_amdgcn_exp2f(a.l2gf * (float)dlt) : (dlt < 0 ? __builtin_amdgcn_exp2f(a.l2gb * (float)(-dlt)) : 2.0f); s1[i] *= d; }
            }
            pv_tile(vb, s0, s1, o0, o1);
            if (t + 1 < a.ntiles) AT_LSTORE(buf ^ 1);
            __syncthreads();
        }
#undef AT_GLOAD
#undef AT_LSTORE
        float sm = 0.f;
#pragma unroll
        for (int i = 0; i < 16; ++i) sm += o0[i] + o1[i];
        sm += __shfl_xor(sm, 32);
        const float mu = sm * (1.0f / 64.0f);
        float vv = 0.f;
#pragma unroll
        for (int i = 0; i < 16; ++i) { o0[i] -= mu; o1[i] -= mu; vv += o0[i] * o0[i] + o1[i] * o1[i]; }
        vv += __shfl_xor(vv, 32);
        const float rs = rsqrtf(vv * (1.0f / 64.0f) + opq(EPS));
        const bf16_t* grow = a.gate + (size_t)(a.qrow0 + nq) * NP;
#pragma unroll
        for (int g4 = 0; g4 < 4; ++g4) {
            const int e0 = 8 * g4 + 4 * h;
            const f32x4 w0 = *(const f32x4*)(a.gnw + e0), w1 = *(const f32x4*)(a.gnw + 32 + e0), b0 = *(const f32x4*)(a.gnb + e0), b1 = *(const f32x4*)(a.gnb + 32 + e0);
            float ga[4], gb[4]; ld4(grow + e0, ga); ld4(grow + 32 + e0, gb);
            float v0[4], v1[4];
#pragma unroll
            for (int j = 0; j < 4; ++j) { v0[j] = (o0[4 * g4 + j] * rs * w0[j] + b0[j]) * silu(ga[j]); v1[j] = (o1[4 * g4 + j] * rs * w1[j] + b1[j]) * silu(gb[j]); }
            st4(orow + e0, v0); st4(orow + 32 + e0, v1);
        }
    }
    __syncthreads();
}

DI void p_attn(const Args& a, int l, LAS unsigned char* lds) {
    unsigned char* ws = kws();
    const bool last = (l == NL - 1);
    const bf16_t* P = (const bf16_t*)(wso(ws, WS_P));
    bf16_t* YC = (bf16_t*)(wso(ws, WS_YC));
    int it = 0; const int cslot = (obx() >> 3) & 7; bool cdone = false;
    for (int U = obx(); U < 9 * 256; U += gridDim.x, ++it) {
        if (it == cslot) { conv_experts(l, lds); cdone = true; }
        const int rnd = U >> 8, vb = U & 255, b = vb & 7, i = vb >> 3;
        int mode, hd, qt;
        if (rnd < 8) { mode = rnd >> 1; const int u = i + 32 * (rnd & 1); hd = u >> 4; qt = 1 + (u & 15); }
        else { if (last || i >= 16) continue; mode = i >> 2; hd = i & 3; qt = 0; }
        AttnP p{};
        p.qrow0 = b * SP + qt * 256; p.krow0 = b * SP; p.ntiles = qt == 0 ? 4 : SP / 64;
        if (mode == M_DIFF) {
            p.Q = (const bf16_t*)(wso(ws, WS_QD)) + hd * 64; p.ldq = 256; p.K = (const bf16_t*)(wso(ws, WS_KD)) + hd * 64; p.ldk = 256; p.V = P + C_DV + hd * 64; p.ldv = NP; p.O = YC + 256 + hd * 64;
            p.lam = ((const float*)(wso(ws, WS_TAB) + TAB_LAM))[l]; p.oml = 1.0f - (0.8f - 0.6f * __expf(-0.3f * (float)l)); p.subln = kin(I_DSUB) + l * 64;
            attn_unit<M_DIFF>(lds, p);
        } else if (mode == M_MLA) {
            p.Q = (const bf16_t*)(wso(ws, WS_QM)) + hd * 96; p.ldq = 384; p.K = (const bf16_t*)(wso(ws, WS_KM)) + hd * 96; p.ldk = 384; p.V = (const bf16_t*)(wso(ws, WS_VM)) + hd * 64; p.ldv = 256; p.O = YC + 768 + hd * 64;
            attn_unit<M_MLA>(lds, p);
        } else if (mode == M_GQA) {
            p.Q = (const bf16_t*)(wso(ws, WS_QG)) + hd * 64; p.ldq = 256; p.qnw = kin(I_GQKN) + l * 128; p.K = (const bf16_t*)(wso(ws, WS_KG)) + (hd >> 1) * 64; p.ldk = 128; p.V = P + C_GV + (hd >> 1) * 64; p.ldv = NP; p.O = YC + 512 + hd * 64;
            attn_unit<M_GQA>(lds, p);
        } else {
            p.Q = (const bf16_t*)(wso(ws, WS_QRET)) + hd * 64; p.ldq = 256; p.K = (const bf16_t*)(wso(ws, WS_KRET)) + hd * 64; p.ldk = 256; p.V = P + C_RV + hd * 64; p.ldv = NP; p.O = YC + hd * 64;
            p.krow0 = p.qrow0; p.ntiles = 4; p.cj = qt;
            p.gate = P + C_RG + hd * 64; p.gnw = kin(I_RGNW) + l * 256 + hd * 64; p.gnb = kin(I_RGNB) + l * 256 + hd * 64;
            p.l2gf = -__expf(kin(I_RLD)[l * 8 + hd]) * LOG2E; p.l2gb = -__expf(kin(I_RLD)[l * 8 + 4 + hd]) * LOG2E;
            p.ust = (const float*)(wso(ws, WS_UST)) + ((size_t)b * 4 + hd) * NCHUNK * 2 * 4096;
            attn_unit<M_RET>(lds, p);
        }
    }
    if (!cdone) conv_experts(l, lds);
}

constexpr int N_PHASES = 2 + 8 * NL;
__global__ void __launch_bounds__(NTHR, 2) fwd(Args args) {
    extern __shared__ __attribute__((aligned(16))) unsigned char lds_raw[];
    LAS unsigned char* lds = (LAS unsigned char*)lds_raw;
    if (threadIdx.x < 4) ((LAS unsigned*)(lds + LDS_XB))[threadIdx.x] = 0u;
    __syncthreads();
    if (args.ph_hi - args.ph_lo > 1) (void)xcd_barrier_post((unsigned*)(wso(kws(), WS_CTL)), (volatile LAS unsigned*)(lds + LDS_XB));
#define KLO (*(const int CAS*)(karg_base() + 216))
#define KHI (*(const int CAS*)(karg_base() + 220))
#ifdef PH_MASK
#define IN(k) ((((PH_MASK) >> ((k) < 2 ? (k) : 2 + ((k) - 2) % 8)) & 1) && KLO <= (k) && (k) < KHI)
#else
#define IN(k) (KLO <= (k) && (k) < KHI)
#endif
#define SEAM(k) do { if (IN(k) && IN((k) + 1)) { XcdBarrier bar_; bar_.bar = (unsigned*)(wso(kws(), WS_CTL)); bar_.x = xb_xcc_id(); bar_.st = (volatile LAS unsigned*)(lds + LDS_XB); xcd_barrier(bar_); } } while (0)
    if (IN(0)) { p0_prologue(args, lds); if (DUP(0)) { __syncthreads(); p0_prologue(args, lds); } SEAM(0); }
    if (IN(1)) { p_norm0(args); SEAM(1); }
#pragma unroll 1
    for (int l = 0; l < NL; ++l) {
        const int pb = 2 + 8 * l;
        if (IN(pb + 0)) { p_gemm_dense<0>(l, lds); if (DUP(2)) p_gemm_dense<0>(l, lds); SEAM(pb + 0); }
        if (IN(pb + 1)) { p_prep(args, l, lds); if (DUP(3)) p_prep(args, l, lds); SEAM(pb + 1); }
        if (IN(pb + 2)) { p_attn(args, l, lds); if (DUP(4)) p_attn(args, l, lds); SEAM(pb + 2); }
        if (IN(pb + 3)) { p_gemm_dense<1>(l, lds); if (DUP(5)) p_gemm_dense<1>(l, lds); SEAM(pb + 3); }
        if (IN(pb + 4)) { p_rowA(args, l, lds); if (DUP(6)) { __syncthreads(); p_rowA(args, l, lds, true); } SEAM(pb + 4); }
        if (IN(pb + 5)) { p_gemm_moe<1>(args, l, lds); if (DUP(7)) p_gemm_moe<1>(args, l, lds); SEAM(pb + 5); }
        if (IN(pb + 6)) { p_gemm_moe<2>(args, l, lds); if (DUP(8)) p_gemm_moe<2>(args, l, lds); SEAM(pb + 6); }
        if (IN(pb + 7)) { p_rowB(args, l, lds); if (DUP(9)) { __syncthreads(); p_rowB(args, l, lds, true); } SEAM(pb + 7); }
    }
#undef IN
#undef SEAM
}

extern "C" void kernel_launch(void* const* d_in, const int* in_sizes, int n_in, void* d_out, int out_size, void* d_ws, size_t ws_size, hipStream_t stream) {
    static int grid = 0;
    if (grid == 0) {
        if (n_in != 25 || in_sizes[0] != NB * SEQ * DM || out_size != NB * SEQ * DM || ws_size < WS_END) {
            fprintf(stderr, "kernel_launch: unexpected problem (n_in %d, in0 %d, out %d, ws %zu, need %zu); nothing launched\n", n_in, n_in > 0 ? in_sizes[0] : -1, out_size, ws_size, (size_t)WS_END);
            grid = -1; return; }
        int dev = 0, cus = 0, per_cu = 0;
        if (hipGetDevice(&dev) != hipSuccess || hipDeviceGetAttribute(&cus, hipDeviceAttributeMultiprocessorCount, dev) != hipSuccess) { grid = -1; return; }
        if (hipFuncSetAttribute((const void*)fwd, hipFuncAttributeMaxDynamicSharedMemorySize, LDS_BYTES) != hipSuccess) { fprintf(stderr, "kernel_launch: hipFuncSetAttribute failed\n"); grid = -1; return; }
        if (hipOccupancyMaxActiveBlocksPerMultiprocessor(&per_cu, (const void*)fwd, NTHR, LDS_BYTES) != hipSuccess || per_cu < 1) {
            fprintf(stderr, "kernel_launch: occupancy query says %d blocks per CU\n", per_cu); }
        (void)hipGetLastError();
        grid = cus;
    }
    if (grid < 0) return;
    (void)hipMemsetAsync((char*)d_ws + WS_CTL, 0, CTL_BYTES, stream);
    Args a{};
    for (int i = 0; i < 25; ++i) a.in[i] = (const float*)d_in[i];
    a.out = (float*)d_out; a.ws = (unsigned char*)d_ws;
#if MK_LAUNCHES == 1
    a.ph_lo = 0; a.ph_hi = N_PHASES;
    hipLaunchKernelGGL(fwd, dim3(grid), dim3(NTHR), LDS_BYTES, stream, a);
#else
    for (int k = 0; k < N_PHASES; ++k) { a.ph_lo = k; a.ph_hi = k + 1; hipLaunchKernelGGL(fwd, dim3(grid), dim3(NTHR), LDS_BYTES, stream, a); }
#endif
    const hipError_t le = hipPeekAtLastError();
    if (le != hipSuccess) fprintf(stderr, "kernel_launch: launch failed: %s\n", hipGetErrorName(le));
}
```

```cpp
#include <hip/hip_runtime.h>
#include <stdint.h>
#include <stdio.h>

#ifndef MK_LAUNCHES
#define MK_LAUNCHES 1
#endif
#ifndef DUP_MASK
#define DUP_MASK 0
#endif
#define DUP(k) (((DUP_MASK) >> (k)) & 1)

#define DI __device__ __forceinline__
#define LAS __attribute__((address_space(3)))
typedef unsigned short bf16_t;
typedef short bf16x8 __attribute__((ext_vector_type(8)));
typedef short s16x4 __attribute__((ext_vector_type(4)));
typedef short v4i16_t __attribute__((ext_vector_type(4)));
typedef float f32x2 __attribute__((ext_vector_type(2)));
typedef float f32x4 __attribute__((ext_vector_type(4)));
typedef float f32x16 __attribute__((ext_vector_type(16)));
typedef unsigned u32x2 __attribute__((ext_vector_type(2)));
typedef unsigned u32x4 __attribute__((ext_vector_type(4)));
typedef __bf16 bf16x2v __attribute__((ext_vector_type(2)));

constexpr int DM = 1024, NB = 8, SEQ = 4096, NCTX = 256, SP = SEQ + NCTX, T = NB * SP, NL = 4;
constexpr int NIN = 2656, NP = 3584, NG1 = 2816;
constexpr int NE = 32, DFF2 = 2048;
constexpr int C_RQ = 0, C_RK = 256, C_RV = 512, C_RG = 768, C_DQ = 1024, C_DK = 1280, C_DV = 1536, C_GQ = 1792, C_GK = 2048, C_GV = 2176,
              C_MCQ = 2304, C_MCKV = 2496, C_MKR = 2624, C_MQE = 2656, C_MKVE = 3040, C_END = 3552;
constexpr int NCHUNK = SP / 256;
constexpr int ACT_ROWS = 4 * T + NE * 256;
constexpr float EPS = 1e-6f;
constexpr float LOG2E = 1.4426950408889634f;
constexpr int NTHR = 512;
constexpr int LDS_BYTES = 147456;
constexpr int LDS_XB = LDS_BYTES - 16;

constexpr size_t AL(size_t x) { return (x + 255) & ~(size_t)255; }
constexpr size_t WS_CTL = 0, CTL_BYTES = 65536;
constexpr size_t CTL_GCUR = 16384;
constexpr size_t WS_MOD = WS_CTL + CTL_BYTES;
constexpr size_t WS_TAB = WS_MOD + AL((size_t)NL * 9 * 6144 * 4);
constexpr size_t TAB_R64 = 0, TAB_R32 = 8192, TAB_LAM = 12288;
constexpr size_t WS_WUQ = WS_TAB + 16384;
constexpr size_t WS_WUKV = WS_WUQ + AL((size_t)NL * 384 * 192 * 2);
constexpr size_t WS_WIN = WS_WUKV + AL((size_t)NL * 512 * 128 * 2);
constexpr size_t WS_WOUT = WS_WIN + (size_t)NL * NP * DM * 2;
constexpr size_t WS_W1 = WS_WOUT + (size_t)NL * DM * DM * 2;
constexpr size_t WS_W2 = WS_W1 + (size_t)NL * NE * DFF2 * DM;
constexpr size_t WS_H8 = WS_W2 + (size_t)NL * NE * DM * DM;
constexpr size_t WS_XS = WS_H8 + (size_t)T * DM;
constexpr size_t WS_H = WS_XS + (size_t)T * DM * 4;
constexpr size_t WS_P = WS_H + (size_t)T * DM * 2;
constexpr size_t WS_QRET = WS_P + (size_t)T * NP * 2;
constexpr size_t WS_KRET = WS_QRET + (size_t)T * 256 * 2;
constexpr size_t WS_QD = WS_KRET + (size_t)T * 256 * 2;
constexpr size_t WS_KD = WS_QD + (size_t)T * 256 * 2;
constexpr size_t WS_QG = WS_KD + (size_t)T * 256 * 2;
constexpr size_t WS_KG = WS_QG + (size_t)T * 256 * 2;
constexpr size_t WS_QM = WS_KG + (size_t)T * 128 * 2;
constexpr size_t WS_KM = WS_QM + (size_t)T * 384 * 2;
constexpr size_t WS_VM = WS_KM + (size_t)T * 384 * 2;
constexpr size_t WS_UST = WS_VM + (size_t)T * 256 * 2;
constexpr size_t WS_YC = WS_UST + (size_t)NB * 4 * NCHUNK * 2 * 4096 * 4;
constexpr size_t WS_YO = WS_YC + (size_t)T * DM * 2;
constexpr size_t WS_LIST = WS_YO + (size_t)T * DM * 2;
constexpr size_t WS_RSLOT = WS_LIST + (size_t)NE * T * 4;
constexpr size_t WS_RGATE = WS_RSLOT + (size_t)T * 16;
constexpr size_t WS_ACT = WS_RGATE + (size_t)T * 16;
constexpr size_t WS_YR = WS_ACT + (size_t)ACT_ROWS * DM;
constexpr size_t WS_END = WS_YR + (size_t)ACT_ROWS * DM * 2;

#define XB_TMO      128
#define XB_XCNT(j)  (256  + 64 * (j))
#define XB_XSUB(j)  (1280 + 64 * (j))
#define XB_XGEN(j)  (2304 + 64 * (j))
#define XB_TOP      3328
#define XB_TOPGEN   3392
#define XCD_BAR_WORDS 3456
#define XB_SPIN_CAP (1u << 18)

__device__ __forceinline__ unsigned xb_ld(unsigned* p)              { return __hip_atomic_load(p, __ATOMIC_RELAXED, __HIP_MEMORY_SCOPE_AGENT); }
__device__ __forceinline__ unsigned xb_add(unsigned* p, unsigned v) { return __hip_atomic_fetch_add(p, v, __ATOMIC_RELAXED, __HIP_MEMORY_SCOPE_AGENT); }
__device__ __forceinline__ unsigned xb_xcc_id() { return (unsigned)__builtin_amdgcn_s_getreg((3 << 11) | 20) & 0xFu; }
#define XB_SPIN(cond, bar) do { unsigned _sp = 0; while (cond) { __builtin_amdgcn_s_sleep(1); \
    if ((++_sp & 255u) == 0u) { if (xb_ld(&(bar)[XB_TMO])) break; if (_sp > XB_SPIN_CAP) { atomicAdd(&(bar)[XB_TMO], 1u); break; } } } } while (0)

struct XcdBarrier { unsigned* bar; unsigned x; volatile LAS unsigned* st; };

__device__ __forceinline__ XcdBarrier xcd_barrier_post(unsigned* bar, volatile LAS unsigned* st) {
    XcdBarrier b; b.bar = bar; b.x = xb_xcc_id(); b.st = st;
    if (threadIdx.x == 0) (void)xb_add(&bar[XB_XCNT(b.x)], 1u);
    return b;
}
__device__ __forceinline__ void xcd_barrier_complete(unsigned* bar, unsigned x, unsigned& nloc, unsigned& nx) {
    const unsigned G = gridDim.x * gridDim.y * gridDim.z;
    unsigned sum, cnt, mine, sp = 0u;
    for (;;) {
        sum = 0u; cnt = 0u; mine = 0u;
#pragma unroll
        for (unsigned j = 0; j < 16; ++j) { const unsigned c = xb_ld(&bar[XB_XCNT(j)]); sum += c; cnt += (c > 0u) ? 1u : 0u; mine = (j == x) ? c : mine; }
        if (sum == G) break;
        __builtin_amdgcn_s_sleep(1);
        if ((++sp & 255u) == 0u) { if (xb_ld(&bar[XB_TMO])) break; if (sp > XB_SPIN_CAP) { atomicAdd(&bar[XB_TMO], 1u); break; } }
    }
    nloc = mine > 0u ? mine : 1u; nx = cnt > 0u ? cnt : 1u;
}
__device__ __forceinline__ void xcd_barrier(const XcdBarrier& b) {
    asm volatile("s_waitcnt vmcnt(0)" ::: "memory");
    __syncthreads();
    if (threadIdx.x == 0) {
        unsigned* bar = b.bar;
        __builtin_amdgcn_s_waitcnt(0);
        unsigned nloc = b.st[0], nx = b.st[1];
        if (nloc == 0u) { xcd_barrier_complete(bar, b.x, nloc, nx); b.st[0] = nloc; b.st[1] = nx; }
        const unsigned old = xb_add(&bar[XB_XSUB(b.x)], 1u);
        const unsigned gen = old / nloc;
        if (old + 1u == (gen + 1u) * nloc) {
            __builtin_amdgcn_fence(__ATOMIC_RELEASE, "agent");
            asm volatile("s_waitcnt vmcnt(0)" ::: "memory");
            const unsigned og = xb_add(&bar[XB_TOP], 1u);
            const unsigned tg = og / nx;
            if (og + 1u == (tg + 1u) * nx) xb_add(&bar[XB_TOPGEN], 1u);
            else XB_SPIN(xb_ld(&bar[XB_TOPGEN]) == tg, bar);
            __builtin_amdgcn_fence(__ATOMIC_ACQUIRE, "agent");
            xb_add(&bar[XB_XGEN(b.x)], 1u);
            asm volatile("s_waitcnt vmcnt(0)" ::: "memory");
        } else {
            XB_SPIN(xb_ld(&bar[XB_XGEN(b.x)]) == gen, bar);
            __builtin_amdgcn_fence(__ATOMIC_ACQUIRE, "agent");
            asm volatile("s_waitcnt vmcnt(0)" ::: "memory");
        }
    }
    __syncthreads();
}

DI float bf2f(unsigned short x) { return __uint_as_float((unsigned)x << 16); }
DI float bflo(unsigned u) { return __uint_as_float(u << 16); }
DI float bfhi(unsigned u) { return __uint_as_float(u & 0xffff0000u); }
DI unsigned pk2(float lo, float hi) { f32x2 v = {lo, hi}; bf16x2v b = __builtin_convertvector(v, bf16x2v); return __builtin_bit_cast(unsigned, b); }
constexpr float S_W8 = 256.0f, S_H8 = 16.0f, S_A8 = 4.0f, S_Y8 = 16.0f;
DI unsigned pk4_fp8(float a, float b, float c, float d) { int v = __builtin_amdgcn_cvt_pk_fp8_f32(a, b, 0, false); v = __builtin_amdgcn_cvt_pk_fp8_f32(c, d, v, true); return (unsigned)v; }
DI unsigned pk2_fp8(float a, float b) { return (unsigned)__builtin_amdgcn_cvt_pk_fp8_f32(a, b, 0, false) & 0xffffu; }
DI float sat8(float x, float lim) { return fminf(fmaxf(x, -lim), lim); }
DI float opq(float c) { asm volatile("" : "+v"(c)); return c; }
DI float opq_s(float c) { asm volatile("" : "+s"(c)); return c; }
DI void ld4(const bf16_t* p, float (&o)[4]) { const u32x2 u = *(const u32x2*)p; o[0] = bflo(u.x); o[1] = bfhi(u.x); o[2] = bflo(u.y); o[3] = bfhi(u.y); }
DI void st4(bf16_t* p, const float (&v)[4]) { u32x2 u; u.x = pk2(v[0], v[1]); u.y = pk2(v[2], v[3]); *(u32x2*)p = u; }
DI void ld8(const bf16_t* p, float (&o)[8]) { const u32x4 u = *(const u32x4*)p; o[0] = bflo(u.x); o[1] = bfhi(u.x); o[2] = bflo(u.y); o[3] = bfhi(u.y); o[4] = bflo(u.z); o[5] = bfhi(u.z); o[6] = bflo(u.w); o[7] = bfhi(u.w); }
DI void st8(bf16_t* p, const float (&v)[8]) { u32x4 u; u.x = pk2(v[0], v[1]); u.y = pk2(v[2], v[3]); u.z = pk2(v[4], v[5]); u.w = pk2(v[6], v[7]); *(u32x4*)p = u; }
template <int CTRL> DI float dpp_f(float v) { return __int_as_float(__builtin_amdgcn_update_dpp(0, __float_as_int(v), CTRL, 0xf, 0xf, true)); }
DI float sum8_dpp(float v) { v += dpp_f<0xB1>(v); v += dpp_f<0x4E>(v); v += dpp_f<0x141>(v); return v; }
DI float xor32_f(float v) { auto rr = __builtin_amdgcn_permlane32_swap(__float_as_uint(v), __float_as_uint(v), false, false); return __uint_as_float((threadIdx.x & 32) ? rr[0] : rr[1]); }
DI float wave_sum(float v) {
    v = sum8_dpp(v); v += dpp_f<0x140>(v);
    const float r0 = __int_as_float(__builtin_amdgcn_readlane(__float_as_int(v), 0)), r1 = __int_as_float(__builtin_amdgcn_readlane(__float_as_int(v), 16));
    const float r2 = __int_as_float(__builtin_amdgcn_readlane(__float_as_int(v), 32)), r3 = __int_as_float(__builtin_amdgcn_readlane(__float_as_int(v), 48));
    return (r0 + r1) + (r2 + r3);
}
DI float silu(float x) { return x / (1.0f + __expf(-x)); }
#define MFMA32(a, b, c) __builtin_amdgcn_mfma_f32_32x32x16_bf16((a), (b), (c), 0, 0, 0)
DI f32x16 mfma32_c(bf16x8 a, bf16x8 b, const f32x16& c) { f32x16 d; asm("v_mfma_f32_32x32x16_bf16 %0, %1, %2, %3" : "=&v"(d) : "v"(a), "v"(b), "v"(c)); return d; }
DI int crow(int reg, int h) { return (reg & 3) + 8 * (reg >> 2) + 4 * h; }
DI s16x4 trread(LAS unsigned char* p) { return __builtin_bit_cast(s16x4, __builtin_amdgcn_ds_read_tr16_b64_v4i16((LAS v4i16_t*)p)); }

struct Args { const float* in[25]; float* out; unsigned char* ws; int ph_lo, ph_hi; };
enum { I_X = 0, I_C, I_CTX, I_CCTX, I_ADAW, I_ADAB, I_NORMG, I_WIN, I_WOUT, I_RLD, I_RGNW, I_RGNB, I_DLAM, I_DSUB, I_GQKN, I_MQN, I_MKVN, I_MUQ, I_MUKV,
       I_RW, I_RB, I_EW1, I_EB1, I_EW2, I_EB2 };


DI int otid() { int t = threadIdx.x; asm volatile("" : "+v"(t)); return t; }
DI int obx() { int b = blockIdx.x; asm volatile("" : "+s"(b)); return b; }
#define CAS __attribute__((address_space(4)))
DI const CAS char* karg_base() { const CAS char* ka = (const CAS char*)__builtin_amdgcn_kernarg_segment_ptr(); asm volatile("" : "+s"(ka)); return ka; }
DI const float* kin(int i) { return *(const float* const CAS*)(karg_base() + 8 * i); }
DI float* kout() { return *(float* const CAS*)(karg_base() + 200); }
DI unsigned char* kws() { return *(unsigned char* const CAS*)(karg_base() + 208); }

DI unsigned char* wso(unsigned char* ws, size_t off) { asm volatile("" : "+s"(off)); return ws + off; }

DI const float* input_row(const Args& a, int row) {
    const int b = row / SP, pos = row - b * SP;
    return pos < NCTX ? kin(I_CTX) + ((size_t)b * NCTX + pos) * DM : kin(I_X) + ((size_t)b * SEQ + (pos - NCTX)) * DM;
}

DI void tconv_unit(const float* __restrict__ src, int ldn, int nvalid, bf16_t* __restrict__ dst, int k0, int n0) {
    const int tid_ = otid(), lane = tid_ & 63, w = __builtin_amdgcn_readfirstlane(tid_ >> 6);
    const int n = n0 + w * 64 + lane;
    if (n < nvalid) {
        const float* s = src + (size_t)k0 * ldn + n;
        float v[64];
#pragma unroll
        for (int j = 0; j < 64; ++j) v[j] = s[(size_t)j * ldn];
        bf16_t* d = dst + (size_t)n * DM + k0;
#pragma unroll
        for (int j = 0; j < 8; ++j) {
            u32x4 o; o.x = pk2(v[8 * j], v[8 * j + 1]); o.y = pk2(v[8 * j + 2], v[8 * j + 3]); o.z = pk2(v[8 * j + 4], v[8 * j + 5]); o.w = pk2(v[8 * j + 6], v[8 * j + 7]);
            *(u32x4*)(d + 8 * j) = o;
        }
    }
}

constexpr int CV_PITCH = 136;
DI void tconv_unit8(const float* __restrict__ src, int ldn, uint8_t* __restrict__ dst, int k0, int n0, LAS unsigned char* lds) {
    const int tid_ = otid(), lane = tid_ & 63, w = __builtin_amdgcn_readfirstlane(tid_ >> 6);
#pragma unroll 1
    for (int hf = 0; hf < 2; ++hf) {
        const float* sp = src + (size_t)(k0 + 64 * hf + 8 * w) * ldn + n0 + lane * 4;
        f32x4 v[32];
#pragma unroll
        for (int j = 0; j < 32; ++j) v[j] = *(const f32x4*)(sp + (size_t)(j >> 2) * ldn + (j & 3) * 256);
        __builtin_amdgcn_sched_barrier(0);
        LAS unsigned char* lp = lds + (4 * lane) * CV_PITCH + 64 * hf + 8 * w;
#pragma unroll
        for (int q = 0; q < 4; ++q)
#pragma unroll
            for (int c = 0; c < 4; ++c) {
                u32x2 o;
                o.x = pk4_fp8(v[0 + q][c] * S_W8, v[4 + q][c] * S_W8, v[8 + q][c] * S_W8, v[12 + q][c] * S_W8);
                o.y = pk4_fp8(v[16 + q][c] * S_W8, v[20 + q][c] * S_W8, v[24 + q][c] * S_W8, v[28 + q][c] * S_W8);
                *(LAS u32x2*)(lp + (256 * q + c) * CV_PITCH) = o;
            }
    }
    __syncthreads();
    {
        const int t = otid(), r0 = t >> 3, ch = t & 7;
        uint8_t* dp = dst + (size_t)(n0 + r0) * DM + k0 + ch * 16;
        const LAS unsigned char* lp = lds + r0 * CV_PITCH + ch * 16;
#pragma unroll 4
        for (int p = 0; p < 16; ++p) {
            const u32x2 x = *(const LAS u32x2*)(lp + p * 64 * CV_PITCH), y = *(const LAS u32x2*)(lp + p * 64 * CV_PITCH + 8);
            *(u32x4*)(dp + (size_t)p * 64 * DM) = (u32x4){x.x, x.y, y.x, y.y};
        }
    }
    __syncthreads();
}

DI void conv_experts(int l, LAS unsigned char* lds) {
    constexpr int U_W1 = NE * 8 * 2, U_W2 = NE * 8;
    unsigned char* ws = kws();
    __syncthreads();
    for (int v = obx(); v < U_W1 + U_W2; v += gridDim.x) {
        if (v < U_W1) { const int e = v / 16, r = v % 16, kt = r / 2, nt = r % 2;
            tconv_unit8(kin(I_EW1) + ((size_t)l * NE + e) * DM * DFF2, DFF2, (uint8_t*)(wso(ws, WS_W1)) + ((size_t)l * NE + e) * DFF2 * DM, kt * 128, nt * 1024, lds); }
        else { const int v2 = v - U_W1, e = v2 / 8, kt = v2 % 8;
            tconv_unit8(kin(I_EW2) + ((size_t)l * NE + e) * DM * DM, DM, (uint8_t*)(wso(ws, WS_W2)) + ((size_t)l * NE + e) * DM * DM, kt * 128, 0, lds); }
    }
}

DI void p0_prologue(const Args& a, LAS unsigned char* lds) {
    const int tid = otid(), lane = tid & 63, w = __builtin_amdgcn_readfirstlane(tid >> 6), G = gridDim.x, bx = obx();
    unsigned char* ws = kws();
    {
        constexpr int U_WIN = 16 * 6, U_WOUT = 16 * 2, U_L = U_WIN + U_WOUT;
        for (int u = bx; u < NL * U_L; u += G) {
            const int l = u / U_L; int v = u - l * U_L;
            if (v < U_WIN) { const int kt = v / 6, nt = v % 6;
                tconv_unit(kin(I_WIN) + (size_t)l * DM * NIN, NIN, NIN, (bf16_t*)(wso(ws, WS_WIN)) + (size_t)l * NP * DM, kt * 64, nt * 512); continue; }
            v -= U_WIN;
            { const int kt = v / 2, nt = v % 2;
                tconv_unit(kin(I_WOUT) + (size_t)l * DM * DM, DM, DM, (bf16_t*)(wso(ws, WS_WOUT)) + (size_t)l * DM * DM, kt * 64, nt * 512); }
        }
    }
    {
        LAS float* sv = (LAS float*)lds;
        LAS float* red = (LAS float*)(lds + 9 * 1024 * 4);
        for (int i = tid; i < 9 * 1024; i += NTHR) { const int v = i >> 10, k = i & 1023; const float c = v < 8 ? kin(I_C)[v * DM + k] : kin(I_CCTX)[k]; sv[i] = silu(c); }
        __syncthreads();
        for (int it = bx; it < NL * 64; it += G) {
            const int l = it >> 6, n0 = (it & 63) * 96;
            const float* wp = kin(I_ADAW) + (size_t)l * DM * 6144 + (size_t)(w * 128) * 6144 + n0 + (lane < 48 ? lane : 47) * 2;
            f32x2 acc[9];
#pragma unroll
            for (int v = 0; v < 9; ++v) acc[v] = (f32x2){0.f, 0.f};
#pragma unroll 1
            for (int kb = 0; kb < 128; kb += 64) {
                f32x2 wv[64];
#pragma unroll
                for (int j = 0; j < 64; ++j) wv[j] = *(const f32x2*)(wp + (size_t)(kb + j) * 6144);
                __builtin_amdgcn_sched_barrier(0);
                LAS float* sk = sv + w * 128 + kb;
#pragma unroll
                for (int j = 0; j < 64; j += 2)
#pragma unroll
                    for (int v = 0; v < 9; ++v) { const f32x2 s2 = *(LAS f32x2*)(sk + v * 1024 + j); acc[v] += wv[j] * s2.x; acc[v] += wv[j + 1] * s2.y; }
            }
            if (lane < 48) {
#pragma unroll
                for (int v = 0; v < 9; ++v) *(LAS f32x2*)(red + (w * 9 + v) * 96 + lane * 2) = acc[v]; }
            __syncthreads();
            for (int i = tid; i < 9 * 96; i += NTHR) {
                const int v = i / 96, c = i - v * 96; float s_ = 0.f;
#pragma unroll
                for (int ww = 0; ww < 8; ++ww) s_ += red[(ww * 9 + v) * 96 + c];
                ((float*)(wso(ws, WS_MOD)))[((size_t)l * 9 + v) * 6144 + n0 + c] = s_ + kin(I_ADAB)[l * 6144 + n0 + c];
            }
            __syncthreads();
        }
    }
    __syncthreads();
    {
        constexpr int NQ = NL * 384 * 24, NKV = NL * 512 * 16;
        for (int i = bx * NTHR + tid; i < NQ + NKV; i += G * NTHR) {
            const bool isq = i < NQ; const int j = isq ? i : i - NQ;
            const int K = isq ? 192 : 128, N = isq ? 384 : 512, k8 = j % (K / 8), n = (j / (K / 8)) % N, l = j / ((K / 8) * N);
            const float* wu = (isq ? kin(I_MUQ) : kin(I_MUKV)) + (size_t)l * K * N + n; const float* nr = (isq ? kin(I_MQN) : kin(I_MKVN)) + l * K;
            float v[8];
#pragma unroll
            for (int q = 0; q < 8; ++q) v[q] = wu[(size_t)(k8 * 8 + q) * N] * nr[k8 * 8 + q];
            bf16_t* dq = (bf16_t*)(wso(ws, WS_WUQ)); bf16_t* dkv = (bf16_t*)(wso(ws, WS_WUKV));
            st8((isq ? dq : dkv) + ((size_t)l * N + n) * K + k8 * 8, v);
        }
    }
    for (int r = bx; r < NL * (NG1 - NIN); r += G) { const int l = r / (NG1 - NIN), rr = r % (NG1 - NIN); ((unsigned*)((bf16_t*)(wso(ws, WS_WIN)) + ((size_t)l * NP + NIN + rr) * DM))[tid] = 0u; }
    if (bx == G - 1) {
        f32x2* r64 = (f32x2*)(wso(ws, WS_TAB) + TAB_R64); f32x2* r32 = (f32x2*)(wso(ws, WS_TAB) + TAB_R32);
        for (int i = tid; i < 64 * 16; i += NTHR) { const int p = i >> 4, f = i & 15; const float inv = powf(10000.0f, -(float)f / 16.0f); const float ang = (float)p * inv; r64[i] = (f32x2){cosf(ang), sinf(ang)}; }
        for (int i = tid; i < 64 * 8; i += NTHR) { const int p = i >> 3, f = i & 7; const float inv = powf(10000.0f, -(float)f / 8.0f); const float ang = (float)p * inv; r32[i] = (f32x2){cosf(ang), sinf(ang)}; }
        if (tid < NL) {
            const float* lp = kin(I_DLAM) + tid * 4 * 32; float s1 = 0.f, s2 = 0.f;
            for (int i = 0; i < 32; ++i) { s1 += lp[i] * lp[32 + i]; s2 += lp[64 + i] * lp[96 + i]; }
            const float lam_init = 0.8f - 0.6f * expf(-0.3f * (float)tid);
            ((float*)(wso(ws, WS_TAB) + TAB_LAM))[tid] = expf(s1) - expf(s2) + lam_init;
        }
    }
}

struct Row16 { f32x4 v[4]; };
DI Row16 ld_f32row(const float* p, int lane) { Row16 r;
#pragma unroll
    for (int i = 0; i < 4; ++i) r.v[i] = *(const f32x4*)(p + i * 256 + lane * 4);
    return r; }
DI void st_f32row(float* p, int lane, const Row16& r) {
#pragma unroll
    for (int i = 0; i < 4; ++i) *(f32x4*)(p + i * 256 + lane * 4) = r.v[i]; }
DI Row16 ld_bf16row(const bf16_t* p, int lane) { Row16 r;
#pragma unroll
    for (int i = 0; i < 4; ++i) { const u32x2 u = *(const u32x2*)(p + i * 256 + lane * 4); r.v[i] = (f32x4){bflo(u.x), bfhi(u.x), bflo(u.y), bfhi(u.y)}; }
    return r; }
DI void st_bf16row(bf16_t* p, int lane, const Row16& r) {
#pragma unroll
    for (int i = 0; i < 4; ++i) { u32x2 u; u.x = pk2(r.v[i][0], r.v[i][1]); u.y = pk2(r.v[i][2], r.v[i][3]); *(u32x2*)(p + i * 256 + lane * 4) = u; } }
DI float row_ss(const Row16& r) { float s = 0.f;
#pragma unroll
    for (int i = 0; i < 4; ++i) s += r.v[i][0] * r.v[i][0] + r.v[i][1] * r.v[i][1] + r.v[i][2] * r.v[i][2] + r.v[i][3] * r.v[i][3];
    return wave_sum(s); }
typedef const __attribute__((address_space(1))) f32x4* gv4p;
DI Row16 modulate_row(const Row16& x, const float* g, const float* shift, const float* scale, int lane) {
    f32x4 gv[4], sh[4], sc[4];
#pragma unroll
    for (int i = 0; i < 4; ++i) { gv[i] = *(gv4p)(g + i * 256 + lane * 4); sh[i] = *(gv4p)(shift + i * 256 + lane * 4); sc[i] = *(gv4p)(scale + i * 256 + lane * 4); }
    const float rstd = rsqrtf(row_ss(x) * (1.0f / DM) + opq(EPS)); Row16 h;
#pragma unroll
    for (int i = 0; i < 4; ++i) h.v[i] = x.v[i] * rstd * gv[i] * (sc[i] + 1.0f) + sh[i];
    return h; }

DI void p_norm0(const Args& a) {
    const int tid = otid(), lane = tid & 63, w = __builtin_amdgcn_readfirstlane(tid >> 6);
    const float* mod = (const float*)(wso(kws(), WS_MOD));
    for (int row = obx() * 8 + w; row < T; row += gridDim.x * 8) {
        const int b = row / SP, pos = row - b * SP; const float* m = mod + (size_t)(pos < NCTX ? 8 : b) * 6144;
        const Row16 x = ld_f32row(input_row(a, row), lane);
        const Row16 h = modulate_row(x, kin(I_NORMG), m, m + 1024, lane);
        st_bf16row((bf16_t*)(wso(kws(), WS_H)) + (size_t)row * DM, lane, h);
    }
}

constexpr int RA_WR = 0, RA_WRP = 1028, RA_SCR = 32 * RA_WRP * 4  , RA_SCRW = 320, RA_RECE = RA_SCR + 8 * RA_SCRW, RA_RECG = RA_RECE + 2176,
              RA_CNT = RA_RECG + 2176, RA_BASE = RA_CNT + 128, RA_RB = RA_BASE + 128, RA_CC = RA_RB + 128, RA_CB = RA_CC + 4096, RA_END = RA_CB + 4096;
static_assert(RA_END <= LDS_XB, "lds");
constexpr int ROWS_PER_BLK = 136;

struct RowAIn { Row16 x; u32x2 y[4]; };
DI RowAIn rowA_load(const Args& a, int l, int row, int lane) {
    RowAIn r; unsigned char* ws = kws();
    if (l == 0) r.x = ld_f32row(input_row(a, row), lane);
    else { const bf16_t* xp = (const bf16_t*)(wso(ws, WS_XS)) + (size_t)row * DM;
#pragma unroll
        for (int i = 0; i < 4; ++i) { const u32x2 u = *(const u32x2*)(xp + i * 256 + lane * 4); r.x.v[i] = (f32x4){__uint_as_float(u.x), __uint_as_float(u.y), 0.f, 0.f}; } }
    const bf16_t* yp = (const bf16_t*)(wso(ws, WS_YO)) + (size_t)row * DM;
#pragma unroll
    for (int i = 0; i < 4; ++i) r.y[i] = *(const u32x2*)(yp + i * 256 + lane * 4);
    return r;
}
DI void rowA_route(int lane, LAS float* scr, bool present, bool valid, int rlq, LAS int* rece, LAS float* recg, LAS int* cnt) {
    if (!present) return;
    if (!valid) { if (lane < 4) rece[rlq * 4 + lane] = -1; return; }
    asm volatile("" ::: "memory");
    const int e_own = lane >> 1;
    const float logit = scr[e_own];
    int rank = 0;
#pragma unroll
    for (int e4 = 0; e4 < 8; ++e4) { const f32x4 o = *(LAS f32x4*)(scr + 4 * e4);
#pragma unroll
        for (int j = 0; j < 4; ++j) rank += (o[j] > logit || (o[j] == logit && 4 * e4 + j < e_own)) ? 1 : 0; }
    if ((lane & 1) == 0 && rank < 4) { scr[32 + rank] = logit; scr[36 + rank] = __int_as_float(e_own); }
    asm volatile("" ::: "memory");
    const f32x4 tv = *(LAS f32x4*)(scr + 32);
    const float e0 = 1.0f, e1 = __expf(tv[1] - tv[0]), e2 = __expf(tv[2] - tv[0]), e3 = __expf(tv[3] - tv[0]), inv = 1.0f / (e0 + e1 + e2 + e3);
    if (lane < 4) {
        const int e = __float_as_int(scr[36 + lane]);
        const float g = (lane == 0 ? e0 : lane == 1 ? e1 : lane == 2 ? e2 : e3) * inv;
        const int lp = __hip_atomic_fetch_add(&cnt[e], 1, __ATOMIC_RELAXED, __HIP_MEMORY_SCOPE_WORKGROUP);
        rece[rlq * 4 + lane] = (e << 16) | lp; recg[rlq * 4 + lane] = g;
    }
    asm volatile("" ::: "memory");
}
DI void p_rowA(const Args& a, int l, LAS unsigned char* lds, bool dry = false) {
    const int tid = otid(), lane = tid & 63, w = __builtin_amdgcn_readfirstlane(tid >> 6);
    const bool last = (l == NL - 1);
    unsigned char* ws = kws();
    LAS float* wr = (LAS float*)(lds + RA_WR);
    LAS float* scr = (LAS float*)(lds + RA_SCR + w * RA_SCRW);
    LAS int* rece = (LAS int*)(lds + RA_RECE); LAS float* recg = (LAS float*)(lds + RA_RECG);
    LAS int* cnt = (LAS int*)(lds + RA_CNT); LAS int* base = (LAS int*)(lds + RA_BASE);
    {   const float* rw = kin(I_RW) + (size_t)l * DM * NE;
#pragma unroll 1
        for (int i0 = 0; i0 < DM * NE; i0 += 16 * NTHR) { float t[16];
#pragma unroll
            for (int j = 0; j < 16; ++j) t[j] = rw[i0 + j * NTHR + tid];
#pragma unroll
            for (int j = 0; j < 16; ++j) { const int i = i0 + j * NTHR + tid; wr[(i & 31) * RA_WRP + (i >> 5)] = t[j]; } }
        if (tid < 32) { cnt[tid] = 0; ((LAS float*)(lds + RA_RB))[tid] = kin(I_RB)[l * NE + tid]; }
    }
    __syncthreads();
    const float* mod = (const float*)(wso(ws, WS_MOD)) + (size_t)l * 9 * 6144;
    const float* ng = kin(I_NORMG) + (size_t)l * 4 * DM;
    LAS float* rb = (LAS float*)(lds + RA_RB);
    int* gcur = (int*)(wso(ws, WS_CTL) + (dry ? 49152 : CTL_GCUR)) + l * NE * (dry ? 16 : 64);
    const int gstride = dry ? 16 : 64;
    bf16_t* XSo = (bf16_t*)(ws + (dry ? WS_ACT : WS_XS)); uint8_t* Ho = (uint8_t*)(ws + (dry ? WS_YR : WS_H8));
    unsigned char* LSo = ws + (dry ? WS_YR + ((size_t)100 << 20) : WS_LIST);
    for (int chunk = obx(); chunk * ROWS_PER_BLK < T; chunk += gridDim.x) {
        const int row0 = chunk * ROWS_PER_BLK;
        Row16 cA;
        LAS float* cCl = (LAS float*)(lds + RA_CC); LAS float* cBl = (LAS float*)(lds + RA_CB);
        const bool cctx = (row0 % SP) < NCTX;
        {   const float* mL = mod + (size_t)(cctx ? 8 : row0 / SP) * 6144;
#pragma unroll
            for (int i = 0; i < 4; ++i) { const int o = i * 256 + lane * 4;
                cA.v[i] = *(const f32x4*)(mL + 2048 + o) * *(const f32x4*)(ng + DM + o); }
            __syncthreads();
            if (tid < 256) *(LAS f32x4*)(cCl + tid * 4) = *(const f32x4*)(mL + 3072 + tid * 4);
            else *(LAS f32x4*)(cBl + (tid - 256) * 4) = *(const f32x4*)(ng + 2 * DM + (tid - 256) * 4) * (*(const f32x4*)(mL + 4096 + (tid - 256) * 4) + 1.0f);
            __syncthreads(); }
        RowAIn cur[2];
        cur[0] = rowA_load(a, l, row0 + w, lane); cur[1] = rowA_load(a, l, row0 + w + 8, lane);
#pragma unroll 1
        for (int rl = w; rl < ROWS_PER_BLK; rl += 16) {
            const bool two = rl + 8 < ROWS_PER_BLK;
            RowAIn nxt[2];
            {   const int n0 = rl + 16 < ROWS_PER_BLK ? rl + 16 : rl, n1 = rl + 24 < ROWS_PER_BLK ? rl + 24 : n0;
                nxt[0] = rowA_load(a, l, row0 + n0, lane); nxt[1] = rowA_load(a, l, row0 + n1, lane); }
            asm volatile("" : "+s"(ng), "+s"(mod));
            Row16 h[2]; bool valid[2];
#pragma unroll
            for (int q = 0; q < 2; ++q) {
                const int rlq = rl + 8 * q, row = row0 + (q == 0 || two ? rlq : rl), b = row / SP, pos = row - b * SP; const bool isctx = pos < NCTX;
                valid[q] = (q == 0 || two) && !(last && isctx);
                const float* m = mod + (size_t)(isctx ? 8 : b) * 6144;
                Row16 x = cur[q].x, y;
                if (l != 0) {
#pragma unroll
                    for (int i = 0; i < 4; ++i) { const unsigned u0 = __float_as_uint(cur[q].x.v[i][0]), u1 = __float_as_uint(cur[q].x.v[i][1]); x.v[i] = (f32x4){bflo(u0), bfhi(u0), bflo(u1), bfhi(u1)}; } }
#pragma unroll
                for (int i = 0; i < 4; ++i) y.v[i] = (f32x4){bflo(cur[q].y[i].x), bfhi(cur[q].y[i].x), bflo(cur[q].y[i].y), bfhi(cur[q].y[i].y)};
                const float rstd = rsqrtf(row_ss(y) * (1.0f / DM) + opq(EPS));
                if (isctx != cctx) {
#pragma unroll
                    for (int i = 0; i < 4; ++i) { const f32x4 g1 = *(gv4p)(ng + DM + i * 256 + lane * 4), ga = *(gv4p)(m + 2048 + i * 256 + lane * 4);
                        x.v[i] = x.v[i] + ga * (y.v[i] * rstd * g1); }
                    h[q] = modulate_row(x, ng + 2 * DM, m + 3072, m + 4096, lane);
                } else {
#pragma unroll
                    for (int i = 0; i < 4; ++i) x.v[i] = x.v[i] + cA.v[i] * (y.v[i] * rstd);
                    const float rs2 = rsqrtf(row_ss(x) * (1.0f / DM) + opq(EPS));
#pragma unroll
                    for (int i = 0; i < 4; ++i) h[q].v[i] = x.v[i] * rs2 * *(LAS f32x4*)(cBl + i * 256 + lane * 4) + *(LAS f32x4*)(cCl + i * 256 + lane * 4);
                }
                if (valid[q]) { st_bf16row(XSo + (size_t)row * DM, lane, x);
#pragma unroll
                    for (int i = 0; i < 4; ++i) { const float lim = opq(448.0f); *(unsigned*)(Ho + (size_t)row * DM + i * 256 + lane * 4) = pk4_fp8(sat8(h[q].v[i][0] * S_H8, lim), sat8(h[q].v[i][1] * S_H8, lim), sat8(h[q].v[i][2] * S_H8, lim), sat8(h[q].v[i][3] * S_H8, lim)); } }
                __builtin_amdgcn_sched_barrier(0);
            }
            LAS float* scr1 = scr + 40;
#pragma unroll 1
            for (int c = 0; c < 4; ++c) {
                float v0[8], v1[8];
                LAS float* wc_ = wr + (8 * c) * RA_WRP + lane * 4;
#pragma unroll
                for (int e = 0; e < 8; ++e) { f32x2 s0 = {0.f, 0.f}, s1 = {0.f, 0.f};
#pragma unroll
                    for (int i = 0; i < 4; ++i) { const f32x4 wv = *(LAS f32x4*)(wc_ + e * RA_WRP + i * 256);
                        const f32x2 wa = {wv[0], wv[1]}, wb = {wv[2], wv[3]};
                        s0 = __builtin_elementwise_fma((f32x2){h[0].v[i][0], h[0].v[i][1]}, wa, s0); s0 = __builtin_elementwise_fma((f32x2){h[0].v[i][2], h[0].v[i][3]}, wb, s0);
                        s1 = __builtin_elementwise_fma((f32x2){h[1].v[i][0], h[1].v[i][1]}, wa, s1); s1 = __builtin_elementwise_fma((f32x2){h[1].v[i][2], h[1].v[i][3]}, wb, s1); }
                    v0[e] = s0.x + s0.y; v1[e] = s1.x + s1.y;
                    if (e & 1) __builtin_amdgcn_sched_barrier(0); }
#pragma unroll
                for (int e = 0; e < 4; ++e) { const bool up = lane & 32;
                    { const float snd = up ? v0[e] : v0[e + 4], keep = up ? v0[e + 4] : v0[e]; v0[e] = keep + xor32_f(snd); }
                    { const float snd = up ? v1[e] : v1[e + 4], keep = up ? v1[e + 4] : v1[e]; v1[e] = keep + xor32_f(snd); } }
#pragma unroll
                for (int e = 0; e < 2; ++e) { const bool up = lane & 16;
                    { const float snd = up ? v0[e] : v0[e + 2], keep = up ? v0[e + 2] : v0[e]; v0[e] = keep + __shfl_xor(snd, 16); }
                    { const float snd = up ? v1[e] : v1[e + 2], keep = up ? v1[e + 2] : v1[e]; v1[e] = keep + __shfl_xor(snd, 16); } }
                { const bool up = lane & 8;
                    { const float snd = up ? v0[0] : v0[1], keep = up ? v0[1] : v0[0]; v0[0] = keep + __shfl_xor(snd, 8); }
                    { const float snd = up ? v1[0] : v1[1], keep = up ? v1[1] : v1[0]; v1[0] = keep + __shfl_xor(snd, 8); } }
                float a0 = v0[0], a1 = v1[0];
                a0 = sum8_dpp(a0); a1 = sum8_dpp(a1);
                if ((lane & 7) == 0) { const int e = 8 * c + (lane >> 3); const float bv = rb[e]; scr[e] = a0 + bv; scr1[e] = a1 + bv; }
            }
            rowA_route(lane, scr, true, valid[0], rl, rece, recg, cnt);
            rowA_route(lane, scr1, two, valid[1], rl + 8, rece, recg, cnt);
            cur[0] = nxt[0]; cur[1] = nxt[1];
        }
        __syncthreads();
        if (tid < 32) { const int c = cnt[tid]; base[tid] = c ? atomicAdd(&gcur[tid * gstride], c) : 0; }
        __syncthreads();
        for (int i = tid; i < ROWS_PER_BLK * 4; i += NTHR) {
            const int ep = rece[i]; if (ep < 0) continue;
            const int e = ep >> 16, row = row0 + (i >> 2), posn = base[e] + (ep & 0xffff);
            ((int*)LSo)[(size_t)e * T + posn] = row;
            ((unsigned*)(LSo + (WS_RSLOT - WS_LIST)))[(size_t)row * 4 + (i & 3)] = ((unsigned)e << 24) | (unsigned)posn;
            ((float*)(LSo + (WS_RGATE - WS_LIST)))[(size_t)row * 4 + (i & 3)] = recg[i];
        }
        __syncthreads();
        if (tid < 32) cnt[tid] = 0;
        __syncthreads();
    }
}

constexpr int MOE_TST = 140416, MOE_CNT = MOE_TST + 256, MOE_TE = MOE_CNT + 128, MOE_TE_MAX = 640;
static_assert(MOE_TE + MOE_TE_MAX * 4 <= LDS_XB && 4 * T / 256 + NE <= MOE_TE_MAX, "lds");
DI void moe_tables(const Args& a, int l, LAS unsigned char* lds) {
    LAS int* tst = (LAS int*)(lds + MOE_TST); LAS int* cn = (LAS int*)(lds + MOE_CNT); LAS int* te = (LAS int*)(lds + MOE_TE);
    const int tid = otid();
    if (tid < NE) { const int* gcur = (const int*)(wso(kws(), WS_CTL) + CTL_GCUR) + (l * NE + tid) * 64; cn[tid] = __hip_atomic_load(gcur, __ATOMIC_RELAXED, __HIP_MEMORY_SCOPE_AGENT); }
    __syncthreads();
    if (tid == 0) { int s = 0; for (int e = 0; e < NE; ++e) { tst[e] = s; s += (cn[e] + 255) >> 8; } tst[NE] = s; }
    __syncthreads();
    if (tid < NE) { const int t1 = tst[tid + 1]; for (int rt = tst[tid]; rt < t1; ++rt) te[rt] = tid; }
    __syncthreads();
}

struct RowBIdx { u32x4 s; f32x4 g; };
struct RowBIn { unsigned y[4][4]; u32x2 x[4]; f32x4 g; };
DI RowBIdx rowB_idx(int row) { RowBIdx r; unsigned char* ws = kws(); r.s = *(const u32x4*)(wso(ws, WS_RSLOT) + (size_t)row * 16); r.g = *(const f32x4*)(wso(ws, WS_RGATE) + (size_t)row * 16); return r; }
DI RowBIn rowB_load(const RowBIdx& ix, int row, int lane, LAS int* tst) {
    RowBIn r; unsigned char* ws = kws();
#pragma unroll
    for (int k = 0; k < 4; ++k) {
        const unsigned s = ix.s[k]; const int e = (s >> 24) & 31, posn = s & 0xffffff; const size_t slot = (size_t)tst[e] * 256 + posn;
        const uint8_t* yp = (const uint8_t*)(wso(ws, WS_YR)) + slot * DM;
#pragma unroll
        for (int i = 0; i < 4; ++i) r.y[k][i] = *(const unsigned*)(yp + i * 256 + lane * 4);
    }
    { const bf16_t* xp = (const bf16_t*)(wso(ws, WS_XS)) + (size_t)row * DM;
#pragma unroll
      for (int i = 0; i < 4; ++i) r.x[i] = *(const u32x2*)(xp + i * 256 + lane * 4); }
    r.g = ix.g;
    return r;
}
DI void p_rowB(const Args& a, int l, LAS unsigned char* lds, bool dry = false) {
    const int tid = otid(), lane = tid & 63, w = __builtin_amdgcn_readfirstlane(tid >> 6);
    const bool last = (l == NL - 1);
    unsigned char* ws = kws();
    moe_tables(a, l, lds);
    LAS int* tst = (LAS int*)(lds + MOE_TST);
    const float* mod = (const float*)(wso(ws, WS_MOD)) + (size_t)l * 9 * 6144;
    const float* ng = kin(I_NORMG) + (size_t)l * 4 * DM;
    for (int chunk = obx(); chunk * ROWS_PER_BLK < T; chunk += gridDim.x) {
        const int row0 = chunk * ROWS_PER_BLK, b = row0 / SP;
        Row16 dA, dB, dC;
        const bool cctx = (row0 % SP) < NCTX;
        {   const float* mL = mod + (size_t)(cctx ? 8 : b) * 6144;
#pragma unroll
            for (int i = 0; i < 4; ++i) { const int o = i * 256 + lane * 4;
                dA.v[i] = *(const f32x4*)(mL + 5120 + o) * *(const f32x4*)(ng + 3 * DM + o);
                if (!last) { dB.v[i] = *(const f32x4*)(ng + 4 * DM + o) * (*(const f32x4*)(mL + 9 * 6144 + 1024 + o) + 1.0f); dC.v[i] = *(const f32x4*)(mL + 9 * 6144 + o); }
                else { dB.v[i] = (f32x4){0.f, 0.f, 0.f, 0.f}; dC.v[i] = dB.v[i]; } } }
        const int rend = row0 + ROWS_PER_BLK;
        int row = row0 + w;
#define RB_SKIP(r) do { while ((r) < rend && last && ((r) % SP) < NCTX) (r) += 8; } while (0)
        RB_SKIP(row);
        int row1 = row + 8; RB_SKIP(row1);
        int row2 = row1 + 8; RB_SKIP(row2);
        RowBIdx ix1, ix2; RowBIn cur, nxt;
        if (row < rend) { const RowBIdx ix0 = rowB_idx(row); cur = rowB_load(ix0, row, lane, tst); }
        if (row1 < rend) ix1 = rowB_idx(row1);
#pragma unroll 1
        while (row < rend) {
            if (row2 < rend) ix2 = rowB_idx(row2);
            if (row1 < rend) nxt = rowB_load(ix1, row1, lane, tst);
            const int pos = row - b * SP; const bool isctx = pos < NCTX;
            Row16 y;
#pragma unroll
            for (int i = 0; i < 4; ++i) y.v[i] = (f32x4){0.f, 0.f, 0.f, 0.f};
#pragma unroll
            for (int k = 0; k < 4; ++k) {
                const float g = cur.g[k] * (1.0f / S_Y8);
#pragma unroll
                for (int i = 0; i < 4; ++i) { const f32x2 lo = __builtin_amdgcn_cvt_pk_f32_fp8((int)cur.y[k][i], false), hi = __builtin_amdgcn_cvt_pk_f32_fp8((int)cur.y[k][i], true); y.v[i] = y.v[i] + (f32x4){lo.x, lo.y, hi.x, hi.y} * g; }
            }
            const float rstd = rsqrtf(row_ss(y) * (1.0f / DM) + opq(EPS));
            Row16 x, h;
#pragma unroll
            for (int i = 0; i < 4; ++i) x.v[i] = (f32x4){bflo(cur.x[i].x), bfhi(cur.x[i].x), bflo(cur.x[i].y), bfhi(cur.x[i].y)};
            if (isctx != cctx) {
                const float* m = mod + (size_t)(isctx ? 8 : b) * 6144;
#pragma unroll
                for (int i = 0; i < 4; ++i) { const f32x4 g3 = *(const f32x4*)(ng + 3 * DM + i * 256 + lane * 4), gf = *(const f32x4*)(m + 5120 + i * 256 + lane * 4);
                    x.v[i] = x.v[i] + gf * (y.v[i] * rstd * g3); }
                if (!last) { const float* m2 = m + 9 * 6144; h = modulate_row(x, ng + 4 * DM, m2, m2 + 1024, lane); }
            } else {
#pragma unroll
                for (int i = 0; i < 4; ++i) x.v[i] = x.v[i] + dA.v[i] * (y.v[i] * rstd);
                if (!last) { const float rs2 = rsqrtf(row_ss(x) * (1.0f / DM) + opq(EPS));
#pragma unroll
                    for (int i = 0; i < 4; ++i) h.v[i] = x.v[i] * rs2 * dB.v[i] + dC.v[i]; }
            }
            if (last) { st_f32row((dry ? (float*)(wso(ws, WS_ACT)) : kout()) + ((size_t)b * SEQ + (pos - NCTX)) * DM, lane, x); }
            else {
                st_bf16row((bf16_t*)(ws + (dry ? WS_ACT : WS_XS)) + (size_t)row * DM, lane, x);
                st_bf16row((bf16_t*)(ws + (dry ? WS_ACT + ((size_t)160 << 20) : WS_H)) + (size_t)row * DM, lane, h);
            }
            row = row1; row1 = row2; row2 = row2 + 8; RB_SKIP(row2);
            cur = nxt; ix1 = ix2;
        }
#undef RB_SKIP
    }
}

namespace gm {
constexpr int BK = 64, HALF = 128, HTB = HALF * BK * 2, NT = DM / BK;
DI int lds_byte(int r, int c) { const int st = (r >> 4) * 2 + (c >> 5), rr = r & 15, cc = c & 31, ob = rr * 64 + cc * 2; return st * 1024 + (ob ^ (((ob >> 9) & 1) << 5)); }
DI void stage_rc(int b, int& R, int& C) { const int st = b / 1024, sb = b % 1024, swz = sb ^ (((sb >> 9) & 1) << 5); R = (st >> 1) * 16 + swz / 64; C = (st & 1) * 32 + (swz % 64) / 2; }

DI int perm32(int rho) { const int n = rho >> 4, i = rho & 15; return 8 * (i >> 2) + 4 * n + (i & 3); }
typedef f32x4 Acc[2][2][4][2];

#define G_SA(b, h) (shm + ((b) * 2 + (h)) * HTB)
#define G_SB(b, h) (shm + (4 + (b) * 2 + (h)) * HTB)
#define G_STAGE(P, BASE, OFF, kt) do { _Pragma("unroll") for (int _i = 0; _i < 2; ++_i) \
    __builtin_amdgcn_global_load_lds((const unsigned*)((BASE) + (OFF)[_i] + (kt) * BK), (LAS unsigned*)((P) + wbase + _i * 8192), 16, 0, 0); } while (0)
#define G_LDA(dst, b, h) _Pragma("unroll") for (int m = 0; m < 4; ++m) _Pragma("unroll") for (int k = 0; k < 2; ++k) \
    dst[m][k] = *(LAS bf16x8*)(G_SA(b, h) + lds_byte(wr * 64 + m * 16 + fr, k * 32 + fq * 8))
#define G_LDB(dst, b, h) _Pragma("unroll") for (int n = 0; n < 2; ++n) _Pragma("unroll") for (int k = 0; k < 2; ++k) \
    dst[n][k] = *(LAS bf16x8*)(G_SB(b, h) + lds_byte(wc * 32 + n * 16 + fr, k * 32 + fq * 8))
#define G_MMA(ai, bj, At, Bx) do { __builtin_amdgcn_s_setprio(1); \
    _Pragma("unroll") for (int m = 0; m < 4; ++m) _Pragma("unroll") for (int n = 0; n < 2; ++n) _Pragma("unroll") for (int k = 0; k < 2; ++k) \
      acc[ai][bj][m][n] = __builtin_amdgcn_mfma_f32_16x16x32_bf16(Bx[n][k], At[m][k], acc[ai][bj][m][n], 0, 0, 0); \
    __builtin_amdgcn_s_setprio(0); } while (0)
#define G_WAITV(n) asm volatile("s_waitcnt vmcnt(" #n ")" ::: "memory")
#define G_WAITL(n) asm volatile("s_waitcnt lgkmcnt(" #n ")" ::: "memory")
#define G_BAR __builtin_amdgcn_s_barrier()
#define G_SCHED __builtin_amdgcn_sched_barrier(0)

struct UnitSrc { const bf16_t* A; const bf16_t* Bt; const float* bias; unsigned aoff[2][2]; };
#define G_STA(b, h, kt) do { _Pragma("unroll") for (int _i = 0; _i < 2; ++_i) \
    __builtin_amdgcn_global_load_lds((const unsigned*)(u.A + (GATHER ? u.aoff[h][_i] : (unsigned)((h) * HALF * DM) + toff[_i]) + (kt) * BK), (LAS unsigned*)(G_SA(b, h) + wbase + _i * 8192), 16, 0, 0); } while (0)
#define G_STB(b, h, kt) do { _Pragma("unroll") for (int _i = 0; _i < 2; ++_i) \
    __builtin_amdgcn_global_load_lds((const unsigned*)(u.Bt + (unsigned)((h) * HALF * DM) + tofb[_i] + (kt) * BK), (LAS unsigned*)(G_SB(b, h) + wbase + _i * 8192), 16, 0, 0); } while (0)
template <bool GATHER>
DI void gemm_head(LAS unsigned char* shm, const UnitSrc& u) {
    const int tid = otid(), wbase = __builtin_amdgcn_readfirstlane(tid >> 6) * 1024;
    unsigned toff[2], tofb[2]; { int r_, c_; stage_rc(tid * 16, r_, c_); toff[0] = r_ * DM + c_; tofb[0] = ((r_ & ~31) | perm32(r_ & 31)) * DM + c_; stage_rc(tid * 16 + 8192, r_, c_); toff[1] = r_ * DM + c_; tofb[1] = ((r_ & ~31) | perm32(r_ & 31)) * DM + c_; }
    G_STB(0, 0, 0); G_STA(0, 0, 0); G_STB(0, 1, 0); G_STA(0, 1, 0);
    G_STB(1, 0, 1); G_STA(1, 0, 1); G_STB(1, 1, 1);
}
template <bool GATHER>
DI void gemm_mainloop(LAS unsigned char* shm, const UnitSrc& u, Acc& acc) {
    const int tid = otid(), wbase = __builtin_amdgcn_readfirstlane(tid >> 6) * 1024;
    unsigned toff[2], tofb[2]; { int r_, c_; stage_rc(tid * 16, r_, c_); toff[0] = r_ * DM + c_; tofb[0] = ((r_ & ~31) | perm32(r_ & 31)) * DM + c_; stage_rc(tid * 16 + 8192, r_, c_); toff[1] = r_ * DM + c_; tofb[1] = ((r_ & ~31) | perm32(r_ & 31)) * DM + c_; }
    int wid = tid >> 6, lane = tid & 63, wr = wid >> 2, wc = wid & 3, fr = lane & 15, fq = lane >> 4;
    {   f32x4 bv[2][2];
#pragma unroll
        for (int i1 = 0; i1 < 2; ++i1)
#pragma unroll
            for (int i3 = 0; i3 < 2; ++i3) bv[i1][i3] = u.bias ? *(const f32x4*)(u.bias + i1 * 128 + wc * 32 + fq * 8 + i3 * 4) : (f32x4){0.f, 0.f, 0.f, 0.f};
#pragma unroll
        for (int i0 = 0; i0 < 2; ++i0)
#pragma unroll
            for (int i1 = 0; i1 < 2; ++i1)
#pragma unroll
                for (int i2 = 0; i2 < 4; ++i2)
#pragma unroll
                    for (int i3 = 0; i3 < 2; ++i3) acc[i0][i1][i2][i3] = bv[i1][i3];
    }
    bf16x8 At[4][2], B0[2][2], B1[2][2];
    G_WAITV(0);
    if (wr == 1) G_BAR;
    G_BAR; G_BAR;
#pragma unroll 1
    for (int t = 0; t < NT - 2; t += 2) {
        asm volatile(".p2align 6");
        G_LDB(B0, 0, 0); G_SCHED; G_LDA(At, 0, 0); G_STA(1, 1, t + 1);
        G_WAITL(8); G_BAR; G_WAITL(0); G_MMA(0, 0, At, B0); G_BAR; G_SCHED;
        G_LDB(B1, 0, 1); G_STB(0, 0, t + 2);
        G_BAR; G_WAITL(0); G_MMA(0, 1, At, B1); G_BAR;
        G_LDA(At, 0, 1); G_STA(0, 0, t + 2);
        G_BAR; G_WAITL(0); G_MMA(1, 0, At, B0); G_BAR; G_SCHED;
        G_STB(0, 1, t + 2);
        G_WAITV(6); G_BAR; G_MMA(1, 1, At, B1); G_BAR;
        G_LDB(B0, 1, 0); G_SCHED; G_LDA(At, 1, 0); G_STA(0, 1, t + 2);
        G_WAITL(8); G_BAR; G_WAITL(0); G_MMA(0, 0, At, B0); G_BAR; G_SCHED;
        G_LDB(B1, 1, 1); G_STB(1, 0, t + 3);
        G_BAR; G_WAITL(0); G_MMA(0, 1, At, B1); G_BAR;
        G_LDA(At, 1, 1); G_STA(1, 0, t + 3);
        G_BAR; G_WAITL(0); G_MMA(1, 0, At, B0); G_BAR; G_SCHED;
        G_STB(1, 1, t + 3);
        G_WAITV(6); G_BAR; G_MMA(1, 1, At, B1); G_BAR;
    }
    { G_LDB(B0, 0, 0); G_WAITV(0); G_LDA(At, 0, 0); G_STA(1, 1, NT - 1);
      G_BAR; G_WAITL(0); G_MMA(0, 0, At, B0); G_BAR;
      G_LDB(B1, 0, 1); G_BAR; G_WAITL(0); G_MMA(0, 1, At, B1); G_BAR;
      G_LDA(At, 0, 1); G_WAITV(4); G_BAR; G_WAITL(0); G_MMA(1, 0, At, B0); G_MMA(1, 1, At, B1); G_BAR; }
    { G_LDB(B0, 1, 0); G_LDA(At, 1, 0); G_WAITV(2); G_BAR; G_WAITL(0); G_MMA(0, 0, At, B0); G_BAR;
      G_LDB(B1, 1, 1); G_WAITV(0); G_BAR; G_WAITL(0); G_MMA(0, 1, At, B1); G_BAR;
      G_LDA(At, 1, 1); G_BAR; G_WAITL(0); G_MMA(1, 0, At, B0); G_MMA(1, 1, At, B1); G_BAR; }
    if (wr == 0) G_BAR;
}
typedef int v8i32 __attribute__((ext_vector_type(8)));
struct UnitSrc8 { const uint8_t* A; const uint8_t* Bt; const float* bias; float bscale; unsigned aoff[2][2]; };
constexpr int NT8 = DM / 128;
#define G_STA8(b, h, kt) do { _Pragma("unroll") for (int _i = 0; _i < 2; ++_i) \
    __builtin_amdgcn_global_load_lds((const unsigned*)(u.A + (GATHER ? u.aoff[h][_i] : (unsigned)((h) * HALF * DM) + toff[_i]) + (kt) * 128), (LAS unsigned*)(G_SA(b, h) + wbase + _i * 8192), 16, 0, 0); } while (0)
#define G_STB8(b, h, kt) do { _Pragma("unroll") for (int _i = 0; _i < 2; ++_i) \
    __builtin_amdgcn_global_load_lds((const unsigned*)(u.Bt + (unsigned)((h) * HALF * DM) + tofb[_i] + (kt) * 128), (LAS unsigned*)(G_SB(b, h) + wbase + _i * 8192), 16, 0, 0); } while (0)
DI v8i32 cat8(u32x4 a, u32x4 b) { v8i32 r; r[0] = a.x; r[1] = a.y; r[2] = a.z; r[3] = a.w; r[4] = b.x; r[5] = b.y; r[6] = b.z; r[7] = b.w; return r; }
#define G_LDA8(dst, b, h) _Pragma("unroll") for (int m = 0; m < 4; ++m) \
    dst[m] = cat8(*(LAS u32x4*)(G_SA(b, h) + lds_byte(wr * 64 + m * 16 + fr, 8 * fq)), *(LAS u32x4*)(G_SA(b, h) + lds_byte(wr * 64 + m * 16 + fr, 32 + 8 * fq)))
#define G_LDB8(dst, b, h) _Pragma("unroll") for (int n = 0; n < 2; ++n) \
    dst[n] = cat8(*(LAS u32x4*)(G_SB(b, h) + lds_byte(wc * 32 + n * 16 + fr, 8 * fq)), *(LAS u32x4*)(G_SB(b, h) + lds_byte(wc * 32 + n * 16 + fr, 32 + 8 * fq)))
#define G_MMA8(ai, bj, At, Bx) do { __builtin_amdgcn_s_setprio(1); \
    _Pragma("unroll") for (int m = 0; m < 4; ++m) _Pragma("unroll") for (int n = 0; n < 2; ++n) \
      asm volatile("v_mfma_scale_f32_16x16x128_f8f6f4 %0, %1, %2, %0, %3, %3 op_sel_hi:[0,0,0]" : "+v"(acc[ai][bj][m][n]) : "v"(Bx[n]), "v"(At[m]), "v"(one8)); \
    __builtin_amdgcn_s_setprio(0); } while (0)
template <bool GATHER>
DI void gemm_head8(LAS unsigned char* shm, const UnitSrc8& u) {
    const int tid = otid(), wbase = __builtin_amdgcn_readfirstlane(tid >> 6) * 1024;
    unsigned toff[2], tofb[2]; { int r_, c_; stage_rc(tid * 16, r_, c_); toff[0] = r_ * DM + 2 * c_; tofb[0] = ((r_ & ~31) | perm32(r_ & 31)) * DM + 2 * c_; stage_rc(tid * 16 + 8192, r_, c_); toff[1] = r_ * DM + 2 * c_; tofb[1] = ((r_ & ~31) | perm32(r_ & 31)) * DM + 2 * c_; }
    G_STB8(0, 0, 0); G_STA8(0, 0, 0); G_STB8(0, 1, 0); G_STA8(0, 1, 0);
    G_STB8(1, 0, 1); G_STA8(1, 0, 1); G_STB8(1, 1, 1);
}
constexpr int G_BIAS8 = 139264;
template <bool GATHER>
DI void gemm_mainloop8(LAS unsigned char* shm, const UnitSrc8& u, Acc& acc) {
    const int tid = otid(), wbase = __builtin_amdgcn_readfirstlane(tid >> 6) * 1024;
    unsigned toff[2], tofb[2]; { int r_, c_; stage_rc(tid * 16, r_, c_); toff[0] = r_ * DM + 2 * c_; tofb[0] = ((r_ & ~31) | perm32(r_ & 31)) * DM + 2 * c_; stage_rc(tid * 16 + 8192, r_, c_); toff[1] = r_ * DM + 2 * c_; tofb[1] = ((r_ & ~31) | perm32(r_ & 31)) * DM + 2 * c_; }
    int wid = tid >> 6, lane = tid & 63, wr = wid >> 2, wc = wid & 3, fr = lane & 15, fq = lane >> 4;
    v8i32 At[4], B0[2], B1[2];
    int one8 = 0x7F7F7F7F; asm volatile("" : "+v"(one8));
    G_WAITV(0);
    if (wr == 1) G_BAR;
    G_BAR;
    {   f32x4 bv[2][2];
#pragma unroll
        for (int i1 = 0; i1 < 2; ++i1)
#pragma unroll
            for (int i3 = 0; i3 < 2; ++i3) bv[i1][i3] = *(LAS f32x4*)(shm + G_BIAS8 + (i1 * 128 + wc * 32 + fq * 8 + i3 * 4) * 4);
#pragma unroll
        for (int i0 = 0; i0 < 2; ++i0)
#pragma unroll
            for (int i1 = 0; i1 < 2; ++i1)
#pragma unroll
                for (int i2 = 0; i2 < 4; ++i2)
#pragma unroll
                    for (int i3 = 0; i3 < 2; ++i3) acc[i0][i1][i2][i3] = bv[i1][i3];
    }
    G_BAR;
#pragma unroll 1
    for (int t = 0; t < NT8 - 2; t += 2) {
        asm volatile(".p2align 6");
        G_LDB8(B0, 0, 0); G_SCHED; G_LDA8(At, 0, 0); G_STA8(1, 1, t + 1);
        G_WAITL(8); G_BAR; G_WAITL(0); G_MMA8(0, 0, At, B0); G_BAR; G_SCHED;
        G_LDB8(B1, 0, 1); G_STB8(0, 0, t + 2);
        G_BAR; G_WAITL(0); G_MMA8(0, 1, At, B1); G_BAR;
        G_LDA8(At, 0, 1); G_STA8(0, 0, t + 2);
        G_BAR; G_WAITL(0); G_MMA8(1, 0, At, B0); G_BAR; G_SCHED;
        G_STB8(0, 1, t + 2);
        G_WAITV(6); G_BAR; G_MMA8(1, 1, At, B1); G_BAR;
        G_LDB8(B0, 1, 0); G_SCHED; G_LDA8(At, 1, 0); G_STA8(0, 1, t + 2);
        G_WAITL(8); G_BAR; G_WAITL(0); G_MMA8(0, 0, At, B0); G_BAR; G_SCHED;
        G_LDB8(B1, 1, 1); G_STB8(1, 0, t + 3);
        G_BAR; G_WAITL(0); G_MMA8(0, 1, At, B1); G_BAR;
        G_LDA8(At, 1, 1); G_STA8(1, 0, t + 3);
        G_BAR; G_WAITL(0); G_MMA8(1, 0, At, B0); G_BAR; G_SCHED;
        G_STB8(1, 1, t + 3);
        G_WAITV(6); G_BAR; G_MMA8(1, 1, At, B1); G_BAR;
    }
    { G_LDB8(B0, 0, 0); G_WAITV(0); G_LDA8(At, 0, 0); G_STA8(1, 1, NT8 - 1);
      G_BAR; G_WAITL(0); G_MMA8(0, 0, At, B0); G_BAR;
      G_LDB8(B1, 0, 1); G_BAR; G_WAITL(0); G_MMA8(0, 1, At, B1); G_BAR;
      G_LDA8(At, 0, 1); G_WAITV(4); G_BAR; G_WAITL(0); G_MMA8(1, 0, At, B0); G_MMA8(1, 1, At, B1); G_BAR; }
    { G_LDB8(B0, 1, 0); G_LDA8(At, 1, 0); G_WAITV(2); G_BAR; G_WAITL(0); G_MMA8(0, 0, At, B0); G_BAR;
      G_LDB8(B1, 1, 1); G_WAITV(0); G_BAR; G_WAITL(0); G_MMA8(0, 1, At, B1); G_BAR;
      G_LDA8(At, 1, 1); G_BAR; G_WAITL(0); G_MMA8(1, 0, At, B0); G_MMA8(1, 1, At, B1); G_BAR; }
    if (wr == 0) G_BAR;
}
#define G_EPI(epi, acc) do { const int tz_ = otid(); (epi)((acc), tz_ >> 8, (tz_ >> 6) & 3, tz_ & 15, (tz_ & 63) >> 4); } while (0)
DI int launder_s(int v) { asm volatile("" : "+s"(v)); return v; }

struct EpiBf16 {
    bf16_t* O; int ldo; int rbase, cbase; float scale;
    DI void operator()(const Acc& acc, int wr, int wc, int fr, int fq) const {
#pragma unroll
        for (int ai = 0; ai < 2; ++ai)
#pragma unroll
            for (int m = 0; m < 4; ++m) {
                bf16_t* rp = O + (size_t)(rbase + ai * 128 + wr * 64 + m * 16 + fr) * ldo + cbase + wc * 32 + fq * 8;
#pragma unroll
                for (int bj = 0; bj < 2; ++bj) {
                    const f32x4 v0 = acc[ai][bj][m][0] * scale, v1 = acc[ai][bj][m][1] * scale;
                    u32x4 o; o.x = pk2(v0[0], v0[1]); o.y = pk2(v0[2], v0[3]); o.z = pk2(v1[0], v1[1]); o.w = pk2(v1[2], v1[3]);
                    *(u32x4*)(rp + bj * 128) = o;
                }
            }
    }
};
struct EpiFp8 {
    uint8_t* O; int ldo; int rbase, cbase; float scale;
    DI void operator()(const Acc& acc, int wr, int wc, int fr, int fq) const {
#pragma unroll
        for (int ai = 0; ai < 2; ++ai)
#pragma unroll
            for (int m = 0; m < 4; ++m) {
                uint8_t* rp = O + (size_t)(rbase + ai * 128 + wr * 64 + m * 16 + fr) * ldo + cbase + wc * 32 + fq * 8;
#pragma unroll
                for (int bj = 0; bj < 2; ++bj) {
                    const f32x4 v0 = acc[ai][bj][m][0] * scale, v1 = acc[ai][bj][m][1] * scale;
                    const float lim = opq_s(448.0f);
#define SAT_(x) __builtin_amdgcn_fmed3f((x), -lim, lim)
                    u32x2 o; o.x = pk4_fp8(SAT_(v0[0]), SAT_(v0[1]), SAT_(v0[2]), SAT_(v0[3])); o.y = pk4_fp8(SAT_(v1[0]), SAT_(v1[1]), SAT_(v1[2]), SAT_(v1[3]));
#undef SAT_
                    *(u32x2*)(rp + bj * 128) = o;
                }
            }
    }
};
struct EpiSwiglu8 {
    uint8_t* O; int rbase, cbase;
    DI void operator()(const Acc& acc, int wr, int wc, int fr, int fq) const {
#pragma unroll
        for (int ai = 0; ai < 2; ++ai)
#pragma unroll
            for (int m = 0; m < 4; ++m) {
                uint8_t* rp = O + (size_t)(rbase + ai * 128 + wr * 64 + m * 16 + fr) * DM + ((cbase + wc * 32 + fq * 8) >> 1);
#pragma unroll
                for (int bj = 0; bj < 2; ++bj) {
                    float av[4];
#pragma unroll
                    for (int n = 0; n < 2; ++n) {
                        const f32x4 z = acc[ai][bj][m][n] * (1.0f / (S_H8 * S_W8));
                        const float c7 = opq_s(7.0f);
                        const float g0 = __builtin_fminf(z[0], c7), l0 = __builtin_amdgcn_fmed3f(z[1], -c7, c7), g1 = __builtin_fminf(z[2], c7), l1 = __builtin_amdgcn_fmed3f(z[3], -c7, c7);
                        av[2 * n] = g0 * __builtin_amdgcn_rcpf(1.0f + __builtin_amdgcn_exp2f(-1.702f * LOG2E * g0)) * __builtin_fmaf(l0, S_A8, S_A8);
                        av[2 * n + 1] = g1 * __builtin_amdgcn_rcpf(1.0f + __builtin_amdgcn_exp2f(-1.702f * LOG2E * g1)) * __builtin_fmaf(l1, S_A8, S_A8);
                    }
                    *(unsigned*)(rp + bj * 64) = pk4_fp8(av[0], av[1], av[2], av[3]);
                }
            }
    }
};
}

template <int WHICH>
DI void dense_unit(int u, bool skipctx, int& pm, int& pn) {
    constexpr int N = WHICH == 0 ? NG1 : DM, nN = N / 256;
    const int nM = skipctx ? NB * 16 : T / 256;
    const int grp = u / (8 * nN), rem = u - grp * 8 * nN, gsz = (nM - grp * 8) < 8 ? (nM - grp * 8) : 8;
    pm = grp * 8 + rem % gsz; pn = rem / gsz;
    if (skipctx) pm += pm / 16 + 1;
}
template <int WHICH>
DI void dense_src(int l, int u, bool skipctx, gm::UnitSrc& s) {
    constexpr int N = WHICH == 0 ? NG1 : DM, NROW = WHICH == 0 ? NP : DM;
    int pm, pn; dense_unit<WHICH>(u, skipctx, pm, pn);
    unsigned char* ws = kws();
    s.A = (const bf16_t*)(ws + (WHICH == 0 ? WS_H : WS_YC)) + (size_t)pm * 256 * DM;
    s.Bt = (const bf16_t*)(ws + (WHICH == 0 ? WS_WIN : WS_WOUT)) + ((size_t)l * NROW + pn * 256) * DM; s.bias = nullptr;
}
template <int WHICH>
DI void p_gemm_dense(int l, LAS unsigned char* lds) {
    constexpr int N = WHICH == 0 ? NG1 : DM, LDO = WHICH == 0 ? NP : DM, nN = N / 256;
    const bool skipctx = (WHICH == 1) && (l == NL - 1);
    const int nU = (skipctx ? NB * 16 : T / 256) * nN, G = gridDim.x;
    int u = obx();
    gm::UnitSrc cur{};
    if (u < nU) { dense_src<WHICH>(l, u, skipctx, cur); gm::gemm_head<false>(lds, cur); }
#pragma unroll 1
    while (u < nU) {
        gm::Acc acc;
        gm::gemm_mainloop<false>(lds, cur, acc);
        const int un = u + G;
        if (un < nU) { dense_src<WHICH>(l, un, skipctx, cur); gm::gemm_head<false>(lds, cur); }
        {   const int u2 = gm::launder_s(u); int pm, pn; dense_unit<WHICH>(u2, skipctx, pm, pn);
            const bool qtile = WHICH == 0 && (pn == C_RQ / 256 || pn == C_DQ / 256 || pn == C_GQ / 256);
            const size_t obase = WHICH == 1 ? WS_YO : !qtile ? WS_P : pn == C_RQ / 256 ? WS_QRET : pn == C_DQ / 256 ? WS_QD : WS_QG;
            gm::EpiBf16 epi{(bf16_t*)(kws() + obase), qtile ? 256 : LDO, pm * 256, qtile ? 0 : pn * 256, 1.0f};
            G_EPI(epi, acc);
        }
        u = un;
    }
    __syncthreads();
}

template <int WHICH> DI bool moe_unit(int u, int ntiles, int& rt, int& pn) {
    const int x = u & 7, v = u >> 3;
    if (WHICH == 1) { pn = 4 * (x & 1) + (v & 3); rt = 4 * (v >> 2) + (x >> 1); }
    else { pn = v & 3; rt = 8 * (v >> 2) + x; }
    return rt < ntiles;
}
template <int WHICH>
DI void moe_ptrs(int l, int rt, int pn, LAS unsigned char* lds, gm::UnitSrc8& s) {
    LAS int* te = (LAS int*)(lds + MOE_TE);
    const int e = te[rt];
    unsigned char* ws = kws();
    if (WHICH == 1) { s.A = (const uint8_t*)(wso(ws, WS_H8)); s.Bt = (const uint8_t*)(wso(ws, WS_W1)) + (((size_t)l * NE + e) * DFF2 + pn * 256) * DM; s.bias = kin(I_EB1) + ((size_t)l * NE + e) * DFF2 + pn * 256; s.bscale = S_H8 * S_W8; }
    else { s.A = (const uint8_t*)(wso(ws, WS_ACT)) + (size_t)rt * 256 * DM; s.Bt = (const uint8_t*)(wso(ws, WS_W2)) + (((size_t)l * NE + e) * DM + pn * 256) * DM; s.bias = kin(I_EB2) + ((size_t)l * NE + e) * DM + pn * 256; s.bscale = S_A8 * S_W8; }
}
DI u32x4 moe_gather(int rt, LAS unsigned char* lds) {
    LAS int* tst = (LAS int*)(lds + MOE_TST); LAS int* cn = (LAS int*)(lds + MOE_CNT); LAS int* te = (LAS int*)(lds + MOE_TE);
    const int e = te[rt], tz = otid();
    int r_[2], c_[2]; gm::stage_rc(tz * 16, r_[0], c_[0]); gm::stage_rc(tz * 16 + 8192, r_[1], c_[1]);
    const int* list = (const int*)(wso(kws(), WS_LIST)) + (size_t)e * T; const int c = cn[e], p0 = (rt - tst[e]) * 256;
    u32x4 o;
    { const int p = p0 + r_[0]; o.x = (unsigned)list[p < c ? p : 0]; }
    { const int p = p0 + r_[1]; o.y = (unsigned)list[p < c ? p : 0]; }
    { const int p = p0 + 128 + r_[0]; o.z = (unsigned)list[p < c ? p : 0]; }
    { const int p = p0 + 128 + r_[1]; o.w = (unsigned)list[p < c ? p : 0]; }
    return o;
}
DI u32x4 moe_gather_fix(u32x4 raw) {
    const int tz = otid(); int r_[2], c_[2]; gm::stage_rc(tz * 16, r_[0], c_[0]); gm::stage_rc(tz * 16 + 8192, r_[1], c_[1]);
    u32x4 o; o.x = raw.x * DM + 2 * c_[0]; o.y = raw.y * DM + 2 * c_[1]; o.z = raw.z * DM + 2 * c_[0]; o.w = raw.w * DM + 2 * c_[1];
    return o;
}
template <int WHICH>
DI void p_gemm_moe(const Args& a, int l, LAS unsigned char* lds) {
    moe_tables(a, l, lds);
    LAS int* tst = (LAS int*)(lds + MOE_TST);
    const int tid = otid();
    LAS u32x4* aslot = (LAS u32x4*)(lds + 131072) + tid;
    LAS f32x4* bslot = (LAS f32x4*)(lds + gm::G_BIAS8) + (tid & 63);
    const int ntiles = tst[NE], nU = WHICH == 1 ? ((ntiles + 3) >> 2) * 32 : ((ntiles + 7) >> 3) * 32, G = gridDim.x;
    int u = obx(), rt = 0, pn = 0;
    while (u < nU && !moe_unit<WHICH>(u, ntiles, rt, pn)) u += G;
    int un = u + G, rtn = 0, pnn = 0;
    while (un < nU && !moe_unit<WHICH>(un, ntiles, rtn, pnn)) un += G;
    gm::UnitSrc8 cur{};
    if (u < nU) {
        moe_ptrs<WHICH>(l, rt, pn, lds, cur);
        if (WHICH == 1) { const u32x4 g = moe_gather_fix(moe_gather(rt, lds)); cur.aoff[0][0] = g.x; cur.aoff[0][1] = g.y; cur.aoff[1][0] = g.z; cur.aoff[1][1] = g.w; }
        gm::gemm_head8<(WHICH == 1)>(lds, cur);
        if (tid < 64) *bslot = *(const f32x4*)(cur.bias + tid * 4) * cur.bscale;
        if (WHICH == 1 && un < nU) *aslot = moe_gather_fix(moe_gather(rtn, lds));
    }
#pragma unroll 1
    while (u < nU) {
        gm::Acc acc;
        gm::gemm_mainloop8<(WHICH == 1)>(lds, cur, acc);
        int unn = un + G, rtnn = 0, pnnn = 0;
        while (unn < nU && !moe_unit<WHICH>(unn, ntiles, rtnn, pnnn)) unn += G;
        u32x4 gnn = {0u, 0u, 0u, 0u}; f32x4 bn = {0.f, 0.f, 0.f, 0.f};
        if (un < nU) {
            moe_ptrs<WHICH>(l, rtn, pnn, lds, cur);
            if (WHICH == 1) { const u32x4 g = *((LAS u32x4*)(lds + 131072) + otid()); cur.aoff[0][0] = g.x; cur.aoff[0][1] = g.y; cur.aoff[1][0] = g.z; cur.aoff[1][1] = g.w; }
            gm::gemm_head8<(WHICH == 1)>(lds, cur);
            { const int t2 = otid(); if (t2 < 64) bn = *(const f32x4*)(cur.bias + t2 * 4); }
            if (WHICH == 1 && unn < nU) gnn = moe_gather(rtnn, lds);
        }
        __builtin_amdgcn_sched_barrier(0);
        {   const int u2 = gm::launder_s(u); int rt2, pn2; moe_unit<WHICH>(u2, ntiles, rt2, pn2);
            if (WHICH == 1) { gm::EpiSwiglu8 epi{(uint8_t*)(wso(kws(), WS_ACT)), rt2 * 256, pn2 * 256}; G_EPI(epi, acc); }
            else { gm::EpiFp8 epi{(uint8_t*)(wso(kws(), WS_YR)), DM, rt2 * 256, pn2 * 256, S_Y8 / (S_A8 * S_W8)}; G_EPI(epi, acc); }
        }
        __builtin_amdgcn_sched_barrier(0);
        { const int t2 = otid(); if (un < nU && t2 < 64) *((LAS f32x4*)(lds + gm::G_BIAS8) + t2) = bn * cur.bscale;
          if (WHICH == 1 && unn < nU) *((LAS u32x4*)(lds + 131072) + t2) = moe_gather_fix(gnn); }
        u = un; un = unn; rtn = rtnn; pnn = pnnn;
    }
    __syncthreads();
}


struct PrepRaw { u32x4 q8[1]; u32x2 d4[4]; };
DI void un4(const u32x2& u, float (&o)[4]) { o[0] = bflo(u.x); o[1] = bfhi(u.x); o[2] = bflo(u.y); o[3] = bfhi(u.y); }
DI void un8(const u32x4& u, float (&o)[8]) { o[0] = bflo(u.x); o[1] = bfhi(u.x); o[2] = bflo(u.y); o[3] = bfhi(u.y); o[4] = bflo(u.z); o[5] = bfhi(u.z); o[6] = bflo(u.w); o[7] = bfhi(u.w); }
DI int prep_src64(int hl) { return hl < 4 ? C_RK + hl * 64 : hl < 6 ? C_GK + (hl - 4) * 64 : 0; }
DI int prep_src32(int ml) { return ml < 8 ? C_DK + ml * 32 : ml < 12 ? C_MQE + (ml - 8) * 96 + 64 : ml < 13 ? C_MKR : 0; }
DI PrepRaw prep_load(int row, int lane) {
    PrepRaw r; const bf16_t* P = (const bf16_t*)(wso(kws(), WS_P)) + (size_t)row * NP;
    r.q8[0] = *(const u32x4*)(P + C_MCQ + (lane < 24 ? lane : 0) * 8);
    { const int src = prep_src64(lane >> 3), aa = lane & 7; r.d4[0] = *(const u32x2*)(P + src + 4 * aa); r.d4[1] = *(const u32x2*)(P + src + 32 + 4 * aa); }
    { const int src = prep_src32(lane >> 2), aa = lane & 3; r.d4[2] = *(const u32x2*)(P + src + 4 * aa); r.d4[3] = *(const u32x2*)(P + src + 16 + 4 * aa); }
    return r;
}
constexpr int PREP_TAB = 102400, PREP_R32 = PREP_TAB + 8192, PREP_QN = PREP_R32 + 4096;
DI void prep_compute(int row, int lane, const PrepRaw& raw, LAS unsigned char* lds) {
    unsigned char* ws = kws();
    const int b = row / SP, pos = row - b * SP; const bool lat = pos >= NCTX;
    const int s = lat ? pos - NCTX : 0, gr = s >> 6, gc = s & 63;
    LAS f32x2* r64 = (LAS f32x2*)(lds + PREP_TAB); LAS f32x2* r32 = (LAS f32x2*)(lds + PREP_R32); LAS float* qnl = (LAS float*)(lds + PREP_QN);
    float rq;
    { float v[8], ss = 0.f; un8(raw.q8[0], v);
      if (lane < 24) {
#pragma unroll
          for (int j = 0; j < 8; ++j) ss += v[j] * v[j]; }
      rq = rsqrtf(wave_sum(ss) * (1.0f / 192.0f) + opq(EPS)); }
    {
        const int hl = lane >> 3, aa = lane & 7;
        const bool act = hl < 6;
        bf16_t* dst = nullptr; float scale = 1.0f; int nrm = -1;
        if (hl < 4) { dst = (bf16_t*)(wso(ws, WS_KRET)) + (size_t)row * 256 + hl * 64; scale = 0.125f; }
        else if (hl < 6) { dst = (bf16_t*)(wso(ws, WS_KG)) + (size_t)row * 128 + (hl - 4) * 64; nrm = 1; }
        float x1[4], x2[4]; un4(raw.d4[0], x1); un4(raw.d4[1], x2);
        float ss = 0.f;
#pragma unroll
        for (int j = 0; j < 4; ++j) ss += x1[j] * x1[j] + x2[j] * x2[j];
        ss += __shfl_xor(ss, 1); ss += __shfl_xor(ss, 2); ss += __shfl_xor(ss, 4);
        if (nrm >= 0) {
            const float rs = rsqrtf(ss * (1.0f / 64.0f) + opq(EPS)); LAS float* qn = qnl + nrm * 64;
#pragma unroll
            for (int j = 0; j < 4; ++j) { x1[j] *= rs * qn[4 * aa + j]; x2[j] *= rs * qn[32 + 4 * aa + j]; }
        }
        if (lat) {
            LAS f32x2* tb = r64 + (aa < 4 ? gr : gc) * 16 + ((4 * aa) & 15);
#pragma unroll
            for (int j = 0; j < 4; ++j) { const f32x2 cs = tb[j]; const float y1 = x1[j] * cs.x - x2[j] * cs.y, y2 = x1[j] * cs.y + x2[j] * cs.x; x1[j] = y1; x2[j] = y2; }
        }
#pragma unroll
        for (int j = 0; j < 4; ++j) { x1[j] *= scale; x2[j] *= scale; }
        if (act) { st4(dst + 4 * aa, x1); st4(dst + 32 + 4 * aa, x2); }
    }
    {
        const int ml = lane >> 2, aa = lane & 3;
        const bool act = ml < 13;
        float scale = 1.0f;
        if (ml >= 8 && ml < 12) scale = rq * 0.10206207261596575f * LOG2E;
        float x1[4], x2[4]; un4(raw.d4[2], x1); un4(raw.d4[3], x2);
        if (lat) {
            LAS f32x2* tb = r32 + (aa < 2 ? gr : gc) * 8 + ((4 * aa) & 7);
#pragma unroll
            for (int j = 0; j < 4; ++j) { const f32x2 cs = tb[j]; const float y1 = x1[j] * cs.x - x2[j] * cs.y, y2 = x1[j] * cs.y + x2[j] * cs.x; x1[j] = y1; x2[j] = y2; }
        }
#pragma unroll
        for (int j = 0; j < 4; ++j) { x1[j] *= scale; x2[j] *= scale; }
        if (act) {
            if (ml < 8) { bf16_t* d = (bf16_t*)(wso(ws, WS_KD)) + (size_t)row * 256 + ml * 32; st4(d + 4 * aa, x1); st4(d + 16 + 4 * aa, x2); }
            else if (ml < 12) { bf16_t* d = (bf16_t*)(wso(ws, WS_QM)) + (size_t)row * 384 + (ml - 8) * 96 + 64; st4(d + 4 * aa, x1); st4(d + 16 + 4 * aa, x2); }
            else { bf16_t* d = (bf16_t*)(wso(ws, WS_KM)) + (size_t)row * 384 + 64;
#pragma unroll
                for (int hh = 0; hh < 4; ++hh) { st4(d + hh * 96 + 4 * aa, x1); st4(d + hh * 96 + 16 + 4 * aa, x2); } }
        }
    }
}

DI void st8l(LAS unsigned char* p, const float (&v)[8]) { u32x4 u; u.x = pk2(v[0], v[1]); u.y = pk2(v[2], v[3]); u.z = pk2(v[4], v[5]); u.w = pk2(v[6], v[7]); *(LAS u32x4*)p = u; }
constexpr int R1_V = 0, R1_KF = 32768, R1_KB = 65536;
DI void r1_item(const Args& a, int l, int item, LAS unsigned char* lds) {
    const int tid = otid(), lane = tid & 63, w = __builtin_amdgcn_readfirstlane(tid >> 6);
    unsigned char* ws = kws();
    const int hd = item & 3, cj = (item >> 2) % NCHUNK, b = (item >> 2) / NCHUNK;
    const int row0 = b * SP + cj * 256;
    const float lgf = -__expf(kin(I_RLD)[l * 8 + hd]) * LOG2E, lgb = -__expf(kin(I_RLD)[l * 8 + 4 + hd]) * LOG2E;
    {
        const int m = tid >> 1, half = tid & 1;
        const bf16_t* P = (const bf16_t*)(wso(ws, WS_P)) + (size_t)(row0 + m) * NP;
        float x1[16], x2[16];
        { float t[8];
          ld8(P + C_RK + hd * 64 + 16 * half, t);
#pragma unroll
          for (int j = 0; j < 8; ++j) x1[j] = t[j];
          ld8(P + C_RK + hd * 64 + 16 * half + 8, t);
#pragma unroll
          for (int j = 0; j < 8; ++j) x1[8 + j] = t[j];
          ld8(P + C_RK + hd * 64 + 32 + 16 * half, t);
#pragma unroll
          for (int j = 0; j < 8; ++j) x2[j] = t[j];
          ld8(P + C_RK + hd * 64 + 32 + 16 * half + 8, t);
#pragma unroll
          for (int j = 0; j < 8; ++j) x2[8 + j] = t[j]; }
        if (cj > 0) {
            const int s = (cj - 1) * 256 + m, gr = s >> 6, gc = s & 63;
            const f32x2* tb = (const f32x2*)(wso(ws, WS_TAB) + TAB_R64) + (half ? gc : gr) * 16;
#pragma unroll
            for (int j = 0; j < 16; ++j) { const f32x2 cs = tb[j]; const float y1 = x1[j] * cs.x - x2[j] * cs.y, y2 = x1[j] * cs.y + x2[j] * cs.x; x1[j] = y1; x2[j] = y2; }
        }
        const float zf = 0.125f * __builtin_amdgcn_exp2f(lgf * (float)(255 - m)), zb = 0.125f * __builtin_amdgcn_exp2f(lgb * (float)m);
        float o[8];
#pragma unroll
        for (int q = 0; q < 2; ++q) {
#pragma unroll
            for (int j = 0; j < 8; ++j) o[j] = x1[8 * q + j] * zf;
            st8l(lds + R1_KF + m * 128 + (16 * half + 8 * q) * 2, o);
#pragma unroll
            for (int j = 0; j < 8; ++j) o[j] = x2[8 * q + j] * zf;
            st8l(lds + R1_KF + m * 128 + (32 + 16 * half + 8 * q) * 2, o);
#pragma unroll
            for (int j = 0; j < 8; ++j) o[j] = x1[8 * q + j] * zb;
            st8l(lds + R1_KB + m * 128 + (16 * half + 8 * q) * 2, o);
#pragma unroll
            for (int j = 0; j < 8; ++j) o[j] = x2[8 * q + j] * zb;
            st8l(lds + R1_KB + m * 128 + (32 + 16 * half + 8 * q) * 2, o);
        }
#pragma unroll
        for (int q = 0; q < 4; ++q) *(LAS u32x4*)(lds + R1_V + m * 128 + half * 64 + q * 16) = *(const u32x4*)(P + C_RV + hd * 64 + half * 32 + q * 8);
    }
    __syncthreads();
    {
        const int dir = w >> 2, eb = (w >> 1) & 1, db = w & 1;
        const int i16 = lane & 15, q = i16 >> 2, p = i16 & 3, g = (lane >> 4) & 1, h = lane >> 5, r = lane & 31;
        LAS unsigned char* vb = lds + R1_V + (8 * h + q) * 128 + (32 * eb + 16 * g + 4 * p) * 2;
        LAS unsigned char* kb = lds + (dir ? R1_KB : R1_KF) + (8 * h + q) * 128 + (32 * db + 16 * g + 4 * p) * 2;
        f32x16 acc;
#pragma unroll
        for (int i = 0; i < 16; ++i) acc[i] = 0.f;
#pragma unroll
        for (int s = 0; s < 16; ++s) {
            const s16x4 alo = trread(vb + s * 2048), ahi = trread(vb + s * 2048 + 512);
            const s16x4 blo = trread(kb + s * 2048), bhi = trread(kb + s * 2048 + 512);
            const bf16x8 av = __builtin_shufflevector(alo, ahi, 0, 1, 2, 3, 4, 5, 6, 7), bv = __builtin_shufflevector(blo, bhi, 0, 1, 2, 3, 4, 5, 6, 7);
            acc = MFMA32(av, bv, acc);
        }
        float* U = (float*)(wso(ws, WS_UST)) + ((((size_t)b * 4 + hd) * NCHUNK + cj) * 2 + dir) * 4096;
#pragma unroll
        for (int i = 0; i < 16; ++i) U[(32 * eb + crow(i, h)) * 64 + 32 * db + r] = acc[i];
    }
    __syncthreads();
}

constexpr int MU_PITCH = 656, MU_ROWS = 144;
constexpr int MU_RS = MU_ROWS * MU_PITCH;
static_assert(MU_RS + MU_ROWS * 8 <= 102400, "lds");
template <int KS  >
DI void mla_up_tile(const bf16x8 (&bf)[KS], LAS unsigned char* ain  , LAS unsigned char* lds, bf16_t* out  , int ldo, int sel, int row0, int fr, int fq) {
#pragma unroll 3
    for (int rt = 0; rt < MU_ROWS / 16; ++rt) {
        LAS unsigned char* ap = ain + (16 * rt + fr) * MU_PITCH + 16 * fq;
        f32x4 acc = {0.f, 0.f, 0.f, 0.f};
#pragma unroll
        for (int ks = 0; ks < KS; ++ks) acc = __builtin_amdgcn_mfma_f32_16x16x32_bf16(bf[ks], *(LAS bf16x8*)(ap + 64 * ks), acc, 0, 0, 0);
        const float sc = sel < 0 ? 1.0f : ((LAS float*)(lds + MU_RS))[(16 * rt + fr) * 2 + sel];
        if (16 * rt + fr < ROWS_PER_BLK) { const float v[4] = {acc[0] * sc, acc[1] * sc, acc[2] * sc, acc[3] * sc}; st4(out + (size_t)(row0 + 16 * rt + fr) * ldo + 4 * fq, v); }
    }
}
DI void prep_mla_up(int l, int row0, LAS unsigned char* lds) {
    const int tid = otid(), lane = tid & 63, w = __builtin_amdgcn_readfirstlane(tid >> 6), fr = lane & 15, fq = lane >> 4;
    unsigned char* ws = kws();
    bf16_t* P = (bf16_t*)(wso(ws, WS_P));
    for (int i = tid; i < MU_ROWS * 40; i += NTHR) {
        const int r = i / 40, c = i - r * 40, row = row0 + r < T ? row0 + r : T - 1;
        *(LAS u32x4*)(lds + r * MU_PITCH + c * 16) = *(const u32x4*)(P + (size_t)row * NP + C_MCQ + c * 8);
    }
    __syncthreads();
    if (tid < 2 * MU_ROWS) {
        const int r = tid >> 1, kv = tid & 1; LAS unsigned char* p = lds + r * MU_PITCH + kv * 384; float ss = 0.f;
        for (int c = 0; c < (kv ? 16 : 24); ++c) { float v[8]; const u32x4 t_ = *(LAS u32x4*)(p + c * 16); un8(t_, v);
#pragma unroll
            for (int j = 0; j < 8; ++j) ss += v[j] * v[j]; }
        ((LAS float*)(lds + MU_RS))[tid] = kv ? rsqrtf(ss * (1.0f / 128.0f) + opq(EPS)) : rsqrtf(ss * (1.0f / 192.0f) + opq(EPS)) * (0.10206207261596575f * LOG2E);
    }
    __syncthreads();
    const bf16_t* Wq = (const bf16_t*)(wso(ws, WS_WUQ)) + (size_t)l * 384 * 192; const bf16_t* Wkv = (const bf16_t*)(wso(ws, WS_WUKV)) + (size_t)l * 512 * 128;
    bf16x8 bq[3][6], bkv[4][4];
#pragma unroll
    for (int j = 0; j < 3; ++j)
#pragma unroll
        for (int ks = 0; ks < 6; ++ks) bq[j][ks] = *(const bf16x8*)(Wq + (size_t)((3 * w + j) * 16 + fr) * 192 + 32 * ks + 8 * fq);
#pragma unroll
    for (int j = 0; j < 4; ++j)
#pragma unroll
        for (int ks = 0; ks < 4; ++ks) bkv[j][ks] = *(const bf16x8*)(Wkv + (size_t)((4 * w + j) * 16 + fr) * 128 + 32 * ks + 8 * fq);
#pragma unroll
    for (int j = 0; j < 3; ++j) { const int n0 = (3 * w + j) * 16, hh = n0 / 96, wi = n0 - hh * 96; const bool rope = wi >= 64;
        bf16_t* qm = (bf16_t*)(wso(ws, WS_QM)) + n0; bf16_t* pq = P + C_MQE + n0;
        mla_up_tile<6>(bq[j], lds, lds, rope ? pq : qm, rope ? NP : 384, rope ? -1 : 0, row0, fr, fq); }
#pragma unroll
    for (int j = 0; j < 4; ++j) { const int n0 = (4 * w + j) * 16, hh = n0 >> 7, wi = n0 & 127; const bool isv = wi >= 64;
        bf16_t* km = (bf16_t*)(wso(ws, WS_KM)) + hh * 96 + wi; bf16_t* vm = (bf16_t*)(wso(ws, WS_VM)) + hh * 64 + (wi - 64);
        mla_up_tile<4>(bkv[j], lds + 384, lds, isv ? vm : km, isv ? 256 : 384, 1, row0, fr, fq); }
}

DI void p_prep(const Args& a, int l, LAS unsigned char* lds) {
    const int tid = otid(), lane = tid & 63, w = __builtin_amdgcn_readfirstlane(tid >> 6);
    {
        const float* tab = (const float*)(wso(kws(), WS_TAB));
        for (int i = tid; i < 3072; i += NTHR) ((LAS float*)(lds + PREP_TAB))[i] = tab[i];
        if (tid < 128) ((LAS float*)(lds + PREP_QN))[tid] = kin(I_GQKN)[l * 128 + tid];
    }
    for (int chunk = obx(); chunk * ROWS_PER_BLK < T; chunk += gridDim.x) {
        const int row0 = chunk * ROWS_PER_BLK;
        prep_mla_up(l, row0, lds);
        asm volatile("s_waitcnt vmcnt(0)" ::: "memory");
        __syncthreads();
        int row = row0 + w;
        PrepRaw cur, nxt;
        cur = prep_load(row, lane);
#pragma unroll 1
        while (row < row0 + ROWS_PER_BLK) {
            const int rn = row + 8;
            if (rn < row0 + ROWS_PER_BLK) nxt = prep_load(rn, lane);
            prep_compute(row, lane, cur, lds);
            cur = nxt; row = rn;
        }
    }
    __syncthreads();
    for (int it = obx(); it < NB * NCHUNK * 4; it += gridDim.x) r1_item(a, l, it, lds);
}

enum { M_DIFF = 0, M_MLA = 1, M_GQA = 2, M_RET = 3 };
constexpr int AT_RING = 4, AT_KSLOT = 12288, AT_VSLOT = 8192, AT_K0 = 0, AT_K1 = AT_KSLOT, AT_V0 = AT_RING * AT_KSLOT, AT_V1 = AT_V0 + AT_VSLOT, AT_SF = AT_V0 + AT_RING * AT_VSLOT, AT_SB = AT_SF + 9216, AT_END = AT_SB + 9216;
static_assert(AT_END <= 131072, "lds");
struct AttnP {
    const bf16_t* Q; int ldq; const bf16_t* K; int ldk; const bf16_t* V; int ldv; bf16_t* O;
    int qrow0, krow0, ntiles;
    float lam, oml; const float* subln;
    const float* qnw;
    const bf16_t* gate; const float* gnw; const float* gnb; float l2gf, l2gb; const float* ust; int cj;
};
template <int ST> DI bf16x8 pack8(const f32x16& s) {
    u32x4 u; u.x = pk2(s[8 * ST], s[8 * ST + 1]); u.y = pk2(s[8 * ST + 2], s[8 * ST + 3]); u.z = pk2(s[8 * ST + 4], s[8 * ST + 5]); u.w = pk2(s[8 * ST + 6], s[8 * ST + 7]);
    return __builtin_bit_cast(bf16x8, u);
}
constexpr float SM_THR = 8.0f;
struct SmState { float m, l; f32x16 negm; };
DI void sm_init(SmState& st) { st.m = 0.f; st.l = 0.f;
#pragma unroll
    for (int i = 0; i < 16; ++i) st.negm[i] = 0.f; }
#define MX3(a, b, c) __builtin_fmaxf(__builtin_fmaxf((a), (b)), (c))
DI float sm_rowmax(const f32x16& s0, const f32x16& s1) {
    float a = MX3(s0[0], s0[1], s1[0]), b = MX3(s0[2], s0[3], s1[1]); a = MX3(a, s1[2], s1[3]);
#pragma unroll
    for (int r = 4; r < 16; r += 4) { a = MX3(a, s0[r], s0[r + 1]); b = MX3(b, s0[r + 2], s0[r + 3]); a = MX3(a, s1[r], s1[r + 1]); b = MX3(b, s1[r + 2], s1[r + 3]); }
    const float mx = __builtin_fmaxf(a, b);
    auto rr = __builtin_amdgcn_permlane32_swap(__float_as_uint(mx), __float_as_uint(mx), false, false);
    return __builtin_fmaxf(__uint_as_float(rr[0]), __uint_as_float(rr[1]));
}
DI void sm_move(float mx, bool first, SmState& st, f32x16& o0, f32x16& o1, f32x16& s0, f32x16& s1) {
    const float d = first ? mx : __builtin_fmaxf(mx, 0.f), alpha = first ? 0.f : __builtin_amdgcn_exp2f(-d);
    st.m += d; st.l *= alpha;
    const float nm = -st.m;
#pragma unroll
    for (int i = 0; i < 16; ++i) { o0[i] *= alpha; o1[i] *= alpha; s0[i] -= d; s1[i] -= d; st.negm[i] = nm; }
}
DI void sm_exp_pack(f32x16& s0, f32x16& s1, SmState& st, bf16x8 (&pf)[4]) {
    float a0 = 0.f, a1 = 0.f;
#pragma unroll
    for (int i = 0; i < 16; i += 2) {
        s0[i] = __builtin_amdgcn_exp2f(s0[i]); s0[i + 1] = __builtin_amdgcn_exp2f(s0[i + 1]); s1[i] = __builtin_amdgcn_exp2f(s1[i]); s1[i + 1] = __builtin_amdgcn_exp2f(s1[i + 1]);
        a0 += s0[i]; a1 += s0[i + 1]; asm("" : "+v"(a0), "+v"(a1)); a0 += s1[i]; a1 += s1[i + 1]; asm("" : "+v"(a0), "+v"(a1));
    }
    st.l += a0 + a1;
    pf[0] = pack8<0>(s0); pf[1] = pack8<1>(s0); pf[2] = pack8<0>(s1); pf[3] = pack8<1>(s1);
}
DI void pv_packed(LAS unsigned char* vlane, const bf16x8 (&pf)[4], f32x16& o0, f32x16& o1) {
#pragma unroll
    for (int ks = 0; ks < 4; ++ks) {
        { const s16x4 lo = trread(vlane + ks * 1024), hi = trread(vlane + ks * 1024 + 512);
          o0 = MFMA32(__builtin_shufflevector(lo, hi, 0, 1, 2, 3, 4, 5, 6, 7), pf[ks], o0); }
        { const s16x4 lo = trread(vlane + 4096 + ks * 1024), hi = trread(vlane + 4096 + ks * 1024 + 512);
          o1 = MFMA32(__builtin_shufflevector(lo, hi, 0, 1, 2, 3, 4, 5, 6, 7), pf[ks], o1); }
    }
}
DI void pv_tile(LAS unsigned char* vlane, const f32x16& p0, const f32x16& p1, f32x16& o0, f32x16& o1) {
    bf16x8 pf[4]; pf[0] = pack8<0>(p0); pf[1] = pack8<1>(p0); pf[2] = pack8<0>(p1); pf[3] = pack8<1>(p1);
    pv_packed(vlane, pf, o0, o1);
}

struct AttnLane { int lane, w, r, h, nq, sdst, klane_off, vlane_off; };
DI AttnLane attn_lane() {
    AttnLane L; const int tid = otid();
    L.lane = tid & 63; L.w = __builtin_amdgcn_readfirstlane(tid >> 6); L.r = L.lane & 31; L.h = L.lane >> 5; L.nq = 32 * L.w + L.r;
    L.sdst = L.w * 1024 + L.lane * 16; L.klane_off = L.h * 1024 + L.r * 16;
    const int i16 = L.lane & 15; L.vlane_off = (4 * L.h + (i16 >> 2)) * 64 + (16 * ((L.lane >> 4) & 1) + 4 * (i16 & 3)) * 2;
    return L;
}

template <int NDC, int NCH  >
DI void attn_pass(LAS unsigned char* lds, const AttnP& a, const AttnLane& L, const bf16x8* qf, int kc0, f32x16& o0, f32x16& o1, SmState& st) {
    constexpr int NLD = (NCH == 12) ? 3 : 2;
    const int w = L.w, lane = L.lane;
    const bf16_t* ksrc = a.K + (size_t)(a.krow0 + lane) * a.ldk + w * 8;
    const bf16_t* ksrc2 = a.K + (size_t)(a.krow0 + lane) * a.ldk + (w < 4 ? 8 + w : w) * 8;
    const bf16_t* vsrc = a.V + (size_t)(a.krow0 + 16 * (w & 3) + (lane >> 2)) * a.ldv + (w >> 2) * 32 + (lane & 3) * 8;
    const size_t kstep = (size_t)64 * a.ldk, vstep = (size_t)64 * a.ldv;
    const unsigned lds0 = (unsigned)(uintptr_t)lds + (unsigned)(w * 1024);
#define AP_GLDS(g, ldsb) do { unsigned sv_; asm volatile("s_mov_b32 %0, m0\n\ts_mov_b32 m0, %2\n\ts_nop 0\n\tglobal_load_lds_dwordx4 %1, off\n\ts_mov_b32 m0, %0" \
        : "=&s"(sv_) : "v"(g), "s"((unsigned)__builtin_amdgcn_readfirstlane(ldsb)) : "memory"); } while (0)
#define AP_DK(j) do { const unsigned sl_ = lds0 + AT_K0 + (unsigned)(((j) % AT_RING) * AT_KSLOT); \
        AP_GLDS(ksrc + (size_t)(j) * kstep, sl_); \
        if (NCH == 12) AP_GLDS(ksrc2 + (size_t)(j) * kstep, sl_ + (w < 4 ? 8192u : 0u)); } while (0)
#define AP_DV(j) do { AP_GLDS(vsrc + (size_t)(j) * vstep, lds0 + AT_V0 + (unsigned)(((j) % AT_RING) * AT_VSLOT)); } while (0)
#define AP_WAITBAR(N) do { asm volatile("s_waitcnt vmcnt(%0) lgkmcnt(0)" :: "n"(N) : "memory"); __builtin_amdgcn_s_barrier(); asm volatile("" ::: "memory"); } while (0)
#define AP_KF(j) do { LAS unsigned char* kb_ = lds + AT_K0 + ((j) % AT_RING) * AT_KSLOT + L.klane_off + kc0 * 1024; \
        _Pragma("unroll") for (int dc = 0; dc < NDC; ++dc) { kf[2 * dc] = *(LAS bf16x8*)(kb_ + dc * 2048); kf[2 * dc + 1] = *(LAS bf16x8*)(kb_ + dc * 2048 + 512); } } while (0)
#define AP_VF(j) do { LAS unsigned char* vb_ = lds + AT_V0 + ((j) % AT_RING) * AT_VSLOT + L.vlane_off; \
        _Pragma("unroll") for (int ks = 0; ks < 4; ++ks) { \
            { const s16x4 lo = trread(vb_ + ks * 1024), hi = trread(vb_ + ks * 1024 + 512); vf[2 * ks] = __builtin_shufflevector(lo, hi, 0, 1, 2, 3, 4, 5, 6, 7); } \
            { const s16x4 lo = trread(vb_ + 4096 + ks * 1024), hi = trread(vb_ + 4096 + ks * 1024 + 512); vf[2 * ks + 1] = __builtin_shufflevector(lo, hi, 0, 1, 2, 3, 4, 5, 6, 7); } } } while (0)
#define AP_QK(S0, S1) do { S0 = mfma32_c(kf[0], qf[0], st.negm); S1 = mfma32_c(kf[1], qf[0], st.negm); \
        _Pragma("unroll") for (int dc = 1; dc < NDC; ++dc) { S0 = MFMA32(kf[2 * dc], qf[dc], S0); S1 = MFMA32(kf[2 * dc + 1], qf[dc], S1); } } while (0)
    sm_init(st);
#pragma unroll
    for (int i = 0; i < 16; ++i) { o0[i] = 0.f; o1[i] = 0.f; }
    AP_DK(0);
#pragma unroll
    for (int j = 0; j < AT_RING - 1; ++j) { AP_DK(j + 1); AP_DV(j); }
    AP_WAITBAR((AT_RING - 2) * NLD);
    f32x16 sc0, sc1;
    { bf16x8 kf[2 * NDC]; AP_KF(0); AP_QK(sc0, sc1); }
    sm_move(sm_rowmax(sc0, sc1), true, st, o0, o1, sc0, sc1);
    AP_WAITBAR((AT_RING - 2) * NLD);
#define AP_STEP(t, SC0, SC1, SN0, SN1) do { \
        AP_DK((t) + AT_RING); AP_DV((t) + AT_RING - 1); \
        bf16x8 kf[2 * NDC], vf[8]; \
        AP_KF((t) + 1); AP_VF(t); \
        __builtin_amdgcn_sched_barrier(0); \
        bf16x8 pf[4]; \
        AP_QK(SN0, SN1);                                  \
        sm_exp_pack(SC0, SC1, st, pf);                    \
        __builtin_amdgcn_sched_barrier(0); \
        _Pragma("unroll") for (int ks = 0; ks < 4; ++ks) { o0 = MFMA32(vf[2 * ks], pf[ks], o0); o1 = MFMA32(vf[2 * ks + 1], pf[ks], o1); } \
        const float mx_ = sm_rowmax(SN0, SN1); \
        if ((t) + 1 < a.ntiles && __any(mx_ > SM_THR)) sm_move(mx_, false, st, o0, o1, SN0, SN1); \
        AP_WAITBAR((AT_RING - 2) * NLD); } while (0)
    f32x16 sd0, sd1;
    asm volatile(".p2align 6");
#pragma unroll 1
    for (int t = 0; t < a.ntiles; t += 2) {
        AP_STEP(t, sc0, sc1, sd0, sd1);
        AP_STEP(t + 1, sd0, sd1, sc0, sc1);
    }
#undef AP_STEP
    AP_WAITBAR(0);
#undef AP_GLDS
#undef AP_DK
#undef AP_DV
#undef AP_WAITBAR
#undef AP_KF
#undef AP_VF
#undef AP_QK
}

template <int MODE>
DI void attn_q_fix(bf16x8 (&qf)[4], int row, int h, const float* qnw) {
    float x[4][8];
#pragma unroll
    for (int dc = 0; dc < 4; ++dc) { const u32x4 u = __builtin_bit_cast(u32x4, qf[dc]); un8(u, x[dc]); }
    const int b = row / SP, pos = row - b * SP; const bool lat = pos >= NCTX; const int s_ = lat ? pos - NCTX : 0, gr = s_ >> 6, gc = s_ & 63;
    unsigned char* ws = kws();
    if (MODE == M_GQA) {
        float ss = 0.f;
#pragma unroll
        for (int dc = 0; dc < 4; ++dc)
#pragma unroll
            for (int j = 0; j < 8; ++j) ss += x[dc][j] * x[dc][j];
        ss += xor32_f(ss);
        const float rs = rsqrtf(ss * (1.0f / 64.0f) + opq(EPS));
#pragma unroll
        for (int dc = 0; dc < 4; ++dc) { const f32x4 w0 = *(gv4p)(qnw + 16 * dc + 8 * h), w1 = *(gv4p)(qnw + 16 * dc + 8 * h + 4);
#pragma unroll
            for (int j = 0; j < 4; ++j) { x[dc][j] *= rs * w0[j]; x[dc][4 + j] *= rs * w1[j]; } }
    }
    if (MODE == M_DIFF) {
        if (lat) { const float* tb = (const float*)(wso(ws, WS_TAB) + TAB_R32) + ((h == 0 ? gr : gc) * 8) * 2;
            f32x4 t[4];
#pragma unroll
            for (int q = 0; q < 4; ++q) t[q] = *(gv4p)(tb + 4 * q);
#pragma unroll
            for (int j = 0; j < 8; ++j) { const float c_ = t[j >> 1][2 * (j & 1)], s2 = t[j >> 1][2 * (j & 1) + 1];
#pragma unroll
                for (int m = 0; m < 4; m += 2) { const float y1 = x[m][j] * c_ - x[m + 1][j] * s2, y2 = x[m][j] * s2 + x[m + 1][j] * c_; x[m][j] = y1; x[m + 1][j] = y2; } } }
    } else {
        if (lat) {
            f32x4 t[2][4];
#pragma unroll
            for (int dc = 0; dc < 2; ++dc) { const float* tb = (const float*)(wso(ws, WS_TAB) + TAB_R64) + ((dc == 0 ? gr : gc) * 16 + 8 * h) * 2;
#pragma unroll
                for (int q = 0; q < 4; ++q) t[dc][q] = *(gv4p)(tb + 4 * q); }
#pragma unroll
            for (int dc = 0; dc < 2; ++dc)
#pragma unroll
                for (int j = 0; j < 8; ++j) { const float c_ = t[dc][j >> 1][2 * (j & 1)], s2 = t[dc][j >> 1][2 * (j & 1) + 1];
                    const float y1 = x[dc][j] * c_ - x[dc + 2][j] * s2, y2 = x[dc][j] * s2 + x[dc + 2][j] * c_; x[dc][j] = y1; x[dc + 2][j] = y2; } }
    }
    const float scale = MODE == M_DIFF ? 0.17677669529663687f * LOG2E : MODE == M_GQA ? 0.125f * LOG2E : 1.0f;
#pragma unroll
    for (int dc = 0; dc < 4; ++dc) { u32x4 u; u.x = pk2(x[dc][0] * scale, x[dc][1] * scale); u.y = pk2(x[dc][2] * scale, x[dc][3] * scale); u.z = pk2(x[dc][4] * scale, x[dc][5] * scale); u.w = pk2(x[dc][6] * scale, x[dc][7] * scale);
        qf[dc] = __builtin_bit_cast(bf16x8, u); }
}

template <int MODE>
DI void attn_unit(LAS unsigned char* lds, const AttnP& a) {
    const AttnLane L = attn_lane();
    const int lane = L.lane, w = L.w, r = L.r, h = L.h, nq = L.nq;
    bf16_t* orow = a.O + (size_t)(a.qrow0 + nq) * DM;
    const bf16_t* qrow = a.Q + (size_t)(a.qrow0 + nq) * a.ldq + 8 * h;
    if (MODE == M_GQA || MODE == M_MLA) {
        constexpr int NDC = (MODE == M_MLA) ? 6 : 4;
        bf16x8 qf[NDC];
#pragma unroll
        for (int dc = 0; dc < NDC; ++dc) qf[dc] = *(const bf16x8*)(qrow + 16 * dc);
        if constexpr (MODE == M_GQA) attn_q_fix<M_GQA>(qf, a.qrow0 + nq, h, a.qnw);
        f32x16 o0, o1; SmState st;
        attn_pass<NDC, (MODE == M_MLA ? 12 : 8)>(lds, a, L, qf, 0, o0, o1, st);
        const float lt = st.l + __shfl_xor(st.l, 32), inv = 1.0f / lt;
#pragma unroll
        for (int g4 = 0; g4 < 4; ++g4) {
            const float v0[4] = {o0[4 * g4] * inv, o0[4 * g4 + 1] * inv, o0[4 * g4 + 2] * inv, o0[4 * g4 + 3] * inv};
            const float v1[4] = {o1[4 * g4] * inv, o1[4 * g4 + 1] * inv, o1[4 * g4 + 2] * inv, o1[4 * g4 + 3] * inv};
            st4(orow + 8 * g4 + 4 * h, v0); st4(orow + 32 + 8 * g4 + 4 * h, v1);
        }
    } else if (MODE == M_DIFF) {
        bf16x8 qf[4];
#pragma unroll
        for (int dc = 0; dc < 4; ++dc) qf[dc] = *(const bf16x8*)(qrow + 16 * dc);
        attn_q_fix<M_DIFF>(qf, a.qrow0 + nq, h, nullptr);
        f32x16 p0, p1, o0, o1; SmState st;
        attn_pass<2, 8>(lds, a, L, qf, 0, p0, p1, st);
        { const float i1 = 1.0f / (st.l + __shfl_xor(st.l, 32));
#pragma unroll
          for (int i = 0; i < 16; ++i) { p0[i] *= i1; p1[i] *= i1; } }
        attn_pass<2, 8>(lds, a, L, qf + 2, 4, o0, o1, st);
        const float i2 = a.lam / (st.l + __shfl_xor(st.l, 32));
        float ss = 0.f;
#pragma unroll
        for (int i = 0; i < 16; ++i) { o0[i] = p0[i] - o0[i] * i2; o1[i] = p1[i] - o1[i] * i2; ss += o0[i] * o0[i] + o1[i] * o1[i]; }
        ss += __shfl_xor(ss, 32);
        const float rs = rsqrtf(ss * (1.0f / 64.0f) + opq(EPS)) * a.oml;
#pragma unroll
        for (int g4 = 0; g4 < 4; ++g4) {
            const int e0 = 8 * g4 + 4 * h; const f32x4 w0 = *(const f32x4*)(a.subln + e0), w1 = *(const f32x4*)(a.subln + 32 + e0);
            const float v0[4] = {o0[4 * g4] * rs * w0[0], o0[4 * g4 + 1] * rs * w0[1], o0[4 * g4 + 2] * rs * w0[2], o0[4 * g4 + 3] * rs * w0[3]};
            const float v1[4] = {o1[4 * g4] * rs * w1[0], o1[4 * g4 + 1] * rs * w1[1], o1[4 * g4 + 2] * rs * w1[2], o1[4 * g4 + 3] * rs * w1[3]};
            st4(orow + e0, v0); st4(orow + 32 + e0, v1);
        }
    } else {
        bf16x8 qf[4];
#pragma unroll
        for (int dc = 0; dc < 4; ++dc) qf[dc] = *(const bf16x8*)(qrow + 16 * dc);
        attn_q_fix<M_RET>(qf, a.qrow0 + nq, h, nullptr);
        const bf16_t* ksrc = a.K + (size_t)(a.krow0 + lane) * a.ldk + w * 8;
        const bf16_t* vsrc = a.V + (size_t)(a.krow0 + 16 * (w & 3) + (lane >> 2)) * a.ldv + (w >> 2) * 32 + (lane & 3) * 8;
        const size_t kstep = (size_t)64 * a.ldk, vstep = (size_t)64 * a.ldv;
        u32x4 kr0, vr;
#define AT_GLOAD(t) do { kr0 = *(const u32x4*)(ksrc + (size_t)(t) * kstep); vr = *(const u32x4*)(vsrc + (size_t)(t) * vstep); } while (0)
#define AT_LSTORE(buf) do { *(LAS u32x4*)(lds + ((buf) ? AT_K1 : AT_K0) + L.sdst) = kr0; *(LAS u32x4*)(lds + ((buf) ? AT_V1 : AT_V0) + L.sdst) = vr; } while (0)
        AT_GLOAD(0);
        f32x16 o0, o1;
#pragma unroll
        for (int i = 0; i < 16; ++i) { o0[i] = 0.f; o1[i] = 0.f; }
        if (a.cj > 0) {
            const float gf256 = __builtin_amdgcn_exp2f(256.0f * a.l2gf), gb256 = __builtin_amdgcn_exp2f(256.0f * a.l2gb);
            const int tid = w * 64 + lane, e = tid >> 3, d0 = (tid & 7) * 8;
            float sf[8], sb[8];
#pragma unroll
            for (int j = 0; j < 8; ++j) { sf[j] = 0.f; sb[j] = 0.f; }
            for (int i = 0; i < a.cj; ++i) { const float* u = a.ust + ((size_t)i * 2 + 0) * 4096 + e * 64 + d0; const f32x4 u0 = *(const f32x4*)u, u1 = *(const f32x4*)(u + 4);
#pragma unroll
                for (int j = 0; j < 4; ++j) { sf[j] = sf[j] * gf256 + u0[j]; sf[4 + j] = sf[4 + j] * gf256 + u1[j]; } }
            { const float* u = a.ust + ((size_t)0 * 2 + 1) * 4096 + e * 64 + d0; const f32x4 u0 = *(const f32x4*)u, u1 = *(const f32x4*)(u + 4);
#pragma unroll
                for (int j = 0; j < 4; ++j) { sb[j] = u0[j]; sb[4 + j] = u1[j]; } }
            for (int i = NCHUNK - 1; i > a.cj; --i) { const float* u = a.ust + ((size_t)i * 2 + 1) * 4096 + e * 64 + d0; const f32x4 u0 = *(const f32x4*)u, u1 = *(const f32x4*)(u + 4);
#pragma unroll
                for (int j = 0; j < 4; ++j) { sb[j] = sb[j] * gb256 + u0[j]; sb[4 + j] = sb[4 + j] * gb256 + u1[j]; } }
            st8l(lds + AT_SF + e * 144 + d0 * 2, sf); st8l(lds + AT_SB + e * 144 + d0 * 2, sb);
        }
        AT_LSTORE(0);
        __syncthreads();
        if (a.cj > 0) {
            f32x16 af0, af1, ab0, ab1;
#pragma unroll
            for (int i = 0; i < 16; ++i) { af0[i] = 0.f; af1[i] = 0.f; ab0[i] = 0.f; ab1[i] = 0.f; }
#pragma unroll
            for (int dc = 0; dc < 4; ++dc) {
                const bf16x8 f0 = *(LAS bf16x8*)(lds + AT_SF + r * 144 + (16 * dc + 8 * h) * 2), f1 = *(LAS bf16x8*)(lds + AT_SF + (32 + r) * 144 + (16 * dc + 8 * h) * 2);
                const bf16x8 b0 = *(LAS bf16x8*)(lds + AT_SB + r * 144 + (16 * dc + 8 * h) * 2), b1 = *(LAS bf16x8*)(lds + AT_SB + (32 + r) * 144 + (16 * dc + 8 * h) * 2);
                af0 = MFMA32(f0, qf[dc], af0); af1 = MFMA32(f1, qf[dc], af1); ab0 = MFMA32(b0, qf[dc], ab0); ab1 = MFMA32(b1, qf[dc], ab1);
            }
            const float xf = __builtin_amdgcn_exp2f(a.l2gf * (float)(nq + 1)), xb = __builtin_amdgcn_exp2f(a.l2gb * (float)(256 - nq));
#pragma unroll
            for (int i = 0; i < 16; ++i) { o0[i] = xf * af0[i] + xb * ab0[i]; o1[i] = xf * af1[i] + xb * ab1[i]; }
        }
#pragma unroll 1
        for (int t = 0; t < a.ntiles; ++t) {
            const int buf = t & 1;
            if (t + 1 < a.ntiles) AT_GLOAD(t + 1);
            LAS unsigned char* kb = lds + (buf ? AT_K1 : AT_K0) + L.klane_off;
            LAS unsigned char* vb = lds + (buf ? AT_V1 : AT_V0) + L.vlane_off;
            f32x16 s0, s1;
#pragma unroll
            for (int i = 0; i < 16; ++i) { s0[i] = 0.f; s1[i] = 0.f; }
#pragma unroll
            for (int dc = 0; dc < 4; ++dc) { s0 = MFMA32(*(LAS bf16x8*)(kb + dc * 2048), qf[dc], s0); s1 = MFMA32(*(LAS bf16x8*)(kb + dc * 2048 + 512), qf[dc], s1); }
#pragma unroll
            for (int i = 0; i < 16; ++i) {
                const int mk = 64 * t + crow(i, h);
                { const int dlt = nq - mk; const float d = dlt > 0 ? __builtin_amdgcn_exp2f(a.l2gf * (float)dlt) : (dlt < 0 ? __builtin_amdgcn_exp2f(a.l2gb * (float)(-dlt)) : 2.0f); s0[i] *= d; }
                { const int dlt = nq - mk - 32; const float d = dlt > 0 ? __builtin_amdgcn_exp2f(a.l2gf * (float)dlt) : (dlt < 0 ? __builtin_amdgcn_exp2f(a.l2gb * (float)(-dlt)) : 2.0f); s1[i] *= d; }
            }
            pv_tile(vb, s0, s1, o0, o1);
            if (t + 1 < a.ntiles) AT_LSTORE(buf ^ 1);
            __syncthreads();
        }
#undef AT_GLOAD
#undef AT_LSTORE
        float sm = 0.f;
#pragma unroll
        for (int i = 0; i < 16; ++i) sm += o0[i] + o1[i];
        sm += __shfl_xor(sm, 32);
        const float mu = sm * (1.0f / 64.0f);
        float vv = 0.f;
#pragma unroll
        for (int i = 0; i < 16; ++i) { o0[i] -= mu; o1[i] -= mu; vv += o0[i] * o0[i] + o1[i] * o1[i]; }
        vv += __shfl_xor(vv, 32);
        const float rs = rsqrtf(vv * (1.0f / 64.0f) + opq(EPS));
        const bf16_t* grow = a.gate + (size_t)(a.qrow0 + nq) * NP;
#pragma unroll
        for (int g4 = 0; g4 < 4; ++g4) {
            const int e0 = 8 * g4 + 4 * h;
            const f32x4 w0 = *(const f32x4*)(a.gnw + e0), w1 = *(const f32x4*)(a.gnw + 32 + e0), b0 = *(const f32x4*)(a.gnb + e0), b1 = *(const f32x4*)(a.gnb + 32 + e0);
            float ga[4], gb[4]; ld4(grow + e0, ga); ld4(grow + 32 + e0, gb);
            float v0[4], v1[4];
#pragma unroll
            for (int j = 0; j < 4; ++j) { v0[j] = (o0[4 * g4 + j] * rs * w0[j] + b0[j]) * silu(ga[j]); v1[j] = (o1[4 * g4 + j] * rs * w1[j] + b1[j]) * silu(gb[j]); }
            st4(orow + e0, v0); st4(orow + 32 + e0, v1);
        }
    }
    __syncthreads();
}

DI void p_attn(const Args& a, int l, LAS unsigned char* lds) {
    asm volatile("s_nop 0\n\ts_nop 0\n\ts_nop 0\n\ts_nop 0\n\ts_nop 0\n\ts_nop 0\n\ts_nop 0\n\ts_nop 0\n\ts_nop 0\n\ts_nop 0\n\ts_nop 0\n\ts_nop 0");
    unsigned char* ws = kws();
    const bool last = (l == NL - 1);
    const bf16_t* P = (const bf16_t*)(wso(ws, WS_P));
    bf16_t* YC = (bf16_t*)(wso(ws, WS_YC));
    int it = 0; const int cslot = (obx() >> 3) & 7; bool cdone = false;
    for (int U = obx(); U < 9 * 256; U += gridDim.x, ++it) {
        if (it == cslot) { conv_experts(l, lds); cdone = true; }
        const int rnd = U >> 8, vb = U & 255, b = vb & 7, i = vb >> 3;
        int mode, hd, qt;
        if (rnd < 8) { mode = rnd >> 1; const int u = i + 32 * (rnd & 1); hd = u >> 4; qt = 1 + (u & 15); }
        else { if (last || i >= 16) continue; mode = i >> 2; hd = i & 3; qt = 0; }
        AttnP p{};
        p.qrow0 = b * SP + qt * 256; p.krow0 = b * SP; p.ntiles = qt == 0 ? 4 : SP / 64;
        if (mode == M_DIFF) {
            p.Q = (const bf16_t*)(wso(ws, WS_QD)) + hd * 64; p.ldq = 256; p.K = (const bf16_t*)(wso(ws, WS_KD)) + hd * 64; p.ldk = 256; p.V = P + C_DV + hd * 64; p.ldv = NP; p.O = YC + 256 + hd * 64;
            p.lam = ((const float*)(wso(ws, WS_TAB) + TAB_LAM))[l]; p.oml = 1.0f - (0.8f - 0.6f * __expf(-0.3f * (float)l)); p.subln = kin(I_DSUB) + l * 64;
            attn_unit<M_DIFF>(lds, p);
        } else if (mode == M_MLA) {
            p.Q = (const bf16_t*)(wso(ws, WS_QM)) + hd * 96; p.ldq = 384; p.K = (const bf16_t*)(wso(ws, WS_KM)) + hd * 96; p.ldk = 384; p.V = (const bf16_t*)(wso(ws, WS_VM)) + hd * 64; p.ldv = 256; p.O = YC + 768 + hd * 64;
            attn_unit<M_MLA>(lds, p);
        } else if (mode == M_GQA) {
            p.Q = (const bf16_t*)(wso(ws, WS_QG)) + hd * 64; p.ldq = 256; p.qnw = kin(I_GQKN) + l * 128; p.K = (const bf16_t*)(wso(ws, WS_KG)) + (hd >> 1) * 64; p.ldk = 128; p.V = P + C_GV + (hd >> 1) * 64; p.ldv = NP; p.O = YC + 512 + hd * 64;
            attn_unit<M_GQA>(lds, p);
        } else {
            p.Q = (const bf16_t*)(wso(ws, WS_QRET)) + hd * 64; p.ldq = 256; p.K = (const bf16_t*)(wso(ws, WS_KRET)) + hd * 64; p.ldk = 256; p.V = P + C_RV + hd * 64; p.ldv = NP; p.O = YC + hd * 64;
            p.krow0 = p.qrow0; p.ntiles = 4; p.cj = qt;
            p.gate = P + C_RG + hd * 64; p.gnw = kin(I_RGNW) + l * 256 + hd * 64; p.gnb = kin(I_RGNB) + l * 256 + hd * 64;
            p.l2gf = -__expf(kin(I_RLD)[l * 8 + hd]) * LOG2E; p.l2gb = -__expf(kin(I_RLD)[l * 8 + 4 + hd]) * LOG2E;
            p.ust = (const float*)(wso(ws, WS_UST)) + ((size_t)b * 4 + hd) * NCHUNK * 2 * 4096;
            attn_unit<M_RET>(lds, p);
        }
    }
    if (!cdone) conv_experts(l, lds);
}

constexpr int N_PHASES = 2 + 8 * NL;
__global__ void __launch_bounds__(NTHR, 2) fwd(Args args) {
    extern __shared__ __attribute__((aligned(16))) unsigned char lds_raw[];
    LAS unsigned char* lds = (LAS unsigned char*)lds_raw;
    if (threadIdx.x < 4) ((LAS unsigned*)(lds + LDS_XB))[threadIdx.x] = 0u;
    __syncthreads();
    if (args.ph_hi - args.ph_lo > 1) (void)xcd_barrier_post((unsigned*)(wso(kws(), WS_CTL)), (volatile LAS unsigned*)(lds + LDS_XB));
#define KLO (*(const int CAS*)(karg_base() + 216))
#define KHI (*(const int CAS*)(karg_base() + 220))
#ifdef PH_MASK
#define IN(k) ((((PH_MASK) >> ((k) < 2 ? (k) : 2 + ((k) - 2) % 8)) & 1) && KLO <= (k) && (k) < KHI)
#else
#define IN(k) (KLO <= (k) && (k) < KHI)
#endif
#define SEAM(k) do { if (IN(k) && IN((k) + 1)) { XcdBarrier bar_; bar_.bar = (unsigned*)(wso(kws(), WS_CTL)); bar_.x = xb_xcc_id(); bar_.st = (volatile LAS unsigned*)(lds + LDS_XB); xcd_barrier(bar_); } } while (0)
    if (IN(0)) { p0_prologue(args, lds); if (DUP(0)) { __syncthreads(); p0_prologue(args, lds); } SEAM(0); }
    if (IN(1)) { p_norm0(args); SEAM(1); }
#pragma unroll 1
    for (int l = 0; l < NL; ++l) {
        const int pb = 2 + 8 * l;
        if (IN(pb + 0)) { p_gemm_dense<0>(l, lds); if (DUP(2)) p_gemm_dense<0>(l, lds); SEAM(pb + 0); }
        if (IN(pb + 1)) { p_prep(args, l, lds); if (DUP(3)) p_prep(args, l, lds); SEAM(pb + 1); }
        if (IN(pb + 2)) { p_attn(args, l, lds); if (DUP(4)) p_attn(args, l, lds); SEAM(pb + 2); }
        if (IN(pb + 3)) { p_gemm_dense<1>(l, lds); if (DUP(5)) p_gemm_dense<1>(l, lds); SEAM(pb + 3); }
        if (IN(pb + 4)) { p_rowA(args, l, lds); if (DUP(6)) { __syncthreads(); p_rowA(args, l, lds, true); } SEAM(pb + 4); }
        if (IN(pb + 5)) { p_gemm_moe<1>(args, l, lds); if (DUP(7)) p_gemm_moe<1>(args, l, lds); SEAM(pb + 5); }
        if (IN(pb + 6)) { p_gemm_moe<2>(args, l, lds); if (DUP(8)) p_gemm_moe<2>(args, l, lds); SEAM(pb + 6); }
        if (IN(pb + 7)) { p_rowB(args, l, lds); if (DUP(9)) { __syncthreads(); p_rowB(args, l, lds, true); } SEAM(pb + 7); }
    }
#undef IN
#undef SEAM
}

extern "C" void kernel_launch(void* const* d_in, const int* in_sizes, int n_in, void* d_out, int out_size, void* d_ws, size_t ws_size, hipStream_t stream) {
    static int grid = 0;
    if (grid == 0) {
        if (n_in != 25 || in_sizes[0] != NB * SEQ * DM || out_size != NB * SEQ * DM || ws_size < WS_END) {
            fprintf(stderr, "kernel_launch: unexpected problem (n_in %d, in0 %d, out %d, ws %zu, need %zu); nothing launched\n", n_in, n_in > 0 ? in_sizes[0] : -1, out_size, ws_size, (size_t)WS_END);
            grid = -1; return; }
        int dev = 0, cus = 0, per_cu = 0;
        if (hipGetDevice(&dev) != hipSuccess || hipDeviceGetAttribute(&cus, hipDeviceAttributeMultiprocessorCount, dev) != hipSuccess) { grid = -1; return; }
        if (hipFuncSetAttribute((const void*)fwd, hipFuncAttributeMaxDynamicSharedMemorySize, LDS_BYTES) != hipSuccess) { fprintf(stderr, "kernel_launch: hipFuncSetAttribute failed\n"); grid = -1; return; }
        if (hipOccupancyMaxActiveBlocksPerMultiprocessor(&per_cu, (const void*)fwd, NTHR, LDS_BYTES) != hipSuccess || per_cu < 1) {
            fprintf(stderr, "kernel_launch: occupancy query says %d blocks per CU\n", per_cu); }
        (void)hipGetLastError();
        grid = cus;
    }
    if (grid < 0) return;
    (void)hipMemsetAsync((char*)d_ws + WS_CTL, 0, CTL_BYTES, stream);
    Args a{};
    for (int i = 0; i < 25; ++i) a.in[i] = (const float*)d_in[i];
    a.out = (float*)d_out; a.ws = (unsigned char*)d_ws;
#if MK_LAUNCHES == 1
    a.ph_lo = 0; a.ph_hi = N_PHASES;
    hipLaunchKernelGGL(fwd, dim3(grid), dim3(NTHR), LDS_BYTES, stream, a);
#else
    for (int k = 0; k < N_PHASES; ++k) { a.ph_lo = k; a.ph_hi = k + 1; hipLaunchKernelGGL(fwd, dim3(grid), dim3(NTHR), LDS_BYTES, stream, a); }
#endif
    const hipError_t le = hipPeekAtLastError();
    if (le != hipSuccess) fprintf(stderr, "kernel_launch: launch failed: %s\n", hipGetErrorName(le));
}
```

```cpp
#include <hip/hip_runtime.h>
#include <stdint.h>
#include <stdio.h>

#ifndef MK_LAUNCHES
#define MK_LAUNCHES 1
#endif
#ifndef DUP_MASK
#define DUP_MASK 0
#endif
#define DUP(k) (((DUP_MASK) >> (k)) & 1)

#define DI __device__ __forceinline__
#define LAS __attribute__((address_space(3)))
typedef unsigned short bf16_t;
typedef short bf16x8 __attribute__((ext_vector_type(8)));
typedef short s16x4 __attribute__((ext_vector_type(4)));
typedef short v4i16_t __attribute__((ext_vector_type(4)));
typedef float f32x2 __attribute__((ext_vector_type(2)));
typedef float f32x4 __attribute__((ext_vector_type(4)));
typedef float f32x16 __attribute__((ext_vector_type(16)));
typedef unsigned u32x2 __attribute__((ext_vector_type(2)));
typedef unsigned u32x4 __attribute__((ext_vector_type(4)));
typedef __bf16 bf16x2v __attribute__((ext_vector_type(2)));

constexpr int DM = 1024, NB = 8, SEQ = 4096, NCTX = 256, SP = SEQ + NCTX, T = NB * SP, NL = 4;
constexpr int NIN = 2656, NP = 3584, NG1 = 2816;
constexpr int NE = 32, DFF2 = 2048;
constexpr int C_RQ = 0, C_RK = 256, C_RV = 512, C_RG = 768, C_DQ = 1024, C_DK = 1280, C_DV = 1536, C_GQ = 1792, C_GK = 2048, C_GV = 2176,
              C_MCQ = 2304, C_MCKV = 2496, C_MKR = 2624, C_MQE = 2656, C_MKVE = 3040, C_END = 3552;
constexpr int NCHUNK = SP / 256;
constexpr int ACT_ROWS = 4 * T + NE * 256;
constexpr float EPS = 1e-6f;
constexpr float LOG2E = 1.4426950408889634f;
constexpr int NTHR = 512;
constexpr int LDS_BYTES = 147456;
constexpr int LDS_XB = LDS_BYTES - 16;

constexpr size_t AL(size_t x) { return (x + 255) & ~(size_t)255; }
constexpr size_t WS_CTL = 0, CTL_BYTES = 65536;
constexpr size_t CTL_GCUR = 16384;
constexpr size_t WS_MOD = WS_CTL + CTL_BYTES;
constexpr size_t WS_TAB = WS_MOD + AL((size_t)NL * 9 * 6144 * 4);
constexpr size_t TAB_R64 = 0, TAB_R32 = 8192, TAB_LAM = 12288;
constexpr size_t WS_WUQ = WS_TAB + 16384;
constexpr size_t WS_WUKV = WS_WUQ + AL((size_t)NL * 384 * 192 * 2);
constexpr size_t WS_WIN = WS_WUKV + AL((size_t)NL * 512 * 128 * 2);
constexpr size_t WS_WOUT = WS_WIN + (size_t)NL * NP * DM * 2;
constexpr size_t WS_W1 = WS_WOUT + (size_t)NL * DM * DM * 2;
constexpr size_t WS_W2 = WS_W1 + (size_t)NL * NE * DFF2 * DM;
constexpr size_t WS_H8 = WS_W2 + (size_t)NL * NE * DM * DM;
constexpr size_t WS_XS = WS_H8 + (size_t)T * DM;
constexpr size_t WS_H = WS_XS + (size_t)T * DM * 4;
constexpr size_t WS_P = WS_H + (size_t)T * DM * 2;
constexpr size_t WS_QRET = WS_P + (size_t)T * NP * 2;
constexpr size_t WS_KRET = WS_QRET + (size_t)T * 256 * 2;
constexpr size_t WS_QD = WS_KRET + (size_t)T * 256 * 2;
constexpr size_t WS_KD = WS_QD + (size_t)T * 256 * 2;
constexpr size_t WS_QG = WS_KD + (size_t)T * 256 * 2;
constexpr size_t WS_KG = WS_QG + (size_t)T * 256 * 2;
constexpr size_t WS_QM = WS_KG + (size_t)T * 128 * 2;
constexpr size_t WS_KM = WS_QM + (size_t)T * 384 * 2;
constexpr size_t WS_VM = WS_KM + (size_t)T * 384 * 2;
constexpr size_t WS_UST = WS_VM + (size_t)T * 256 * 2;
constexpr size_t WS_YC = WS_UST + (size_t)NB * 4 * NCHUNK * 2 * 4096 * 4;
constexpr size_t WS_YO = WS_YC + (size_t)T * DM * 2;
constexpr size_t WS_LIST = WS_YO + (size_t)T * DM * 2;
constexpr size_t WS_RSLOT = WS_LIST + (size_t)NE * T * 4;
constexpr size_t WS_RGATE = WS_RSLOT + (size_t)T * 16;
constexpr size_t WS_ACT = WS_RGATE + (size_t)T * 16;
constexpr size_t WS_YR = WS_ACT + (size_t)ACT_ROWS * DM;
constexpr size_t WS_END = WS_YR + (size_t)ACT_ROWS * DM * 2;

#define XB_TMO      128
#define XB_XCNT(j)  (256  + 64 * (j))
#define XB_XSUB(j)  (1280 + 64 * (j))
#define XB_XGEN(j)  (2304 + 64 * (j))
#define XB_TOP      3328
#define XB_TOPGEN   3392
#define XCD_BAR_WORDS 3456
#define XB_SPIN_CAP (1u << 18)

__device__ __forceinline__ unsigned xb_ld(unsigned* p)              { return __hip_atomic_load(p, __ATOMIC_RELAXED, __HIP_MEMORY_SCOPE_AGENT); }
__device__ __forceinline__ unsigned xb_add(unsigned* p, unsigned v) { return __hip_atomic_fetch_add(p, v, __ATOMIC_RELAXED, __HIP_MEMORY_SCOPE_AGENT); }
__device__ __forceinline__ unsigned xb_xcc_id() { return (unsigned)__builtin_amdgcn_s_getreg((3 << 11) | 20) & 0xFu; }
#define XB_SPIN(cond, bar) do { unsigned _sp = 0; while (cond) { __builtin_amdgcn_s_sleep(1); \
    if ((++_sp & 255u) == 0u) { if (xb_ld(&(bar)[XB_TMO])) break; if (_sp > XB_SPIN_CAP) { atomicAdd(&(bar)[XB_TMO], 1u); break; } } } } while (0)

struct XcdBarrier { unsigned* bar; unsigned x; volatile LAS unsigned* st; };

__device__ __forceinline__ XcdBarrier xcd_barrier_post(unsigned* bar, volatile LAS unsigned* st) {
    XcdBarrier b; b.bar = bar; b.x = xb_xcc_id(); b.st = st;
    if (threadIdx.x == 0) (void)xb_add(&bar[XB_XCNT(b.x)], 1u);
    return b;
}
__device__ __forceinline__ void xcd_barrier_complete(unsigned* bar, unsigned x, unsigned& nloc, unsigned& nx) {
    const unsigned G = gridDim.x * gridDim.y * gridDim.z;
    unsigned sum, cnt, mine, sp = 0u;
    for (;;) {
        sum = 0u; cnt = 0u; mine = 0u;
#pragma unroll
        for (unsigned j = 0; j < 16; ++j) { const unsigned c = xb_ld(&bar[XB_XCNT(j)]); sum += c; cnt += (c > 0u) ? 1u : 0u; mine = (j == x) ? c : mine; }
        if (sum == G) break;
        __builtin_amdgcn_s_sleep(1);
        if ((++sp & 255u) == 0u) { if (xb_ld(&bar[XB_TMO])) break; if (sp > XB_SPIN_CAP) { atomicAdd(&bar[XB_TMO], 1u); break; } }
    }
    nloc = mine > 0u ? mine : 1u; nx = cnt > 0u ? cnt : 1u;
}
__device__ __forceinline__ void xcd_barrier(const XcdBarrier& b) {
    asm volatile("s_waitcnt vmcnt(0)" ::: "memory");
    __syncthreads();
    if (threadIdx.x == 0) {
        unsigned* bar = b.bar;
        __builtin_amdgcn_s_waitcnt(0);
        unsigned nloc = b.st[0], nx = b.st[1];
        if (nloc == 0u) { xcd_barrier_complete(bar, b.x, nloc, nx); b.st[0] = nloc; b.st[1] = nx; }
        const unsigned old = xb_add(&bar[XB_XSUB(b.x)], 1u);
        const unsigned gen = old / nloc;
        if (old + 1u == (gen + 1u) * nloc) {
            __builtin_amdgcn_fence(__ATOMIC_RELEASE, "agent");
            asm volatile("s_waitcnt vmcnt(0)" ::: "memory");
            const unsigned og = xb_add(&bar[XB_TOP], 1u);
            const unsigned tg = og / nx;
            if (og + 1u == (tg + 1u) * nx) xb_add(&bar[XB_TOPGEN], 1u);
            else XB_SPIN(xb_ld(&bar[XB_TOPGEN]) == tg, bar);
            __builtin_amdgcn_fence(__ATOMIC_ACQUIRE, "agent");
            xb_add(&bar[XB_XGEN(b.x)], 1u);
            asm volatile("s_waitcnt vmcnt(0)" ::: "memory");
        } else {
            XB_SPIN(xb_ld(&bar[XB_XGEN(b.x)]) == gen, bar);
            __builtin_amdgcn_fence(__ATOMIC_ACQUIRE, "agent");
            asm volatile("s_waitcnt vmcnt(0)" ::: "memory");
        }
    }
    __syncthreads();
}

DI float bf2f(unsigned short x) { return __uint_as_float((unsigned)x << 16); }
DI float bflo(unsigned u) { return __uint_as_float(u << 16); }
DI float bfhi(unsigned u) { return __uint_as_float(u & 0xffff0000u); }
DI unsigned pk2(float lo, float hi) { f32x2 v = {lo, hi}; bf16x2v b = __builtin_convertvector(v, bf16x2v); return __builtin_bit_cast(unsigned, b); }
constexpr float S_W8 = 256.0f, S_H8 = 16.0f, S_A8 = 4.0f, S_Y8 = 16.0f, S_C8 = 16.0f;
DI unsigned pk4_fp8(float a, float b, float c, float d) { int v = __builtin_amdgcn_cvt_pk_fp8_f32(a, b, 0, false); v = __builtin_amdgcn_cvt_pk_fp8_f32(c, d, v, true); return (unsigned)v; }
DI unsigned pk2_fp8(float a, float b) { return (unsigned)__builtin_amdgcn_cvt_pk_fp8_f32(a, b, 0, false) & 0xffffu; }
DI float sat8(float x, float lim) { return fminf(fmaxf(x, -lim), lim); }
DI float opq(float c) { asm volatile("" : "+v"(c)); return c; }
DI float opq_s(float c) { asm volatile("" : "+s"(c)); return c; }
DI void ld4(const bf16_t* p, float (&o)[4]) { const u32x2 u = *(const u32x2*)p; o[0] = bflo(u.x); o[1] = bfhi(u.x); o[2] = bflo(u.y); o[3] = bfhi(u.y); }
DI void st4(bf16_t* p, const float (&v)[4]) { u32x2 u; u.x = pk2(v[0], v[1]); u.y = pk2(v[2], v[3]); *(u32x2*)p = u; }
DI void ld8(const bf16_t* p, float (&o)[8]) { const u32x4 u = *(const u32x4*)p; o[0] = bflo(u.x); o[1] = bfhi(u.x); o[2] = bflo(u.y); o[3] = bfhi(u.y); o[4] = bflo(u.z); o[5] = bfhi(u.z); o[6] = bflo(u.w); o[7] = bfhi(u.w); }
DI void st8(bf16_t* p, const float (&v)[8]) { u32x4 u; u.x = pk2(v[0], v[1]); u.y = pk2(v[2], v[3]); u.z = pk2(v[4], v[5]); u.w = pk2(v[6], v[7]); *(u32x4*)p = u; }
template <int CTRL> DI float dpp_f(float v) { return __int_as_float(__builtin_amdgcn_update_dpp(0, __float_as_int(v), CTRL, 0xf, 0xf, true)); }
DI float sum8_dpp(float v) { v += dpp_f<0xB1>(v); v += dpp_f<0x4E>(v); v += dpp_f<0x141>(v); return v; }
DI float xor32_f(float v) { auto rr = __builtin_amdgcn_permlane32_swap(__float_as_uint(v), __float_as_uint(v), false, false); return __uint_as_float((threadIdx.x & 32) ? rr[0] : rr[1]); }
DI float wave_sum(float v) {
    v = sum8_dpp(v); v += dpp_f<0x140>(v);
    const float r0 = __int_as_float(__builtin_amdgcn_readlane(__float_as_int(v), 0)), r1 = __int_as_float(__builtin_amdgcn_readlane(__float_as_int(v), 16));
    const float r2 = __int_as_float(__builtin_amdgcn_readlane(__float_as_int(v), 32)), r3 = __int_as_float(__builtin_amdgcn_readlane(__float_as_int(v), 48));
    return (r0 + r1) + (r2 + r3);
}
DI float silu(float x) { return x / (1.0f + __expf(-x)); }
#define MFMA32(a, b, c) __builtin_amdgcn_mfma_f32_32x32x16_bf16((a), (b), (c), 0, 0, 0)
DI f32x16 mfma32_c(bf16x8 a, bf16x8 b, const f32x16& c) { f32x16 d; asm("v_mfma_f32_32x32x16_bf16 %0, %1, %2, %3" : "=&v"(d) : "v"(a), "v"(b), "v"(c)); return d; }
DI int crow(int reg, int h) { return (reg & 3) + 8 * (reg >> 2) + 4 * h; }
DI s16x4 trread(LAS unsigned char* p) { return __builtin_bit_cast(s16x4, __builtin_amdgcn_ds_read_tr16_b64_v4i16((LAS v4i16_t*)p)); }

struct Args { const float* in[25]; float* out; unsigned char* ws; int ph_lo, ph_hi; };
enum { I_X = 0, I_C, I_CTX, I_CCTX, I_ADAW, I_ADAB, I_NORMG, I_WIN, I_WOUT, I_RLD, I_RGNW, I_RGNB, I_DLAM, I_DSUB, I_GQKN, I_MQN, I_MKVN, I_MUQ, I_MUKV,
       I_RW, I_RB, I_EW1, I_EB1, I_EW2, I_EB2 };


DI int otid() { int t = threadIdx.x; asm volatile("" : "+v"(t)); return t; }
DI int obx() { int b = blockIdx.x; asm volatile("" : "+s"(b)); return b; }
#define CAS __attribute__((address_space(4)))
DI const CAS char* karg_base() { const CAS char* ka = (const CAS char*)__builtin_amdgcn_kernarg_segment_ptr(); asm volatile("" : "+s"(ka)); return ka; }
DI const float* kin(int i) { return *(const float* const CAS*)(karg_base() + 8 * i); }
DI float* kout() { return *(float* const CAS*)(karg_base() + 200); }
DI unsigned char* kws() { return *(unsigned char* const CAS*)(karg_base() + 208); }

DI unsigned char* wso(unsigned char* ws, size_t off) { asm volatile("" : "+s"(off)); return ws + off; }

DI const float* input_row(const Args& a, int row) {
    const int b = row / SP, pos = row - b * SP;
    return pos < NCTX ? kin(I_CTX) + ((size_t)b * NCTX + pos) * DM : kin(I_X) + ((size_t)b * SEQ + (pos - NCTX)) * DM;
}

DI void tconv_unit(const float* __restrict__ src, int ldn, int nvalid, bf16_t* __restrict__ dst, int k0, int n0) {
    const int tid_ = otid(), lane = tid_ & 63, w = __builtin_amdgcn_readfirstlane(tid_ >> 6);
    const int n = n0 + w * 64 + lane;
    if (n < nvalid) {
        const float* s = src + (size_t)k0 * ldn + n;
        float v[64];
#pragma unroll
        for (int j = 0; j < 64; ++j) v[j] = s[(size_t)j * ldn];
        bf16_t* d = dst + (size_t)n * DM + k0;
#pragma unroll
        for (int j = 0; j < 8; ++j) {
            u32x4 o; o.x = pk2(v[8 * j], v[8 * j + 1]); o.y = pk2(v[8 * j + 2], v[8 * j + 3]); o.z = pk2(v[8 * j + 4], v[8 * j + 5]); o.w = pk2(v[8 * j + 6], v[8 * j + 7]);
            *(u32x4*)(d + 8 * j) = o;
        }
    }
}

constexpr int CV_PITCH = 136;
DI void tconv_unit_f8(const float* __restrict__ src, int ldn, int nvalid, uint8_t* __restrict__ dst, int k0, int n0) {
    const int tid_ = otid(), lane = tid_ & 63, w = __builtin_amdgcn_readfirstlane(tid_ >> 6);
    const int n = n0 + w * 64 + lane;
    if (n >= nvalid) return;
    const float* sp = src + (size_t)k0 * ldn + n;
    float v[64];
#pragma unroll
    for (int j = 0; j < 64; ++j) v[j] = sp[(size_t)j * ldn];
    uint8_t* d = dst + (size_t)n * DM + k0;
#pragma unroll
    for (int j = 0; j < 4; ++j) {
        u32x4 o; o.x = pk4_fp8(v[16 * j] * S_W8, v[16 * j + 1] * S_W8, v[16 * j + 2] * S_W8, v[16 * j + 3] * S_W8); o.y = pk4_fp8(v[16 * j + 4] * S_W8, v[16 * j + 5] * S_W8, v[16 * j + 6] * S_W8, v[16 * j + 7] * S_W8);
        o.z = pk4_fp8(v[16 * j + 8] * S_W8, v[16 * j + 9] * S_W8, v[16 * j + 10] * S_W8, v[16 * j + 11] * S_W8); o.w = pk4_fp8(v[16 * j + 12] * S_W8, v[16 * j + 13] * S_W8, v[16 * j + 14] * S_W8, v[16 * j + 15] * S_W8);
        *(u32x4*)(d + 16 * j) = o;
    }
}
DI void tconv_unit8(const float* __restrict__ src, int ldn, uint8_t* __restrict__ dst, int k0, int n0, LAS unsigned char* lds) {
    const int tid_ = otid(), lane = tid_ & 63, w = __builtin_amdgcn_readfirstlane(tid_ >> 6);
#pragma unroll 1
    for (int hf = 0; hf < 2; ++hf) {
        const float* sp = src + (size_t)(k0 + 64 * hf + 8 * w) * ldn + n0 + lane * 4;
        f32x4 v[32];
#pragma unroll
        for (int j = 0; j < 32; ++j) v[j] = *(const f32x4*)(sp + (size_t)(j >> 2) * ldn + (j & 3) * 256);
        __builtin_amdgcn_sched_barrier(0);
        LAS unsigned char* lp = lds + (4 * lane) * CV_PITCH + 64 * hf + 8 * w;
#pragma unroll
        for (int q = 0; q < 4; ++q)
#pragma unroll
            for (int c = 0; c < 4; ++c) {
                u32x2 o;
                o.x = pk4_fp8(v[0 + q][c] * S_W8, v[4 + q][c] * S_W8, v[8 + q][c] * S_W8, v[12 + q][c] * S_W8);
                o.y = pk4_fp8(v[16 + q][c] * S_W8, v[20 + q][c] * S_W8, v[24 + q][c] * S_W8, v[28 + q][c] * S_W8);
                *(LAS u32x2*)(lp + (256 * q + c) * CV_PITCH) = o;
            }
    }
    __syncthreads();
    {
        const int t = otid(), r0 = t >> 3, ch = t & 7;
        uint8_t* dp = dst + (size_t)(n0 + r0) * DM + k0 + ch * 16;
        const LAS unsigned char* lp = lds + r0 * CV_PITCH + ch * 16;
#pragma unroll 4
        for (int p = 0; p < 16; ++p) {
            const u32x2 x = *(const LAS u32x2*)(lp + p * 64 * CV_PITCH), y = *(const LAS u32x2*)(lp + p * 64 * CV_PITCH + 8);
            *(u32x4*)(dp + (size_t)p * 64 * DM) = (u32x4){x.x, x.y, y.x, y.y};
        }
    }
    __syncthreads();
}

DI void conv_experts(int l, LAS unsigned char* lds) {
    constexpr int U_W1 = NE * 8 * 2, U_W2 = NE * 8;
    unsigned char* ws = kws();
    __syncthreads();
    for (int v = obx(); v < U_W1 + U_W2; v += gridDim.x) {
        if (v < U_W1) { const int e = v / 16, r = v % 16, kt = r / 2, nt = r % 2;
            tconv_unit8(kin(I_EW1) + ((size_t)l * NE + e) * DM * DFF2, DFF2, (uint8_t*)(wso(ws, WS_W1)) + ((size_t)l * NE + e) * DFF2 * DM, kt * 128, nt * 1024, lds); }
        else { const int v2 = v - U_W1, e = v2 / 8, kt = v2 % 8;
            tconv_unit8(kin(I_EW2) + ((size_t)l * NE + e) * DM * DM, DM, (uint8_t*)(wso(ws, WS_W2)) + ((size_t)l * NE + e) * DM * DM, kt * 128, 0, lds); }
    }
}

DI void p0_prologue(const Args& a, LAS unsigned char* lds) {
    const int tid = otid(), lane = tid & 63, w = __builtin_amdgcn_readfirstlane(tid >> 6), G = gridDim.x, bx = obx();
    unsigned char* ws = kws();
    {
        constexpr int U_WIN = 16 * 6, U_WOUT = 16 * 2, U_L = U_WIN + U_WOUT;
        for (int u = bx; u < NL * U_L; u += G) {
            const int l = u / U_L; int v = u - l * U_L;
            if (v < U_WIN) { const int kt = v / 6, nt = v % 6;
                tconv_unit_f8(kin(I_WIN) + (size_t)l * DM * NIN, NIN, NIN, (uint8_t*)(wso(ws, WS_WIN)) + (size_t)l * NP * DM, kt * 64, nt * 512); continue; }
            v -= U_WIN;
            { const int kt = v / 2, nt = v % 2;
                tconv_unit_f8(kin(I_WOUT) + (size_t)l * DM * DM, DM, DM, (uint8_t*)(wso(ws, WS_WOUT)) + (size_t)l * DM * DM, kt * 64, nt * 512); }
        }
    }
    {
        LAS float* sv = (LAS float*)lds;
        LAS float* red = (LAS float*)(lds + 9 * 1024 * 4);
        for (int i = tid; i < 9 * 1024; i += NTHR) { const int v = i >> 10, k = i & 1023; const float c = v < 8 ? kin(I_C)[v * DM + k] : kin(I_CCTX)[k]; sv[i] = silu(c); }
        __syncthreads();
        for (int it = bx; it < NL * 64; it += G) {
            const int l = it >> 6, n0 = (it & 63) * 96;
            const float* wp = kin(I_ADAW) + (size_t)l * DM * 6144 + (size_t)(w * 128) * 6144 + n0 + (lane < 48 ? lane : 47) * 2;
            f32x2 acc[9];
#pragma unroll
            for (int v = 0; v < 9; ++v) acc[v] = (f32x2){0.f, 0.f};
#pragma unroll 1
            for (int kb = 0; kb < 128; kb += 64) {
                f32x2 wv[64];
#pragma unroll
                for (int j = 0; j < 64; ++j) wv[j] = *(const f32x2*)(wp + (size_t)(kb + j) * 6144);
                __builtin_amdgcn_sched_barrier(0);
                LAS float* sk = sv + w * 128 + kb;
#pragma unroll
                for (int j = 0; j < 64; j += 2)
#pragma unroll
                    for (int v = 0; v < 9; ++v) { const f32x2 s2 = *(LAS f32x2*)(sk + v * 1024 + j); acc[v] += wv[j] * s2.x; acc[v] += wv[j + 1] * s2.y; }
            }
            if (lane < 48) {
#pragma unroll
                for (int v = 0; v < 9; ++v) *(LAS f32x2*)(red + (w * 9 + v) * 96 + lane * 2) = acc[v]; }
            __syncthreads();
            for (int i = tid; i < 9 * 96; i += NTHR) {
                const int v = i / 96, c = i - v * 96; float s_ = 0.f;
#pragma unroll
                for (int ww = 0; ww < 8; ++ww) s_ += red[(ww * 9 + v) * 96 + c];
                ((float*)(wso(ws, WS_MOD)))[((size_t)l * 9 + v) * 6144 + n0 + c] = s_ + kin(I_ADAB)[l * 6144 + n0 + c];
            }
            __syncthreads();
        }
    }
    __syncthreads();
    {
        constexpr int NQ = NL * 384 * 24, NKV = NL * 512 * 16;
        for (int i = bx * NTHR + tid; i < NQ + NKV; i += G * NTHR) {
            const bool isq = i < NQ; const int j = isq ? i : i - NQ;
            const int K = isq ? 192 : 128, N = isq ? 384 : 512, k8 = j % (K / 8), n = (j / (K / 8)) % N, l = j / ((K / 8) * N);
            const float* wu = (isq ? kin(I_MUQ) : kin(I_MUKV)) + (size_t)l * K * N + n; const float* nr = (isq ? kin(I_MQN) : kin(I_MKVN)) + l * K;
            float v[8];
#pragma unroll
            for (int q = 0; q < 8; ++q) v[q] = wu[(size_t)(k8 * 8 + q) * N] * nr[k8 * 8 + q];
            bf16_t* dq = (bf16_t*)(wso(ws, WS_WUQ)); bf16_t* dkv = (bf16_t*)(wso(ws, WS_WUKV));
            st8((isq ? dq : dkv) + ((size_t)l * N + n) * K + k8 * 8, v);
        }
    }
    for (int r = bx; r < NL * (NG1 - NIN); r += G) { const int l = r / (NG1 - NIN), rr = r % (NG1 - NIN); if (tid < 256) ((unsigned*)((uint8_t*)(wso(ws, WS_WIN)) + ((size_t)l * NP + NIN + rr) * DM))[tid] = 0u; }
    if (bx == G - 1) {
        f32x2* r64 = (f32x2*)(wso(ws, WS_TAB) + TAB_R64); f32x2* r32 = (f32x2*)(wso(ws, WS_TAB) + TAB_R32);
        for (int i = tid; i < 64 * 16; i += NTHR) { const int p = i >> 4, f = i & 15; const float inv = powf(10000.0f, -(float)f / 16.0f); const float ang = (float)p * inv; r64[i] = (f32x2){cosf(ang), sinf(ang)}; }
        for (int i = tid; i < 64 * 8; i += NTHR) { const int p = i >> 3, f = i & 7; const float inv = powf(10000.0f, -(float)f / 8.0f); const float ang = (float)p * inv; r32[i] = (f32x2){cosf(ang), sinf(ang)}; }
        if (tid < NL) {
            const float* lp = kin(I_DLAM) + tid * 4 * 32; float s1 = 0.f, s2 = 0.f;
            for (int i = 0; i < 32; ++i) { s1 += lp[i] * lp[32 + i]; s2 += lp[64 + i] * lp[96 + i]; }
            const float lam_init = 0.8f - 0.6f * expf(-0.3f * (float)tid);
            ((float*)(wso(ws, WS_TAB) + TAB_LAM))[tid] = expf(s1) - expf(s2) + lam_init;
        }
    }
}

struct Row16 { f32x4 v[4]; };
DI Row16 ld_f32row(const float* p, int lane) { Row16 r;
#pragma unroll
    for (int i = 0; i < 4; ++i) r.v[i] = *(const f32x4*)(p + i * 256 + lane * 4);
    return r; }
DI void st_f32row(float* p, int lane, const Row16& r) {
#pragma unroll
    for (int i = 0; i < 4; ++i) *(f32x4*)(p + i * 256 + lane * 4) = r.v[i]; }
DI Row16 ld_bf16row(const bf16_t* p, int lane) { Row16 r;
#pragma unroll
    for (int i = 0; i < 4; ++i) { const u32x2 u = *(const u32x2*)(p + i * 256 + lane * 4); r.v[i] = (f32x4){bflo(u.x), bfhi(u.x), bflo(u.y), bfhi(u.y)}; }
    return r; }
DI void st_bf16row(bf16_t* p, int lane, const Row16& r) {
#pragma unroll
    for (int i = 0; i < 4; ++i) { u32x2 u; u.x = pk2(r.v[i][0], r.v[i][1]); u.y = pk2(r.v[i][2], r.v[i][3]); *(u32x2*)(p + i * 256 + lane * 4) = u; } }
DI void st_fp8row(uint8_t* p, int lane, const Row16& r) {
    const float lim = opq_s(448.0f);
#pragma unroll
    for (int i = 0; i < 4; ++i) *(unsigned*)(p + i * 256 + lane * 4) = pk4_fp8(__builtin_amdgcn_fmed3f(r.v[i][0] * S_H8, -lim, lim), __builtin_amdgcn_fmed3f(r.v[i][1] * S_H8, -lim, lim),
                                                                             __builtin_amdgcn_fmed3f(r.v[i][2] * S_H8, -lim, lim), __builtin_amdgcn_fmed3f(r.v[i][3] * S_H8, -lim, lim)); }
DI float row_ss(const Row16& r) { float s = 0.f;
#pragma unroll
    for (int i = 0; i < 4; ++i) s += r.v[i][0] * r.v[i][0] + r.v[i][1] * r.v[i][1] + r.v[i][2] * r.v[i][2] + r.v[i][3] * r.v[i][3];
    return wave_sum(s); }
typedef const __attribute__((address_space(1))) f32x4* gv4p;
DI Row16 modulate_row(const Row16& x, const float* g, const float* shift, const float* scale, int lane) {
    f32x4 gv[4], sh[4], sc[4];
#pragma unroll
    for (int i = 0; i < 4; ++i) { gv[i] = *(gv4p)(g + i * 256 + lane * 4); sh[i] = *(gv4p)(shift + i * 256 + lane * 4); sc[i] = *(gv4p)(scale + i * 256 + lane * 4); }
    const float rstd = rsqrtf(row_ss(x) * (1.0f / DM) + opq(EPS)); Row16 h;
#pragma unroll
    for (int i = 0; i < 4; ++i) h.v[i] = x.v[i] * rstd * gv[i] * (sc[i] + 1.0f) + sh[i];
    return h; }

DI void p_norm0(const Args& a) {
    const int tid = otid(), lane = tid & 63, w = __builtin_amdgcn_readfirstlane(tid >> 6);
    const float* mod = (const float*)(wso(kws(), WS_MOD));
    for (int row = obx() * 8 + w; row < T; row += gridDim.x * 8) {
        const int b = row / SP, pos = row - b * SP; const float* m = mod + (size_t)(pos < NCTX ? 8 : b) * 6144;
        const Row16 x = ld_f32row(input_row(a, row), lane);
        const Row16 h = modulate_row(x, kin(I_NORMG), m, m + 1024, lane);
        st_fp8row((uint8_t*)(wso(kws(), WS_H)) + (size_t)row * DM, lane, h);
    }
}

constexpr int RA_WR = 0, RA_WRP = 1028, RA_SCR = 32 * RA_WRP * 4  , RA_SCRW = 320, RA_RECE = RA_SCR + 8 * RA_SCRW, RA_RECG = RA_RECE + 2176,
              RA_CNT = RA_RECG + 2176, RA_BASE = RA_CNT + 128, RA_RB = RA_BASE + 128, RA_CC = RA_RB + 128, RA_CB = RA_CC + 4096, RA_END = RA_CB + 4096;
static_assert(RA_END <= LDS_XB, "lds");
constexpr int ROWS_PER_BLK = 136;

struct RowAIn { Row16 x; u32x2 y[4]; };
DI RowAIn rowA_load(const Args& a, int l, int row, int lane) {
    RowAIn r; unsigned char* ws = kws();
    if (l == 0) r.x = ld_f32row(input_row(a, row), lane);
    else { const bf16_t* xp = (const bf16_t*)(wso(ws, WS_XS)) + (size_t)row * DM;
#pragma unroll
        for (int i = 0; i < 4; ++i) { const u32x2 u = *(const u32x2*)(xp + i * 256 + lane * 4); r.x.v[i] = (f32x4){__uint_as_float(u.x), __uint_as_float(u.y), 0.f, 0.f}; } }
    const bf16_t* yp = (const bf16_t*)(wso(ws, WS_YO)) + (size_t)row * DM;
#pragma unroll
    for (int i = 0; i < 4; ++i) r.y[i] = *(const u32x2*)(yp + i * 256 + lane * 4);
    return r;
}
DI void rowA_route(int lane, LAS float* scr, bool present, bool valid, int rlq, LAS int* rece, LAS float* recg, LAS int* cnt) {
    if (!present) return;
    if (!valid) { if (lane < 4) rece[rlq * 4 + lane] = -1; return; }
    asm volatile("" ::: "memory");
    const int e_own = lane >> 1;
    const float logit = scr[e_own];
    int rank = 0;
#pragma unroll
    for (int e4 = 0; e4 < 8; ++e4) { const f32x4 o = *(LAS f32x4*)(scr + 4 * e4);
#pragma unroll
        for (int j = 0; j < 4; ++j) rank += (o[j] > logit || (o[j] == logit && 4 * e4 + j < e_own)) ? 1 : 0; }
    if ((lane & 1) == 0 && rank < 4) { scr[32 + rank] = logit; scr[36 + rank] = __int_as_float(e_own); }
    asm volatile("" ::: "memory");
    const f32x4 tv = *(LAS f32x4*)(scr + 32);
    const float e0 = 1.0f, e1 = __expf(tv[1] - tv[0]), e2 = __expf(tv[2] - tv[0]), e3 = __expf(tv[3] - tv[0]), inv = 1.0f / (e0 + e1 + e2 + e3);
    if (lane < 4) {
        const int e = __float_as_int(scr[36 + lane]);
        const float g = (lane == 0 ? e0 : lane == 1 ? e1 : lane == 2 ? e2 : e3) * inv;
        const int lp = __hip_atomic_fetch_add(&cnt[e], 1, __ATOMIC_RELAXED, __HIP_MEMORY_SCOPE_WORKGROUP);
        rece[rlq * 4 + lane] = (e << 16) | lp; recg[rlq * 4 + lane] = g;
    }
    asm volatile("" ::: "memory");
}
DI void p_rowA(const Args& a, int l, LAS unsigned char* lds, bool dry = false) {
    const int tid = otid(), lane = tid & 63, w = __builtin_amdgcn_readfirstlane(tid >> 6);
    const bool last = (l == NL - 1);
    unsigned char* ws = kws();
    LAS float* wr = (LAS float*)(lds + RA_WR);
    LAS float* scr = (LAS float*)(lds + RA_SCR + w * RA_SCRW);
    LAS int* rece = (LAS int*)(lds + RA_RECE); LAS float* recg = (LAS float*)(lds + RA_RECG);
    LAS int* cnt = (LAS int*)(lds + RA_CNT); LAS int* base = (LAS int*)(lds + RA_BASE);
    {   const float* rw = kin(I_RW) + (size_t)l * DM * NE;
#pragma unroll 1
        for (int i0 = 0; i0 < DM * NE; i0 += 16 * NTHR) { float t[16];
#pragma unroll
            for (int j = 0; j < 16; ++j) t[j] = rw[i0 + j * NTHR + tid];
#pragma unroll
            for (int j = 0; j < 16; ++j) { const int i = i0 + j * NTHR + tid; wr[(i & 31) * RA_WRP + (i >> 5)] = t[j]; } }
        if (tid < 32) { cnt[tid] = 0; ((LAS float*)(lds + RA_RB))[tid] = kin(I_RB)[l * NE + tid]; }
    }
    __syncthreads();
    const float* mod = (const float*)(wso(ws, WS_MOD)) + (size_t)l * 9 * 6144;
    const float* ng = kin(I_NORMG) + (size_t)l * 4 * DM;
    LAS float* rb = (LAS float*)(lds + RA_RB);
    int* gcur = (int*)(wso(ws, WS_CTL) + (dry ? 49152 : CTL_GCUR)) + l * NE * (dry ? 16 : 64);
    const int gstride = dry ? 16 : 64;
    bf16_t* XSo = (bf16_t*)(ws + (dry ? WS_ACT : WS_XS)); uint8_t* Ho = (uint8_t*)(ws + (dry ? WS_YR : WS_H8));
    unsigned char* LSo = ws + (dry ? WS_YR + ((size_t)100 << 20) : WS_LIST);
    for (int chunk = obx(); chunk * ROWS_PER_BLK < T; chunk += gridDim.x) {
        const int row0 = chunk * ROWS_PER_BLK;
        Row16 cA;
        LAS float* cCl = (LAS float*)(lds + RA_CC); LAS float* cBl = (LAS float*)(lds + RA_CB);
        const bool cctx = (row0 % SP) < NCTX;
        {   const float* mL = mod + (size_t)(cctx ? 8 : row0 / SP) * 6144;
#pragma unroll
            for (int i = 0; i < 4; ++i) { const int o = i * 256 + lane * 4;
                cA.v[i] = *(const f32x4*)(mL + 2048 + o) * *(const f32x4*)(ng + DM + o); }
            __syncthreads();
            if (tid < 256) *(LAS f32x4*)(cCl + tid * 4) = *(const f32x4*)(mL + 3072 + tid * 4);
            else *(LAS f32x4*)(cBl + (tid - 256) * 4) = *(const f32x4*)(ng + 2 * DM + (tid - 256) * 4) * (*(const f32x4*)(mL + 4096 + (tid - 256) * 4) + 1.0f);
            __syncthreads(); }
        RowAIn cur[2];
        cur[0] = rowA_load(a, l, row0 + w, lane); cur[1] = rowA_load(a, l, row0 + w + 8, lane);
#pragma unroll 1
        for (int rl = w; rl < ROWS_PER_BLK; rl += 16) {
            const bool two = rl + 8 < ROWS_PER_BLK;
            RowAIn nxt[2];
            {   const int n0 = rl + 16 < ROWS_PER_BLK ? rl + 16 : rl, n1 = rl + 24 < ROWS_PER_BLK ? rl + 24 : n0;
                nxt[0] = rowA_load(a, l, row0 + n0, lane); nxt[1] = rowA_load(a, l, row0 + n1, lane); }
            asm volatile("" : "+s"(ng), "+s"(mod));
            Row16 h[2]; bool valid[2];
#pragma unroll
            for (int q = 0; q < 2; ++q) {
                const int rlq = rl + 8 * q, row = row0 + (q == 0 || two ? rlq : rl), b = row / SP, pos = row - b * SP; const bool isctx = pos < NCTX;
                valid[q] = (q == 0 || two) && !(last && isctx);
                const float* m = mod + (size_t)(isctx ? 8 : b) * 6144;
                Row16 x = cur[q].x, y;
                if (l != 0) {
#pragma unroll
                    for (int i = 0; i < 4; ++i) { const unsigned u0 = __float_as_uint(cur[q].x.v[i][0]), u1 = __float_as_uint(cur[q].x.v[i][1]); x.v[i] = (f32x4){bflo(u0), bfhi(u0), bflo(u1), bfhi(u1)}; } }
#pragma unroll
                for (int i = 0; i < 4; ++i) y.v[i] = (f32x4){bflo(cur[q].y[i].x), bfhi(cur[q].y[i].x), bflo(cur[q].y[i].y), bfhi(cur[q].y[i].y)};
                const float rstd = rsqrtf(row_ss(y) * (1.0f / DM) + opq(EPS));
                if (isctx != cctx) {
#pragma unroll
                    for (int i = 0; i < 4; ++i) { const f32x4 g1 = *(gv4p)(ng + DM + i * 256 + lane * 4), ga = *(gv4p)(m + 2048 + i * 256 + lane * 4);
                        x.v[i] = x.v[i] + ga * (y.v[i] * rstd * g1); }
                    h[q] = modulate_row(x, ng + 2 * DM, m + 3072, m + 4096, lane);
                } else {
#pragma unroll
                    for (int i = 0; i < 4; ++i) x.v[i] = x.v[i] + cA.v[i] * (y.v[i] * rstd);
                    const float rs2 = rsqrtf(row_ss(x) * (1.0f / DM) + opq(EPS));
#pragma unroll
                    for (int i = 0; i < 4; ++i) h[q].v[i] = x.v[i] * rs2 * *(LAS f32x4*)(cBl + i * 256 + lane * 4) + *(LAS f32x4*)(cCl + i * 256 + lane * 4);
                }
                if (valid[q]) { st_bf16row(XSo + (size_t)row * DM, lane, x);
                    st_fp8row(Ho + (size_t)row * DM, lane, h[q]); }
                __builtin_amdgcn_sched_barrier(0);
            }
            LAS float* scr1 = scr + 40;
#pragma unroll 1
            for (int c = 0; c < 4; ++c) {
                float v0[8], v1[8];
                LAS float* wc_ = wr + (8 * c) * RA_WRP + lane * 4;
#pragma unroll
                for (int e = 0; e < 8; ++e) { f32x2 s0 = {0.f, 0.f}, s1 = {0.f, 0.f};
#pragma unroll
                    for (int i = 0; i < 4; ++i) { const f32x4 wv = *(LAS f32x4*)(wc_ + e * RA_WRP + i * 256);
                        const f32x2 wa = {wv[0], wv[1]}, wb = {wv[2], wv[3]};
                        s0 = __builtin_elementwise_fma((f32x2){h[0].v[i][0], h[0].v[i][1]}, wa, s0); s0 = __builtin_elementwise_fma((f32x2){h[0].v[i][2], h[0].v[i][3]}, wb, s0);
                        s1 = __builtin_elementwise_fma((f32x2){h[1].v[i][0], h[1].v[i][1]}, wa, s1); s1 = __builtin_elementwise_fma((f32x2){h[1].v[i][2], h[1].v[i][3]}, wb, s1); }
                    v0[e] = s0.x + s0.y; v1[e] = s1.x + s1.y;
                    if (e & 1) __builtin_amdgcn_sched_barrier(0); }
#pragma unroll
                for (int e = 0; e < 4; ++e) { const bool up = lane & 32;
                    { const float snd = up ? v0[e] : v0[e + 4], keep = up ? v0[e + 4] : v0[e]; v0[e] = keep + xor32_f(snd); }
                    { const float snd = up ? v1[e] : v1[e + 4], keep = up ? v1[e + 4] : v1[e]; v1[e] = keep + xor32_f(snd); } }
#pragma unroll
                for (int e = 0; e < 2; ++e) { const bool up = lane & 16;
                    { const float snd = up ? v0[e] : v0[e + 2], keep = up ? v0[e + 2] : v0[e]; v0[e] = keep + __shfl_xor(snd, 16); }
                    { const float snd = up ? v1[e] : v1[e + 2], keep = up ? v1[e + 2] : v1[e]; v1[e] = keep + __shfl_xor(snd, 16); } }
                { const bool up = lane & 8;
                    { const float snd = up ? v0[0] : v0[1], keep = up ? v0[1] : v0[0]; v0[0] = keep + __shfl_xor(snd, 8); }
                    { const float snd = up ? v1[0] : v1[1], keep = up ? v1[1] : v1[0]; v1[0] = keep + __shfl_xor(snd, 8); } }
                float a0 = v0[0], a1 = v1[0];
                a0 = sum8_dpp(a0); a1 = sum8_dpp(a1);
                if ((lane & 7) == 0) { const int e = 8 * c + (lane >> 3); const float bv = rb[e]; scr[e] = a0 + bv; scr1[e] = a1 + bv; }
            }
            rowA_route(lane, scr, true, valid[0], rl, rece, recg, cnt);
            rowA_route(lane, scr1, two, valid[1], rl + 8, rece, recg, cnt);
            cur[0] = nxt[0]; cur[1] = nxt[1];
        }
        __syncthreads();
        if (tid < 32) { const int c = cnt[tid]; base[tid] = c ? atomicAdd(&gcur[tid * gstride], c) : 0; }
        __syncthreads();
        for (int i = tid; i < ROWS_PER_BLK * 4; i += NTHR) {
            const int ep = rece[i]; if (ep < 0) continue;
            const int e = ep >> 16, row = row0 + (i >> 2), posn = base[e] + (ep & 0xffff);
            ((int*)LSo)[(size_t)e * T + posn] = row;
            ((unsigned*)(LSo + (WS_RSLOT - WS_LIST)))[(size_t)row * 4 + (i & 3)] = ((unsigned)e << 24) | (unsigned)posn;
            ((float*)(LSo + (WS_RGATE - WS_LIST)))[(size_t)row * 4 + (i & 3)] = recg[i];
        }
        __syncthreads();
        if (tid < 32) cnt[tid] = 0;
        __syncthreads();
    }
}

constexpr int MOE_TST = 140416, MOE_CNT = MOE_TST + 256, MOE_TE = MOE_CNT + 128, MOE_TE_MAX = 640;
static_assert(MOE_TE + MOE_TE_MAX * 4 <= LDS_XB && 4 * T / 256 + NE <= MOE_TE_MAX, "lds");
DI void moe_tables(const Args& a, int l, LAS unsigned char* lds) {
    LAS int* tst = (LAS int*)(lds + MOE_TST); LAS int* cn = (LAS int*)(lds + MOE_CNT); LAS int* te = (LAS int*)(lds + MOE_TE);
    const int tid = otid();
    if (tid < NE) { const int* gcur = (const int*)(wso(kws(), WS_CTL) + CTL_GCUR) + (l * NE + tid) * 64; cn[tid] = __hip_atomic_load(gcur, __ATOMIC_RELAXED, __HIP_MEMORY_SCOPE_AGENT); }
    __syncthreads();
    if (tid == 0) { int s = 0; for (int e = 0; e < NE; ++e) { tst[e] = s; s += (cn[e] + 255) >> 8; } tst[NE] = s; }
    __syncthreads();
    if (tid < NE) { const int t1 = tst[tid + 1]; for (int rt = tst[tid]; rt < t1; ++rt) te[rt] = tid; }
    __syncthreads();
}

struct RowBIdx { u32x4 s; f32x4 g; };
struct RowBIn { unsigned y[4][4]; u32x2 x[4]; f32x4 g; };
DI RowBIdx rowB_idx(int row) { RowBIdx r; unsigned char* ws = kws(); r.s = *(const u32x4*)(wso(ws, WS_RSLOT) + (size_t)row * 16); r.g = *(const f32x4*)(wso(ws, WS_RGATE) + (size_t)row * 16); return r; }
DI RowBIn rowB_load(const RowBIdx& ix, int row, int lane, LAS int* tst) {
    RowBIn r; unsigned char* ws = kws();
#pragma unroll
    for (int k = 0; k < 4; ++k) {
        const unsigned s = ix.s[k]; const int e = (s >> 24) & 31, posn = s & 0xffffff; const size_t slot = (size_t)tst[e] * 256 + posn;
        const uint8_t* yp = (const uint8_t*)(wso(ws, WS_YR)) + slot * DM;
#pragma unroll
        for (int i = 0; i < 4; ++i) r.y[k][i] = *(const unsigned*)(yp + i * 256 + lane * 4);
    }
    { const bf16_t* xp = (const bf16_t*)(wso(ws, WS_XS)) + (size_t)row * DM;
#pragma unroll
      for (int i = 0; i < 4; ++i) r.x[i] = *(const u32x2*)(xp + i * 256 + lane * 4); }
    r.g = ix.g;
    return r;
}
DI void p_rowB(const Args& a, int l, LAS unsigned char* lds, bool dry = false) {
    const int tid = otid(), lane = tid & 63, w = __builtin_amdgcn_readfirstlane(tid >> 6);
    const bool last = (l == NL - 1);
    unsigned char* ws = kws();
    moe_tables(a, l, lds);
    LAS int* tst = (LAS int*)(lds + MOE_TST);
    const float* mod = (const float*)(wso(ws, WS_MOD)) + (size_t)l * 9 * 6144;
    const float* ng = kin(I_NORMG) + (size_t)l * 4 * DM;
    for (int chunk = obx(); chunk * ROWS_PER_BLK < T; chunk += gridDim.x) {
        const int row0 = chunk * ROWS_PER_BLK, b = row0 / SP;
        Row16 dA, dB, dC;
        const bool cctx = (row0 % SP) < NCTX;
        {   const float* mL = mod + (size_t)(cctx ? 8 : b) * 6144;
#pragma unroll
            for (int i = 0; i < 4; ++i) { const int o = i * 256 + lane * 4;
                dA.v[i] = *(const f32x4*)(mL + 5120 + o) * *(const f32x4*)(ng + 3 * DM + o);
                if (!last) { dB.v[i] = *(const f32x4*)(ng + 4 * DM + o) * (*(const f32x4*)(mL + 9 * 6144 + 1024 + o) + 1.0f); dC.v[i] = *(const f32x4*)(mL + 9 * 6144 + o); }
                else { dB.v[i] = (f32x4){0.f, 0.f, 0.f, 0.f}; dC.v[i] = dB.v[i]; } } }
        const int rend = row0 + ROWS_PER_BLK;
        int row = row0 + w;
#define RB_SKIP(r) do { while ((r) < rend && last && ((r) % SP) < NCTX) (r) += 8; } while (0)
        RB_SKIP(row);
        int row1 = row + 8; RB_SKIP(row1);
        int row2 = row1 + 8; RB_SKIP(row2);
        RowBIdx ix1, ix2; RowBIn cur, nxt;
        if (row < rend) { const RowBIdx ix0 = rowB_idx(row); cur = rowB_load(ix0, row, lane, tst); }
        if (row1 < rend) ix1 = rowB_idx(row1);
#pragma unroll 1
        while (row < rend) {
            if (row2 < rend) ix2 = rowB_idx(row2);
            if (row1 < rend) nxt = rowB_load(ix1, row1, lane, tst);
            const int pos = row - b * SP; const bool isctx = pos < NCTX;
            Row16 y;
#pragma unroll
            for (int i = 0; i < 4; ++i) y.v[i] = (f32x4){0.f, 0.f, 0.f, 0.f};
#pragma unroll
            for (int k = 0; k < 4; ++k) {
                const float g = cur.g[k] * (1.0f / S_Y8);
#pragma unroll
                for (int i = 0; i < 4; ++i) { const f32x2 lo = __builtin_amdgcn_cvt_pk_f32_fp8((int)cur.y[k][i], false), hi = __builtin_amdgcn_cvt_pk_f32_fp8((int)cur.y[k][i], true); y.v[i] = y.v[i] + (f32x4){lo.x, lo.y, hi.x, hi.y} * g; }
            }
            const float rstd = rsqrtf(row_ss(y) * (1.0f / DM) + opq(EPS));
            Row16 x, h;
#pragma unroll
            for (int i = 0; i < 4; ++i) x.v[i] = (f32x4){bflo(cur.x[i].x), bfhi(cur.x[i].x), bflo(cur.x[i].y), bfhi(cur.x[i].y)};
            if (isctx != cctx) {
                const float* m = mod + (size_t)(isctx ? 8 : b) * 6144;
#pragma unroll
                for (int i = 0; i < 4; ++i) { const f32x4 g3 = *(const f32x4*)(ng + 3 * DM + i * 256 + lane * 4), gf = *(const f32x4*)(m + 5120 + i * 256 + lane * 4);
                    x.v[i] = x.v[i] + gf * (y.v[i] * rstd * g3); }
                if (!last) { const float* m2 = m + 9 * 6144; h = modulate_row(x, ng + 4 * DM, m2, m2 + 1024, lane); }
            } else {
#pragma unroll
                for (int i = 0; i < 4; ++i) x.v[i] = x.v[i] + dA.v[i] * (y.v[i] * rstd);
                if (!last) { const float rs2 = rsqrtf(row_ss(x) * (1.0f / DM) + opq(EPS));
#pragma unroll
                    for (int i = 0; i < 4; ++i) h.v[i] = x.v[i] * rs2 * dB.v[i] + dC.v[i]; }
            }
            if (last) { st_f32row((dry ? (float*)(wso(ws, WS_ACT)) : kout()) + ((size_t)b * SEQ + (pos - NCTX)) * DM, lane, x); }
            else {
                st_bf16row((bf16_t*)(ws + (dry ? WS_ACT : WS_XS)) + (size_t)row * DM, lane, x);
                st_fp8row((uint8_t*)(ws + (dry ? WS_ACT + ((size_t)160 << 20) : WS_H)) + (size_t)row * DM, lane, h);
            }
            row = row1; row1 = row2; row2 = row2 + 8; RB_SKIP(row2);
            cur = nxt; ix1 = ix2;
        }
#undef RB_SKIP
    }
}

namespace gm {
constexpr int BK = 64, HALF = 128, HTB = HALF * BK * 2, NT = DM / BK;
DI int lds_byte(int r, int c) { const int st = (r >> 4) * 2 + (c >> 5), rr = r & 15, cc = c & 31, ob = rr * 64 + cc * 2; return st * 1024 + (ob ^ (((ob >> 9) & 1) << 5)); }
DI void stage_rc(int b, int& R, int& C) { const int st = b / 1024, sb = b % 1024, swz = sb ^ (((sb >> 9) & 1) << 5); R = (st >> 1) * 16 + swz / 64; C = (st & 1) * 32 + (swz % 64) / 2; }

DI int perm32(int rho) { const int n = rho >> 4, i = rho & 15; return 8 * (i >> 2) + 4 * n + (i & 3); }
typedef f32x4 Acc[2][2][4][2];

#define G_SA(b, h) (shm + ((b) * 2 + (h)) * HTB)
#define G_SB(b, h) (shm + (4 + (b) * 2 + (h)) * HTB)
#define G_STAGE(P, BASE, OFF, kt) do { _Pragma("unroll") for (int _i = 0; _i < 2; ++_i) \
    __builtin_amdgcn_global_load_lds((const unsigned*)((BASE) + (OFF)[_i] + (kt) * BK), (LAS unsigned*)((P) + wbase + _i * 8192), 16, 0, 0); } while (0)
#define G_LDA(dst, b, h) _Pragma("unroll") for (int m = 0; m < 4; ++m) _Pragma("unroll") for (int k = 0; k < 2; ++k) \
    dst[m][k] = *(LAS bf16x8*)(G_SA(b, h) + lds_byte(wr * 64 + m * 16 + fr, k * 32 + fq * 8))
#define G_LDB(dst, b, h) _Pragma("unroll") for (int n = 0; n < 2; ++n) _Pragma("unroll") for (int k = 0; k < 2; ++k) \
    dst[n][k] = *(LAS bf16x8*)(G_SB(b, h) + lds_byte(wc * 32 + n * 16 + fr, k * 32 + fq * 8))
#define G_MMA(ai, bj, At, Bx) do { __builtin_amdgcn_s_setprio(1); \
    _Pragma("unroll") for (int m = 0; m < 4; ++m) _Pragma("unroll") for (int n = 0; n < 2; ++n) _Pragma("unroll") for (int k = 0; k < 2; ++k) \
      acc[ai][bj][m][n] = __builtin_amdgcn_mfma_f32_16x16x32_bf16(Bx[n][k], At[m][k], acc[ai][bj][m][n], 0, 0, 0); \
    __builtin_amdgcn_s_setprio(0); } while (0)
#define G_WAITV(n) asm volatile("s_waitcnt vmcnt(" #n ")" ::: "memory")
#define G_WAITL(n) asm volatile("s_waitcnt lgkmcnt(" #n ")" ::: "memory")
#define G_BAR __builtin_amdgcn_s_barrier()
#define G_SCHED __builtin_amdgcn_sched_barrier(0)

struct UnitSrc { const bf16_t* A; const bf16_t* Bt; const float* bias; unsigned aoff[2][2]; };
#define G_STA(b, h, kt) do { _Pragma("unroll") for (int _i = 0; _i < 2; ++_i) \
    __builtin_amdgcn_global_load_lds((const unsigned*)(u.A + (GATHER ? u.aoff[h][_i] : (unsigned)((h) * HALF * DM) + toff[_i]) + (kt) * BK), (LAS unsigned*)(G_SA(b, h) + wbase + _i * 8192), 16, 0, 0); } while (0)
#define G_STB(b, h, kt) do { _Pragma("unroll") for (int _i = 0; _i < 2; ++_i) \
    __builtin_amdgcn_global_load_lds((const unsigned*)(u.Bt + (unsigned)((h) * HALF * DM) + tofb[_i] + (kt) * BK), (LAS unsigned*)(G_SB(b, h) + wbase + _i * 8192), 16, 0, 0); } while (0)
template <bool GATHER>
DI void gemm_head(LAS unsigned char* shm, const UnitSrc& u) {
    const int tid = otid(), wbase = __builtin_amdgcn_readfirstlane(tid >> 6) * 1024;
    unsigned toff[2], tofb[2]; { int r_, c_; stage_rc(tid * 16, r_, c_); toff[0] = r_ * DM + c_; tofb[0] = ((r_ & ~31) | perm32(r_ & 31)) * DM + c_; stage_rc(tid * 16 + 8192, r_, c_); toff[1] = r_ * DM + c_; tofb[1] = ((r_ & ~31) | perm32(r_ & 31)) * DM + c_; }
    G_STB(0, 0, 0); G_STA(0, 0, 0); G_STB(0, 1, 0); G_STA(0, 1, 0);
    G_STB(1, 0, 1); G_STA(1, 0, 1); G_STB(1, 1, 1);
}
template <bool GATHER>
DI void gemm_mainloop(LAS unsigned char* shm, const UnitSrc& u, Acc& acc) {
    const int tid = otid(), wbase = __builtin_amdgcn_readfirstlane(tid >> 6) * 1024;
    unsigned toff[2], tofb[2]; { int r_, c_; stage_rc(tid * 16, r_, c_); toff[0] = r_ * DM + c_; tofb[0] = ((r_ & ~31) | perm32(r_ & 31)) * DM + c_; stage_rc(tid * 16 + 8192, r_, c_); toff[1] = r_ * DM + c_; tofb[1] = ((r_ & ~31) | perm32(r_ & 31)) * DM + c_; }
    int wid = tid >> 6, lane = tid & 63, wr = wid >> 2, wc = wid & 3, fr = lane & 15, fq = lane >> 4;
    {   f32x4 bv[2][2];
#pragma unroll
        for (int i1 = 0; i1 < 2; ++i1)
#pragma unroll
            for (int i3 = 0; i3 < 2; ++i3) bv[i1][i3] = u.bias ? *(const f32x4*)(u.bias + i1 * 128 + wc * 32 + fq * 8 + i3 * 4) : (f32x4){0.f, 0.f, 0.f, 0.f};
#pragma unroll
        for (int i0 = 0; i0 < 2; ++i0)
#pragma unroll
            for (int i1 = 0; i1 < 2; ++i1)
#pragma unroll
                for (int i2 = 0; i2 < 4; ++i2)
#pragma unroll
                    for (int i3 = 0; i3 < 2; ++i3) acc[i0][i1][i2][i3] = bv[i1][i3];
    }
    bf16x8 At[4][2], B0[2][2], B1[2][2];
    G_WAITV(0);
    if (wr == 1) G_BAR;
    G_BAR; G_BAR;
#pragma unroll 1
    for (int t = 0; t < NT - 2; t += 2) {
        G_LDB(B0, 0, 0); G_SCHED; G_LDA(At, 0, 0); G_STA(1, 1, t + 1);
        G_WAITL(8); G_BAR; G_WAITL(0); G_MMA(0, 0, At, B0); G_BAR; G_SCHED;
        G_LDB(B1, 0, 1); G_STB(0, 0, t + 2);
        G_BAR; G_WAITL(0); G_MMA(0, 1, At, B1); G_BAR;
        G_LDA(At, 0, 1); G_STA(0, 0, t + 2);
        G_BAR; G_WAITL(0); G_MMA(1, 0, At, B0); G_BAR; G_SCHED;
        G_STB(0, 1, t + 2);
        G_WAITV(6); G_BAR; G_MMA(1, 1, At, B1); G_BAR;
        G_LDB(B0, 1, 0); G_SCHED; G_LDA(At, 1, 0); G_STA(0, 1, t + 2);
        G_WAITL(8); G_BAR; G_WAITL(0); G_MMA(0, 0, At, B0); G_BAR; G_SCHED;
        G_LDB(B1, 1, 1); G_STB(1, 0, t + 3);
        G_BAR; G_WAITL(0); G_MMA(0, 1, At, B1); G_BAR;
        G_LDA(At, 1, 1); G_STA(1, 0, t + 3);
        G_BAR; G_WAITL(0); G_MMA(1, 0, At, B0); G_BAR; G_SCHED;
        G_STB(1, 1, t + 3);
        G_WAITV(6); G_BAR; G_MMA(1, 1, At, B1); G_BAR;
    }
    { G_LDB(B0, 0, 0); G_WAITV(0); G_LDA(At, 0, 0); G_STA(1, 1, NT - 1);
      G_BAR; G_WAITL(0); G_MMA(0, 0, At, B0); G_BAR;
      G_LDB(B1, 0, 1); G_BAR; G_WAITL(0); G_MMA(0, 1, At, B1); G_BAR;
      G_LDA(At, 0, 1); G_WAITV(4); G_BAR; G_WAITL(0); G_MMA(1, 0, At, B0); G_MMA(1, 1, At, B1); G_BAR; }
    { G_LDB(B0, 1, 0); G_LDA(At, 1, 0); G_WAITV(2); G_BAR; G_WAITL(0); G_MMA(0, 0, At, B0); G_BAR;
      G_LDB(B1, 1, 1); G_WAITV(0); G_BAR; G_WAITL(0); G_MMA(0, 1, At, B1); G_BAR;
      G_LDA(At, 1, 1); G_BAR; G_WAITL(0); G_MMA(1, 0, At, B0); G_MMA(1, 1, At, B1); G_BAR; }
    if (wr == 0) G_BAR;
}
typedef int v8i32 __attribute__((ext_vector_type(8)));
struct UnitSrc8 { const uint8_t* A; const uint8_t* Bt; const float* bias; float bscale; unsigned aoff[2][2]; };
constexpr int NT8 = DM / 128;
#define G_STA8(b, h, kt) do { _Pragma("unroll") for (int _i = 0; _i < 2; ++_i) \
    __builtin_amdgcn_global_load_lds((const unsigned*)(u.A + (GATHER ? u.aoff[h][_i] : (unsigned)((h) * HALF * DM) + toff[_i]) + (kt) * 128), (LAS unsigned*)(G_SA(b, h) + wbase + _i * 8192), 16, 0, 0); } while (0)
#define G_STB8(b, h, kt) do { _Pragma("unroll") for (int _i = 0; _i < 2; ++_i) \
    __builtin_amdgcn_global_load_lds((const unsigned*)(u.Bt + (unsigned)((h) * HALF * DM) + tofb[_i] + (kt) * 128), (LAS unsigned*)(G_SB(b, h) + wbase + _i * 8192), 16, 0, 0); } while (0)
DI v8i32 cat8(u32x4 a, u32x4 b) { v8i32 r; r[0] = a.x; r[1] = a.y; r[2] = a.z; r[3] = a.w; r[4] = b.x; r[5] = b.y; r[6] = b.z; r[7] = b.w; return r; }
#define G_LDA8(dst, b, h) _Pragma("unroll") for (int m = 0; m < 4; ++m) \
    dst[m] = cat8(*(LAS u32x4*)(G_SA(b, h) + lds_byte(wr * 64 + m * 16 + fr, 8 * fq)), *(LAS u32x4*)(G_SA(b, h) + lds_byte(wr * 64 + m * 16 + fr, 32 + 8 * fq)))
#define G_LDB8(dst, b, h) _Pragma("unroll") for (int n = 0; n < 2; ++n) \
    dst[n] = cat8(*(LAS u32x4*)(G_SB(b, h) + lds_byte(wc * 32 + n * 16 + fr, 8 * fq)), *(LAS u32x4*)(G_SB(b, h) + lds_byte(wc * 32 + n * 16 + fr, 32 + 8 * fq)))
#define G_MMA8(ai, bj, At, Bx) do { __builtin_amdgcn_s_setprio(1); \
    _Pragma("unroll") for (int m = 0; m < 4; ++m) _Pragma("unroll") for (int n = 0; n < 2; ++n) \
      asm volatile("v_mfma_scale_f32_16x16x128_f8f6f4 %0, %1, %2, %0, %3, %3 op_sel_hi:[0,0,0]" : "+v"(acc[ai][bj][m][n]) : "v"(Bx[n]), "v"(At[m]), "v"(one8)); \
    __builtin_amdgcn_s_setprio(0); } while (0)
template <bool GATHER>
DI void gemm_head8(LAS unsigned char* shm, const UnitSrc8& u) {
    const int tid = otid(), wbase = __builtin_amdgcn_readfirstlane(tid >> 6) * 1024;
    unsigned toff[2], tofb[2]; { int r_, c_; stage_rc(tid * 16, r_, c_); toff[0] = r_ * DM + 2 * c_; tofb[0] = ((r_ & ~31) | perm32(r_ & 31)) * DM + 2 * c_; stage_rc(tid * 16 + 8192, r_, c_); toff[1] = r_ * DM + 2 * c_; tofb[1] = ((r_ & ~31) | perm32(r_ & 31)) * DM + 2 * c_; }
    G_STB8(0, 0, 0); G_STA8(0, 0, 0); G_STB8(0, 1, 0); G_STA8(0, 1, 0);
    G_STB8(1, 0, 1); G_STA8(1, 0, 1); G_STB8(1, 1, 1);
}
constexpr int G_BIAS8 = 139264;
template <bool GATHER>
DI void gemm_mainloop8(LAS unsigned char* shm, const UnitSrc8& u, Acc& acc) {
    const int tid = otid(), wbase = __builtin_amdgcn_readfirstlane(tid >> 6) * 1024;
    unsigned toff[2], tofb[2]; { int r_, c_; stage_rc(tid * 16, r_, c_); toff[0] = r_ * DM + 2 * c_; tofb[0] = ((r_ & ~31) | perm32(r_ & 31)) * DM + 2 * c_; stage_rc(tid * 16 + 8192, r_, c_); toff[1] = r_ * DM + 2 * c_; tofb[1] = ((r_ & ~31) | perm32(r_ & 31)) * DM + 2 * c_; }
    int wid = tid >> 6, lane = tid & 63, wr = wid >> 2, wc = wid & 3, fr = lane & 15, fq = lane >> 4;
    v8i32 At[4], B0[2], B1[2];
    int one8 = 0x7F7F7F7F; asm volatile("" : "+v"(one8));
    G_WAITV(0);
    if (wr == 1) G_BAR;
    G_BAR;
    {   f32x4 bv[2][2];
#pragma unroll
        for (int i1 = 0; i1 < 2; ++i1)
#pragma unroll
            for (int i3 = 0; i3 < 2; ++i3) bv[i1][i3] = *(LAS f32x4*)(shm + G_BIAS8 + (i1 * 128 + wc * 32 + fq * 8 + i3 * 4) * 4);
#pragma unroll
        for (int i0 = 0; i0 < 2; ++i0)
#pragma unroll
            for (int i1 = 0; i1 < 2; ++i1)
#pragma unroll
                for (int i2 = 0; i2 < 4; ++i2)
#pragma unroll
                    for (int i3 = 0; i3 < 2; ++i3) acc[i0][i1][i2][i3] = bv[i1][i3];
    }
    G_BAR;
#pragma unroll 1
    for (int t = 0; t < NT8 - 2; t += 2) {
        G_LDB8(B0, 0, 0); G_SCHED; G_LDA8(At, 0, 0); G_STA8(1, 1, t + 1);
        G_WAITL(8); G_BAR; G_WAITL(0); G_MMA8(0, 0, At, B0); G_BAR; G_SCHED;
        G_LDB8(B1, 0, 1); G_STB8(0, 0, t + 2);
        G_BAR; G_WAITL(0); G_MMA8(0, 1, At, B1); G_BAR;
        G_LDA8(At, 0, 1); G_STA8(0, 0, t + 2);
        G_BAR; G_WAITL(0); G_MMA8(1, 0, At, B0); G_BAR; G_SCHED;
        G_STB8(0, 1, t + 2);
        G_WAITV(6); G_BAR; G_MMA8(1, 1, At, B1); G_BAR;
        G_LDB8(B0, 1, 0); G_SCHED; G_LDA8(At, 1, 0); G_STA8(0, 1, t + 2);
        G_WAITL(8); G_BAR; G_WAITL(0); G_MMA8(0, 0, At, B0); G_BAR; G_SCHED;
        G_LDB8(B1, 1, 1); G_STB8(1, 0, t + 3);
        G_BAR; G_WAITL(0); G_MMA8(0, 1, At, B1); G_BAR;
        G_LDA8(At, 1, 1); G_STA8(1, 0, t + 3);
        G_BAR; G_WAITL(0); G_MMA8(1, 0, At, B0); G_BAR; G_SCHED;
        G_STB8(1, 1, t + 3);
        G_WAITV(6); G_BAR; G_MMA8(1, 1, At, B1); G_BAR;
    }
    { G_LDB8(B0, 0, 0); G_WAITV(0); G_LDA8(At, 0, 0); G_STA8(1, 1, NT8 - 1);
      G_BAR; G_WAITL(0); G_MMA8(0, 0, At, B0); G_BAR;
      G_LDB8(B1, 0, 1); G_BAR; G_WAITL(0); G_MMA8(0, 1, At, B1); G_BAR;
      G_LDA8(At, 0, 1); G_WAITV(4); G_BAR; G_WAITL(0); G_MMA8(1, 0, At, B0); G_MMA8(1, 1, At, B1); G_BAR; }
    { G_LDB8(B0, 1, 0); G_LDA8(At, 1, 0); G_WAITV(2); G_BAR; G_WAITL(0); G_MMA8(0, 0, At, B0); G_BAR;
      G_LDB8(B1, 1, 1); G_WAITV(0); G_BAR; G_WAITL(0); G_MMA8(0, 1, At, B1); G_BAR;
      G_LDA8(At, 1, 1); G_BAR; G_WAITL(0); G_MMA8(1, 0, At, B0); G_MMA8(1, 1, At, B1); G_BAR; }
    if (wr == 0) G_BAR;
}
#define G_EPI(epi, acc) do { const int tz_ = otid(); (epi)((acc), tz_ >> 8, (tz_ >> 6) & 3, tz_ & 15, (tz_ & 63) >> 4); } while (0)
DI int launder_s(int v) { asm volatile("" : "+s"(v)); return v; }

struct EpiBf16 {
    bf16_t* O; int ldo; int rbase, cbase; float scale;
    DI void operator()(const Acc& acc, int wr, int wc, int fr, int fq) const {
#pragma unroll
        for (int ai = 0; ai < 2; ++ai)
#pragma unroll
            for (int m = 0; m < 4; ++m) {
                bf16_t* rp = O + (size_t)(rbase + ai * 128 + wr * 64 + m * 16 + fr) * ldo + cbase + wc * 32 + fq * 8;
#pragma unroll
                for (int bj = 0; bj < 2; ++bj) {
                    const f32x4 v0 = acc[ai][bj][m][0] * scale, v1 = acc[ai][bj][m][1] * scale;
                    u32x4 o; o.x = pk2(v0[0], v0[1]); o.y = pk2(v0[2], v0[3]); o.z = pk2(v1[0], v1[1]); o.w = pk2(v1[2], v1[3]);
                    *(u32x4*)(rp + bj * 128) = o;
                }
            }
    }
};
struct EpiFp8 {
    uint8_t* O; int ldo; int rbase, cbase; float scale;
    DI void operator()(const Acc& acc, int wr, int wc, int fr, int fq) const {
#pragma unroll
        for (int ai = 0; ai < 2; ++ai)
#pragma unroll
            for (int m = 0; m < 4; ++m) {
                uint8_t* rp = O + (size_t)(rbase + ai * 128 + wr * 64 + m * 16 + fr) * ldo + cbase + wc * 32 + fq * 8;
#pragma unroll
                for (int bj = 0; bj < 2; ++bj) {
                    const f32x4 v0 = acc[ai][bj][m][0] * scale, v1 = acc[ai][bj][m][1] * scale;
                    const float lim = opq_s(448.0f);
#define SAT_(x) __builtin_amdgcn_fmed3f((x), -lim, lim)
                    u32x2 o; o.x = pk4_fp8(SAT_(v0[0]), SAT_(v0[1]), SAT_(v0[2]), SAT_(v0[3])); o.y = pk4_fp8(SAT_(v1[0]), SAT_(v1[1]), SAT_(v1[2]), SAT_(v1[3]));
#undef SAT_
                    *(u32x2*)(rp + bj * 128) = o;
                }
            }
    }
};
struct EpiSwiglu8 {
    uint8_t* O; int rbase, cbase;
    DI void operator()(const Acc& acc, int wr, int wc, int fr, int fq) const {
#pragma unroll
        for (int ai = 0; ai < 2; ++ai)
#pragma unroll
            for (int m = 0; m < 4; ++m) {
                uint8_t* rp = O + (size_t)(rbase + ai * 128 + wr * 64 + m * 16 + fr) * DM + ((cbase + wc * 32 + fq * 8) >> 1);
#pragma unroll
                for (int bj = 0; bj < 2; ++bj) {
                    float av[4];
#pragma unroll
                    for (int n = 0; n < 2; ++n) {
                        const f32x4 z = acc[ai][bj][m][n] * (1.0f / (S_H8 * S_W8));
                        const float c7 = opq_s(7.0f);
                        const float g0 = __builtin_fminf(z[0], c7), l0 = __builtin_amdgcn_fmed3f(z[1], -c7, c7), g1 = __builtin_fminf(z[2], c7), l1 = __builtin_amdgcn_fmed3f(z[3], -c7, c7);
                        av[2 * n] = g0 * __builtin_amdgcn_rcpf(1.0f + __builtin_amdgcn_exp2f(-1.702f * LOG2E * g0)) * __builtin_fmaf(l0, S_A8, S_A8);
                        av[2 * n + 1] = g1 * __builtin_amdgcn_rcpf(1.0f + __builtin_amdgcn_exp2f(-1.702f * LOG2E * g1)) * __builtin_fmaf(l1, S_A8, S_A8);
                    }
                    *(unsigned*)(rp + bj * 64) = pk4_fp8(av[0], av[1], av[2], av[3]);
                }
            }
    }
};
}

template <int WHICH>
DI void dense_unit(int u, bool skipctx, int& pm, int& pn) {
    constexpr int N = WHICH == 0 ? NG1 : DM, nN = N / 256;
    const int nM = skipctx ? NB * 16 : T / 256;
    const int grp = u / (8 * nN), rem = u - grp * 8 * nN, gsz = (nM - grp * 8) < 8 ? (nM - grp * 8) : 8;
    pm = grp * 8 + rem % gsz; pn = rem / gsz;
    if (skipctx) pm += pm / 16 + 1;
}
template <int WHICH>
DI void dense_src(int l, int u, bool skipctx, gm::UnitSrc& s) {
    constexpr int N = WHICH == 0 ? NG1 : DM, NROW = WHICH == 0 ? NP : DM;
    int pm, pn; dense_unit<WHICH>(u, skipctx, pm, pn);
    unsigned char* ws = kws();
    s.A = (const bf16_t*)(ws + (WHICH == 0 ? WS_H : WS_YC)) + (size_t)pm * 256 * DM;
    s.Bt = (const bf16_t*)(ws + (WHICH == 0 ? WS_WIN : WS_WOUT)) + ((size_t)l * NROW + pn * 256) * DM; s.bias = nullptr;
}
template <int WHICH>
DI void p_gemm_dense(int l, LAS unsigned char* lds) {
    constexpr int N = WHICH == 0 ? NG1 : DM, LDO = WHICH == 0 ? NP : DM, nN = N / 256;
    const bool skipctx = (WHICH == 1) && (l == NL - 1);
    const int nU = (skipctx ? NB * 16 : T / 256) * nN, G = gridDim.x;
    int u = obx();
    gm::UnitSrc cur{};
    if (u < nU) { dense_src<WHICH>(l, u, skipctx, cur); gm::gemm_head<false>(lds, cur); }
#pragma unroll 1
    while (u < nU) {
        gm::Acc acc;
        gm::gemm_mainloop<false>(lds, cur, acc);
        const int un = u + G;
        if (un < nU) { dense_src<WHICH>(l, un, skipctx, cur); gm::gemm_head<false>(lds, cur); }
        {   const int u2 = gm::launder_s(u); int pm, pn; dense_unit<WHICH>(u2, skipctx, pm, pn);
            const bool qtile = WHICH == 0 && (pn == C_RQ / 256 || pn == C_DQ / 256 || pn == C_GQ / 256);
            const size_t obase = WHICH == 1 ? WS_YO : !qtile ? WS_P : pn == C_RQ / 256 ? WS_QRET : pn == C_DQ / 256 ? WS_QD : WS_QG;
            gm::EpiBf16 epi{(bf16_t*)(kws() + obase), qtile ? 256 : LDO, pm * 256, qtile ? 0 : pn * 256, 1.0f};
            G_EPI(epi, acc);
        }
        u = un;
    }
    __syncthreads();
}

DI void p_gemm_in8(int l, LAS unsigned char* lds) {
    constexpr int nN = NG1 / 256;
    const int nU = (T / 256) * nN, G = gridDim.x;
    int u = obx();
    { const int t0 = otid(); const float z = opq(0.f); if (t0 < 64) *((LAS f32x4*)(lds + gm::G_BIAS8) + t0) = (f32x4){z, z, z, z}; }
    __syncthreads();
    gm::UnitSrc8 cur{};
    if (u < nU) { int pm, pn; dense_unit<0>(u, false, pm, pn); unsigned char* ws = kws();
        cur.A = (const uint8_t*)(wso(ws, WS_H)) + (size_t)pm * 256 * DM; cur.Bt = (const uint8_t*)(wso(ws, WS_WIN)) + ((size_t)l * NP + pn * 256) * DM; gm::gemm_head8<false>(lds, cur); }
#pragma unroll 1
    while (u < nU) {
        gm::Acc acc;
        gm::gemm_mainloop8<false>(lds, cur, acc);
        const int un = u + G;
        if (un < nU) { int pm, pn; dense_unit<0>(un, false, pm, pn); unsigned char* ws = kws();
            cur.A = (const uint8_t*)(wso(ws, WS_H)) + (size_t)pm * 256 * DM; cur.Bt = (const uint8_t*)(wso(ws, WS_WIN)) + ((size_t)l * NP + pn * 256) * DM; gm::gemm_head8<false>(lds, cur); }
        {   const int u2 = gm::launder_s(u); int pm, pn; dense_unit<0>(u2, false, pm, pn);
            const bool qtile = (pn == C_RQ / 256 || pn == C_DQ / 256 || pn == C_GQ / 256);
            const size_t obase = !qtile ? WS_P : pn == C_RQ / 256 ? WS_QRET : pn == C_DQ / 256 ? WS_QD : WS_QG;
            gm::EpiBf16 epi{(bf16_t*)(kws() + obase), qtile ? 256 : NP, pm * 256, qtile ? 0 : pn * 256, opq_s(1.0f / (S_H8 * S_W8))};
            G_EPI(epi, acc);
        }
        u = un;
    }
    __syncthreads();
}

DI void p_gemm_out8(int l, LAS unsigned char* lds) {
    const bool skipctx = (l == NL - 1);
    const int nU = (skipctx ? NB * 16 : T / 256) * 4, G = gridDim.x;
    int u = obx();
    { const int t0 = otid(); const float z = opq(0.f); if (t0 < 64) *((LAS f32x4*)(lds + gm::G_BIAS8) + t0) = (f32x4){z, z, z, z}; }
    __syncthreads();
    gm::UnitSrc8 cur{};
    if (u < nU) { int pm, pn; dense_unit<1>(u, skipctx, pm, pn); unsigned char* ws = kws();
        cur.A = (const uint8_t*)(wso(ws, WS_YC)) + (size_t)pm * 256 * DM; cur.Bt = (const uint8_t*)(wso(ws, WS_WOUT)) + ((size_t)l * DM + pn * 256) * DM; gm::gemm_head8<false>(lds, cur); }
#pragma unroll 1
    while (u < nU) {
        gm::Acc acc;
        gm::gemm_mainloop8<false>(lds, cur, acc);
        const int un = u + G;
        if (un < nU) { int pm, pn; dense_unit<1>(un, skipctx, pm, pn); unsigned char* ws = kws();
            cur.A = (const uint8_t*)(wso(ws, WS_YC)) + (size_t)pm * 256 * DM; cur.Bt = (const uint8_t*)(wso(ws, WS_WOUT)) + ((size_t)l * DM + pn * 256) * DM; gm::gemm_head8<false>(lds, cur); }
        {   const int u2 = gm::launder_s(u); int pm, pn; dense_unit<1>(u2, skipctx, pm, pn);
            gm::EpiBf16 epi{(bf16_t*)(wso(kws(), WS_YO)), DM, pm * 256, pn * 256, opq_s(1.0f / (S_C8 * S_W8))};
            G_EPI(epi, acc);
        }
        u = un;
    }
    __syncthreads();
}

template <int WHICH> DI bool moe_unit(int u, int ntiles, int& rt, int& pn) {
    const int x = u & 7, v = u >> 3;
    if (WHICH == 1) { pn = 4 * (x & 1) + (v & 3); rt = 4 * (v >> 2) + (x >> 1); }
    else { pn = v & 3; rt = 8 * (v >> 2) + x; }
    return rt < ntiles;
}
template <int WHICH>
DI void moe_ptrs(int l, int rt, int pn, LAS unsigned char* lds, gm::UnitSrc8& s) {
    LAS int* te = (LAS int*)(lds + MOE_TE);
    const int e = te[rt];
    unsigned char* ws = kws();
    if (WHICH == 1) { s.A = (const uint8_t*)(wso(ws, WS_H8)); s.Bt = (const uint8_t*)(wso(ws, WS_W1)) + (((size_t)l * NE + e) * DFF2 + pn * 256) * DM; s.bias = kin(I_EB1) + ((size_t)l * NE + e) * DFF2 + pn * 256; s.bscale = S_H8 * S_W8; }
    else { s.A = (const uint8_t*)(wso(ws, WS_ACT)) + (size_t)rt * 256 * DM; s.Bt = (const uint8_t*)(wso(ws, WS_W2)) + (((size_t)l * NE + e) * DM + pn * 256) * DM; s.bias = kin(I_EB2) + ((size_t)l * NE + e) * DM + pn * 256; s.bscale = S_A8 * S_W8; }
}
DI u32x4 moe_gather(int rt, LAS unsigned char* lds) {
    LAS int* tst = (LAS int*)(lds + MOE_TST); LAS int* cn = (LAS int*)(lds + MOE_CNT); LAS int* te = (LAS int*)(lds + MOE_TE);
    const int e = te[rt], tz = otid();
    int r_[2], c_[2]; gm::stage_rc(tz * 16, r_[0], c_[0]); gm::stage_rc(tz * 16 + 8192, r_[1], c_[1]);
    const int* list = (const int*)(wso(kws(), WS_LIST)) + (size_t)e * T; const int c = cn[e], p0 = (rt - tst[e]) * 256;
    u32x4 o;
    { const int p = p0 + r_[0]; o.x = (unsigned)list[p < c ? p : 0]; }
    { const int p = p0 + r_[1]; o.y = (unsigned)list[p < c ? p : 0]; }
    { const int p = p0 + 128 + r_[0]; o.z = (unsigned)list[p < c ? p : 0]; }
    { const int p = p0 + 128 + r_[1]; o.w = (unsigned)list[p < c ? p : 0]; }
    return o;
}
DI u32x4 moe_gather_fix(u32x4 raw) {
    const int tz = otid(); int r_[2], c_[2]; gm::stage_rc(tz * 16, r_[0], c_[0]); gm::stage_rc(tz * 16 + 8192, r_[1], c_[1]);
    u32x4 o; o.x = raw.x * DM + 2 * c_[0]; o.y = raw.y * DM + 2 * c_[1]; o.z = raw.z * DM + 2 * c_[0]; o.w = raw.w * DM + 2 * c_[1];
    return o;
}
template <int WHICH>
DI void p_gemm_moe(const Args& a, int l, LAS unsigned char* lds) {
    moe_tables(a, l, lds);
    LAS int* tst = (LAS int*)(lds + MOE_TST);
    const int tid = otid();
    LAS u32x4* aslot = (LAS u32x4*)(lds + 131072) + tid;
    LAS f32x4* bslot = (LAS f32x4*)(lds + gm::G_BIAS8) + (tid & 63);
    const int ntiles = tst[NE], nU = WHICH == 1 ? ((ntiles + 3) >> 2) * 32 : ((ntiles + 7) >> 3) * 32, G = gridDim.x;
    int u = obx(), rt = 0, pn = 0;
    while (u < nU && !moe_unit<WHICH>(u, ntiles, rt, pn)) u += G;
    int un = u + G, rtn = 0, pnn = 0;
    while (un < nU && !moe_unit<WHICH>(un, ntiles, rtn, pnn)) un += G;
    gm::UnitSrc8 cur{};
    if (u < nU) {
        moe_ptrs<WHICH>(l, rt, pn, lds, cur);
        if (WHICH == 1) { const u32x4 g = moe_gather_fix(moe_gather(rt, lds)); cur.aoff[0][0] = g.x; cur.aoff[0][1] = g.y; cur.aoff[1][0] = g.z; cur.aoff[1][1] = g.w; }
        gm::gemm_head8<(WHICH == 1)>(lds, cur);
        if (tid < 64) *bslot = *(const f32x4*)(cur.bias + tid * 4) * cur.bscale;
        if (WHICH == 1 && un < nU) *aslot = moe_gather_fix(moe_gather(rtn, lds));
    }
#pragma unroll 1
    while (u < nU) {
        gm::Acc acc;
        gm::gemm_mainloop8<(WHICH == 1)>(lds, cur, acc);
        int unn = un + G, rtnn = 0, pnnn = 0;
        while (unn < nU && !moe_unit<WHICH>(unn, ntiles, rtnn, pnnn)) unn += G;
        u32x4 gnn = {0u, 0u, 0u, 0u}; f32x4 bn = {0.f, 0.f, 0.f, 0.f};
        if (un < nU) {
            moe_ptrs<WHICH>(l, rtn, pnn, lds, cur);
            if (WHICH == 1) { const u32x4 g = *((LAS u32x4*)(lds + 131072) + otid()); cur.aoff[0][0] = g.x; cur.aoff[0][1] = g.y; cur.aoff[1][0] = g.z; cur.aoff[1][1] = g.w; }
            gm::gemm_head8<(WHICH == 1)>(lds, cur);
            { const int t2 = otid(); if (t2 < 64) bn = *(const f32x4*)(cur.bias + t2 * 4); }
            if (WHICH == 1 && unn < nU) gnn = moe_gather(rtnn, lds);
        }
        __builtin_amdgcn_sched_barrier(0);
        {   const int u2 = gm::launder_s(u); int rt2, pn2; moe_unit<WHICH>(u2, ntiles, rt2, pn2);
            if (WHICH == 1) { gm::EpiSwiglu8 epi{(uint8_t*)(wso(kws(), WS_ACT)), rt2 * 256, pn2 * 256}; G_EPI(epi, acc); }
            else { gm::EpiFp8 epi{(uint8_t*)(wso(kws(), WS_YR)), DM, rt2 * 256, pn2 * 256, S_Y8 / (S_A8 * S_W8)}; G_EPI(epi, acc); }
        }
        __builtin_amdgcn_sched_barrier(0);
        { const int t2 = otid(); if (un < nU && t2 < 64) *((LAS f32x4*)(lds + gm::G_BIAS8) + t2) = bn * cur.bscale;
          if (WHICH == 1 && unn < nU) *((LAS u32x4*)(lds + 131072) + t2) = moe_gather_fix(gnn); }
        u = un; un = unn; rtn = rtnn; pnn = pnnn;
    }
    __syncthreads();
}


struct PrepRaw { u32x4 q8[1]; u32x2 d4[4]; };
DI void un4(const u32x2& u, float (&o)[4]) { o[0] = bflo(u.x); o[1] = bfhi(u.x); o[2] = bflo(u.y); o[3] = bfhi(u.y); }
DI void un8(const u32x4& u, float (&o)[8]) { o[0] = bflo(u.x); o[1] = bfhi(u.x); o[2] = bflo(u.y); o[3] = bfhi(u.y); o[4] = bflo(u.z); o[5] = bfhi(u.z); o[6] = bflo(u.w); o[7] = bfhi(u.w); }
DI int prep_src64(int hl) { return hl < 4 ? C_RK + hl * 64 : hl < 6 ? C_GK + (hl - 4) * 64 : 0; }
DI int prep_src32(int ml) { return ml < 8 ? C_DK + ml * 32 : ml < 12 ? C_MQE + (ml - 8) * 96 + 64 : ml < 13 ? C_MKR : 0; }
DI PrepRaw prep_load(int row, int lane) {
    PrepRaw r; const bf16_t* P = (const bf16_t*)(wso(kws(), WS_P)) + (size_t)row * NP;
    r.q8[0] = *(const u32x4*)(P + C_MCQ + (lane < 24 ? lane : 0) * 8);
    { const int src = prep_src64(lane >> 3), aa = lane & 7; r.d4[0] = *(const u32x2*)(P + src + 4 * aa); r.d4[1] = *(const u32x2*)(P + src + 32 + 4 * aa); }
    { const int src = prep_src32(lane >> 2), aa = lane & 3; r.d4[2] = *(const u32x2*)(P + src + 4 * aa); r.d4[3] = *(const u32x2*)(P + src + 16 + 4 * aa); }
    return r;
}
constexpr int PREP_TAB = 102400, PREP_R32 = PREP_TAB + 8192, PREP_QN = PREP_R32 + 4096;
DI void prep_compute(int row, int lane, const PrepRaw& raw, LAS unsigned char* lds) {
    unsigned char* ws = kws();
    const int b = row / SP, pos = row - b * SP; const bool lat = pos >= NCTX;
    const int s = lat ? pos - NCTX : 0, gr = s >> 6, gc = s & 63;
    LAS f32x2* r64 = (LAS f32x2*)(lds + PREP_TAB); LAS f32x2* r32 = (LAS f32x2*)(lds + PREP_R32); LAS float* qnl = (LAS float*)(lds + PREP_QN);
    float rq;
    { float v[8], ss = 0.f; un8(raw.q8[0], v);
      if (lane < 24) {
#pragma unroll
          for (int j = 0; j < 8; ++j) ss += v[j] * v[j]; }
      rq = rsqrtf(wave_sum(ss) * (1.0f / 192.0f) + opq(EPS)); }
    {
        const int hl = lane >> 3, aa = lane & 7;
        const bool act = hl < 6;
        bf16_t* dst = nullptr; float scale = 1.0f; int nrm = -1;
        if (hl < 4) { dst = (bf16_t*)(wso(ws, WS_KRET)) + (size_t)row * 256 + hl * 64; scale = 0.125f; }
        else if (hl < 6) { dst = (bf16_t*)(wso(ws, WS_KG)) + (size_t)row * 128 + (hl - 4) * 64; nrm = 1; }
        float x1[4], x2[4]; un4(raw.d4[0], x1); un4(raw.d4[1], x2);
        float ss = 0.f;
#pragma unroll
        for (int j = 0; j < 4; ++j) ss += x1[j] * x1[j] + x2[j] * x2[j];
        ss += __shfl_xor(ss, 1); ss += __shfl_xor(ss, 2); ss += __shfl_xor(ss, 4);
        if (nrm >= 0) {
            const float rs = rsqrtf(ss * (1.0f / 64.0f) + opq(EPS)); LAS float* qn = qnl + nrm * 64;
#pragma unroll
            for (int j = 0; j < 4; ++j) { x1[j] *= rs * qn[4 * aa + j]; x2[j] *= rs * qn[32 + 4 * aa + j]; }
        }
        if (lat) {
            LAS f32x2* tb = r64 + (aa < 4 ? gr : gc) * 16 + ((4 * aa) & 15);
#pragma unroll
            for (int j = 0; j < 4; ++j) { const f32x2 cs = tb[j]; const float y1 = x1[j] * cs.x - x2[j] * cs.y, y2 = x1[j] * cs.y + x2[j] * cs.x; x1[j] = y1; x2[j] = y2; }
        }
#pragma unroll
        for (int j = 0; j < 4; ++j) { x1[j] *= scale; x2[j] *= scale; }
        if (act) { st4(dst + 4 * aa, x1); st4(dst + 32 + 4 * aa, x2); }
    }
    {
        const int ml = lane >> 2, aa = lane & 3;
        const bool act = ml < 13;
        float scale = 1.0f;
        if (ml >= 8 && ml < 12) scale = rq * 0.10206207261596575f * LOG2E;
        float x1[4], x2[4]; un4(raw.d4[2], x1); un4(raw.d4[3], x2);
        if (lat) {
            LAS f32x2* tb = r32 + (aa < 2 ? gr : gc) * 8 + ((4 * aa) & 7);
#pragma unroll
            for (int j = 0; j < 4; ++j) { const f32x2 cs = tb[j]; const float y1 = x1[j] * cs.x - x2[j] * cs.y, y2 = x1[j] * cs.y + x2[j] * cs.x; x1[j] = y1; x2[j] = y2; }
        }
#pragma unroll
        for (int j = 0; j < 4; ++j) { x1[j] *= scale; x2[j] *= scale; }
        if (act) {
            if (ml < 8) { bf16_t* d = (bf16_t*)(wso(ws, WS_KD)) + (size_t)row * 256 + ml * 32; st4(d + 4 * aa, x1); st4(d + 16 + 4 * aa, x2); }
            else if (ml < 12) { bf16_t* d = (bf16_t*)(wso(ws, WS_QM)) + (size_t)row * 384 + (ml - 8) * 96 + 64; st4(d + 4 * aa, x1); st4(d + 16 + 4 * aa, x2); }
            else { bf16_t* d = (bf16_t*)(wso(ws, WS_KM)) + (size_t)row * 384 + 64;
#pragma unroll
                for (int hh = 0; hh < 4; ++hh) { st4(d + hh * 96 + 4 * aa, x1); st4(d + hh * 96 + 16 + 4 * aa, x2); } }
        }
    }
}

DI void st8l(LAS unsigned char* p, const float (&v)[8]) { u32x4 u; u.x = pk2(v[0], v[1]); u.y = pk2(v[2], v[3]); u.z = pk2(v[4], v[5]); u.w = pk2(v[6], v[7]); *(LAS u32x4*)p = u; }
constexpr int R1_V = 0, R1_KF = 32768, R1_KB = 65536;
DI void r1_item(const Args& a, int l, int item, LAS unsigned char* lds) {
    const int tid = otid(), lane = tid & 63, w = __builtin_amdgcn_readfirstlane(tid >> 6);
    unsigned char* ws = kws();
    const int hd = item & 3, cj = (item >> 2) % NCHUNK, b = (item >> 2) / NCHUNK;
    const int row0 = b * SP + cj * 256;
    const float lgf = -__expf(kin(I_RLD)[l * 8 + hd]) * LOG2E, lgb = -__expf(kin(I_RLD)[l * 8 + 4 + hd]) * LOG2E;
    {
        const int m = tid >> 1, half = tid & 1;
        const bf16_t* P = (const bf16_t*)(wso(ws, WS_P)) + (size_t)(row0 + m) * NP;
        float x1[16], x2[16];
        { float t[8];
          ld8(P + C_RK + hd * 64 + 16 * half, t);
#pragma unroll
          for (int j = 0; j < 8; ++j) x1[j] = t[j];
          ld8(P + C_RK + hd * 64 + 16 * half + 8, t);
#pragma unroll
          for (int j = 0; j < 8; ++j) x1[8 + j] = t[j];
          ld8(P + C_RK + hd * 64 + 32 + 16 * half, t);
#pragma unroll
          for (int j = 0; j < 8; ++j) x2[j] = t[j];
          ld8(P + C_RK + hd * 64 + 32 + 16 * half + 8, t);
#pragma unroll
          for (int j = 0; j < 8; ++j) x2[8 + j] = t[j]; }
        if (cj > 0) {
            const int s = (cj - 1) * 256 + m, gr = s >> 6, gc = s & 63;
            const f32x2* tb = (const f32x2*)(wso(ws, WS_TAB) + TAB_R64) + (half ? gc : gr) * 16;
#pragma unroll
            for (int j = 0; j < 16; ++j) { const f32x2 cs = tb[j]; const float y1 = x1[j] * cs.x - x2[j] * cs.y, y2 = x1[j] * cs.y + x2[j] * cs.x; x1[j] = y1; x2[j] = y2; }
        }
        const float zf = 0.125f * __builtin_amdgcn_exp2f(lgf * (float)(255 - m)), zb = 0.125f * __builtin_amdgcn_exp2f(lgb * (float)m);
        float o[8];
#pragma unroll
        for (int q = 0; q < 2; ++q) {
#pragma unroll
            for (int j = 0; j < 8; ++j) o[j] = x1[8 * q + j] * zf;
            st8l(lds + R1_KF + m * 128 + (16 * half + 8 * q) * 2, o);
#pragma unroll
            for (int j = 0; j < 8; ++j) o[j] = x2[8 * q + j] * zf;
            st8l(lds + R1_KF + m * 128 + (32 + 16 * half + 8 * q) * 2, o);
#pragma unroll
            for (int j = 0; j < 8; ++j) o[j] = x1[8 * q + j] * zb;
            st8l(lds + R1_KB + m * 128 + (16 * half + 8 * q) * 2, o);
#pragma unroll
            for (int j = 0; j < 8; ++j) o[j] = x2[8 * q + j] * zb;
            st8l(lds + R1_KB + m * 128 + (32 + 16 * half + 8 * q) * 2, o);
        }
#pragma unroll
        for (int q = 0; q < 4; ++q) *(LAS u32x4*)(lds + R1_V + m * 128 + half * 64 + q * 16) = *(const u32x4*)(P + C_RV + hd * 64 + half * 32 + q * 8);
    }
    __syncthreads();
    {
        const int dir = w >> 2, eb = (w >> 1) & 1, db = w & 1;
        const int i16 = lane & 15, q = i16 >> 2, p = i16 & 3, g = (lane >> 4) & 1, h = lane >> 5, r = lane & 31;
        LAS unsigned char* vb = lds + R1_V + (8 * h + q) * 128 + (32 * eb + 16 * g + 4 * p) * 2;
        LAS unsigned char* kb = lds + (dir ? R1_KB : R1_KF) + (8 * h + q) * 128 + (32 * db + 16 * g + 4 * p) * 2;
        f32x16 acc;
#pragma unroll
        for (int i = 0; i < 16; ++i) acc[i] = 0.f;
#pragma unroll
        for (int s = 0; s < 16; ++s) {
            const s16x4 alo = trread(vb + s * 2048), ahi = trread(vb + s * 2048 + 512);
            const s16x4 blo = trread(kb + s * 2048), bhi = trread(kb + s * 2048 + 512);
            const bf16x8 av = __builtin_shufflevector(alo, ahi, 0, 1, 2, 3, 4, 5, 6, 7), bv = __builtin_shufflevector(blo, bhi, 0, 1, 2, 3, 4, 5, 6, 7);
            acc = MFMA32(av, bv, acc);
        }
        float* U = (float*)(wso(ws, WS_UST)) + ((((size_t)b * 4 + hd) * NCHUNK + cj) * 2 + dir) * 4096;
#pragma unroll
        for (int i = 0; i < 16; ++i) U[(32 * eb + crow(i, h)) * 64 + 32 * db + r] = acc[i];
    }
    __syncthreads();
}

constexpr int MU_PITCH = 656, MU_ROWS = 144;
constexpr int MU_RS = MU_ROWS * MU_PITCH;
static_assert(MU_RS + MU_ROWS * 8 <= 102400, "lds");
template <int KS  >
DI void mla_up_tile(const bf16x8 (&bf)[KS], LAS unsigned char* ain  , LAS unsigned char* lds, bf16_t* out  , int ldo, int sel, int row0, int fr, int fq) {
#pragma unroll 3
    for (int rt = 0; rt < MU_ROWS / 16; ++rt) {
        LAS unsigned char* ap = ain + (16 * rt + fr) * MU_PITCH + 16 * fq;
        f32x4 acc = {0.f, 0.f, 0.f, 0.f};
#pragma unroll
        for (int ks = 0; ks < KS; ++ks) acc = __builtin_amdgcn_mfma_f32_16x16x32_bf16(bf[ks], *(LAS bf16x8*)(ap + 64 * ks), acc, 0, 0, 0);
        const float sc = sel < 0 ? 1.0f : ((LAS float*)(lds + MU_RS))[(16 * rt + fr) * 2 + sel];
        if (16 * rt + fr < ROWS_PER_BLK) { const float v[4] = {acc[0] * sc, acc[1] * sc, acc[2] * sc, acc[3] * sc}; st4(out + (size_t)(row0 + 16 * rt + fr) * ldo + 4 * fq, v); }
    }
}
DI void prep_mla_up(int l, int row0, LAS unsigned char* lds) {
    const int tid = otid(), lane = tid & 63, w = __builtin_amdgcn_readfirstlane(tid >> 6), fr = lane & 15, fq = lane >> 4;
    unsigned char* ws = kws();
    bf16_t* P = (bf16_t*)(wso(ws, WS_P));
    for (int i = tid; i < MU_ROWS * 40; i += NTHR) {
        const int r = i / 40, c = i - r * 40, row = row0 + r < T ? row0 + r : T - 1;
        *(LAS u32x4*)(lds + r * MU_PITCH + c * 16) = *(const u32x4*)(P + (size_t)row * NP + C_MCQ + c * 8);
    }
    __syncthreads();
    if (tid < 2 * MU_ROWS) {
        const int r = tid >> 1, kv = tid & 1; LAS unsigned char* p = lds + r * MU_PITCH + kv * 384; float ss = 0.f;
        for (int c = 0; c < (kv ? 16 : 24); ++c) { float v[8]; const u32x4 t_ = *(LAS u32x4*)(p + c * 16); un8(t_, v);
#pragma unroll
            for (int j = 0; j < 8; ++j) ss += v[j] * v[j]; }
        ((LAS float*)(lds + MU_RS))[tid] = kv ? rsqrtf(ss * (1.0f / 128.0f) + opq(EPS)) : rsqrtf(ss * (1.0f / 192.0f) + opq(EPS)) * (0.10206207261596575f * LOG2E);
    }
    __syncthreads();
    const bf16_t* Wq = (const bf16_t*)(wso(ws, WS_WUQ)) + (size_t)l * 384 * 192; const bf16_t* Wkv = (const bf16_t*)(wso(ws, WS_WUKV)) + (size_t)l * 512 * 128;
    bf16x8 bq[3][6], bkv[4][4];
#pragma unroll
    for (int j = 0; j < 3; ++j)
#pragma unroll
        for (int ks = 0; ks < 6; ++ks) bq[j][ks] = *(const bf16x8*)(Wq + (size_t)((3 * w + j) * 16 + fr) * 192 + 32 * ks + 8 * fq);
#pragma unroll
    for (int j = 0; j < 4; ++j)
#pragma unroll
        for (int ks = 0; ks < 4; ++ks) bkv[j][ks] = *(const bf16x8*)(Wkv + (size_t)((4 * w + j) * 16 + fr) * 128 + 32 * ks + 8 * fq);
#pragma unroll
    for (int j = 0; j < 3; ++j) { const int n0 = (3 * w + j) * 16, hh = n0 / 96, wi = n0 - hh * 96; const bool rope = wi >= 64;
        bf16_t* qm = (bf16_t*)(wso(ws, WS_QM)) + n0; bf16_t* pq = P + C_MQE + n0;
        mla_up_tile<6>(bq[j], lds, lds, rope ? pq : qm, rope ? NP : 384, rope ? -1 : 0, row0, fr, fq); }
#pragma unroll
    for (int j = 0; j < 4; ++j) { const int n0 = (4 * w + j) * 16, hh = n0 >> 7, wi = n0 & 127; const bool isv = wi >= 64;
        bf16_t* km = (bf16_t*)(wso(ws, WS_KM)) + hh * 96 + wi; bf16_t* vm = (bf16_t*)(wso(ws, WS_VM)) + hh * 64 + (wi - 64);
        mla_up_tile<4>(bkv[j], lds + 384, lds, isv ? vm : km, isv ? 256 : 384, 1, row0, fr, fq); }
}

DI void p_prep(const Args& a, int l, LAS unsigned char* lds) {
    const int tid = otid(), lane = tid & 63, w = __builtin_amdgcn_readfirstlane(tid >> 6);
    {
        const float* tab = (const float*)(wso(kws(), WS_TAB));
        for (int i = tid; i < 3072; i += NTHR) ((LAS float*)(lds + PREP_TAB))[i] = tab[i];
        if (tid < 128) ((LAS float*)(lds + PREP_QN))[tid] = kin(I_GQKN)[l * 128 + tid];
    }
    for (int chunk = obx(); chunk * ROWS_PER_BLK < T; chunk += gridDim.x) {
        const int row0 = chunk * ROWS_PER_BLK;
        prep_mla_up(l, row0, lds);
        asm volatile("s_waitcnt vmcnt(0)" ::: "memory");
        __syncthreads();
        int row = row0 + w;
        PrepRaw cur, nxt;
        cur = prep_load(row, lane);
#pragma unroll 1
        while (row < row0 + ROWS_PER_BLK) {
            const int rn = row + 8;
            if (rn < row0 + ROWS_PER_BLK) nxt = prep_load(rn, lane);
            prep_compute(row, lane, cur, lds);
            cur = nxt; row = rn;
        }
    }
    __syncthreads();
    for (int it = obx(); it < NB * NCHUNK * 4; it += gridDim.x) r1_item(a, l, it, lds);
}

enum { M_DIFF = 0, M_MLA = 1, M_GQA = 2, M_RET = 3 };
constexpr int AT_RING = 4, AT_KSLOT = 12288, AT_VSLOT = 8192, AT_K0 = 0, AT_K1 = AT_KSLOT, AT_V0 = AT_RING * AT_KSLOT, AT_V1 = AT_V0 + AT_VSLOT, AT_SF = AT_V0 + AT_RING * AT_VSLOT, AT_SB = AT_SF + 9216, AT_END = AT_SB + 9216;
static_assert(AT_END <= 131072, "lds");
struct AttnP {
    const bf16_t* Q; int ldq; const bf16_t* K; int ldk; const bf16_t* V; int ldv; uint8_t* O;
    int qrow0, krow0, ntiles;
    float lam, oml; const float* subln;
    const float* qnw;
    const bf16_t* gate; const float* gnw; const float* gnb; float l2gf, l2gb; const float* ust; int cj;
};
DI void st4c8(uint8_t* p, const float (&v)[4]) { const float lim = opq_s(448.0f);
    *(unsigned*)p = pk4_fp8(__builtin_amdgcn_fmed3f(v[0] * S_C8, -lim, lim), __builtin_amdgcn_fmed3f(v[1] * S_C8, -lim, lim), __builtin_amdgcn_fmed3f(v[2] * S_C8, -lim, lim), __builtin_amdgcn_fmed3f(v[3] * S_C8, -lim, lim)); }
template <int ST> DI bf16x8 pack8(const f32x16& s) {
    u32x4 u; u.x = pk2(s[8 * ST], s[8 * ST + 1]); u.y = pk2(s[8 * ST + 2], s[8 * ST + 3]); u.z = pk2(s[8 * ST + 4], s[8 * ST + 5]); u.w = pk2(s[8 * ST + 6], s[8 * ST + 7]);
    return __builtin_bit_cast(bf16x8, u);
}
constexpr float SM_THR = 8.0f;
struct SmState { float m, l; f32x16 negm; };
DI void sm_init(SmState& st) { st.m = 0.f; st.l = 0.f;
#pragma unroll
    for (int i = 0; i < 16; ++i) st.negm[i] = 0.f; }
#define MX3(a, b, c) __builtin_fmaxf(__builtin_fmaxf((a), (b)), (c))
DI float sm_rowmax(const f32x16& s0, const f32x16& s1) {
    float a = MX3(s0[0], s0[1], s1[0]), b = MX3(s0[2], s0[3], s1[1]); a = MX3(a, s1[2], s1[3]);
#pragma unroll
    for (int r = 4; r < 16; r += 4) { a = MX3(a, s0[r], s0[r + 1]); b = MX3(b, s0[r + 2], s0[r + 3]); a = MX3(a, s1[r], s1[r + 1]); b = MX3(b, s1[r + 2], s1[r + 3]); }
    const float mx = __builtin_fmaxf(a, b);
    auto rr = __builtin_amdgcn_permlane32_swap(__float_as_uint(mx), __float_as_uint(mx), false, false);
    return __builtin_fmaxf(__uint_as_float(rr[0]), __uint_as_float(rr[1]));
}
DI void sm_move(float mx, bool first, SmState& st, f32x16& o0, f32x16& o1, f32x16& s0, f32x16& s1) {
    const float d = first ? mx : __builtin_fmaxf(mx, 0.f), alpha = first ? 0.f : __builtin_amdgcn_exp2f(-d);
    st.m += d; st.l *= alpha;
    const float nm = -st.m;
#pragma unroll
    for (int i = 0; i < 16; ++i) { o0[i] *= alpha; o1[i] *= alpha; s0[i] -= d; s1[i] -= d; st.negm[i] = nm; }
}
DI void sm_exp_pack(f32x16& s0, f32x16& s1, SmState& st, bf16x8 (&pf)[4]) {
    float a0 = 0.f, a1 = 0.f;
#pragma unroll
    for (int i = 0; i < 16; i += 2) {
        s0[i] = __builtin_amdgcn_exp2f(s0[i]); s0[i + 1] = __builtin_amdgcn_exp2f(s0[i + 1]); s1[i] = __builtin_amdgcn_exp2f(s1[i]); s1[i + 1] = __builtin_amdgcn_exp2f(s1[i + 1]);
        a0 += s0[i]; a1 += s0[i + 1]; asm("" : "+v"(a0), "+v"(a1)); a0 += s1[i]; a1 += s1[i + 1]; asm("" : "+v"(a0), "+v"(a1));
    }
    st.l += a0 + a1;
    pf[0] = pack8<0>(s0); pf[1] = pack8<1>(s0); pf[2] = pack8<0>(s1); pf[3] = pack8<1>(s1);
}
DI void pv_packed(LAS unsigned char* vlane, const bf16x8 (&pf)[4], f32x16& o0, f32x16& o1) {
#pragma unroll
    for (int ks = 0; ks < 4; ++ks) {
        { const s16x4 lo = trread(vlane + ks * 1024), hi = trread(vlane + ks * 1024 + 512);
          o0 = MFMA32(__builtin_shufflevector(lo, hi, 0, 1, 2, 3, 4, 5, 6, 7), pf[ks], o0); }
        { const s16x4 lo = trread(vlane + 4096 + ks * 1024), hi = trread(vlane + 4096 + ks * 1024 + 512);
          o1 = MFMA32(__builtin_shufflevector(lo, hi, 0, 1, 2, 3, 4, 5, 6, 7), pf[ks], o1); }
    }
}
DI void pv_tile(LAS unsigned char* vlane, const f32x16& p0, const f32x16& p1, f32x16& o0, f32x16& o1) {
    bf16x8 pf[4]; pf[0] = pack8<0>(p0); pf[1] = pack8<1>(p0); pf[2] = pack8<0>(p1); pf[3] = pack8<1>(p1);
    pv_packed(vlane, pf, o0, o1);
}

struct AttnLane { int lane, w, r, h, nq, sdst, klane_off, vlane_off; };
DI AttnLane attn_lane() {
    AttnLane L; const int tid = otid();
    L.lane = tid & 63; L.w = __builtin_amdgcn_readfirstlane(tid >> 6); L.r = L.lane & 31; L.h = L.lane >> 5; L.nq = 32 * L.w + L.r;
    L.sdst = L.w * 1024 + L.lane * 16; L.klane_off = L.h * 1024 + L.r * 16;
    const int i16 = L.lane & 15; L.vlane_off = (4 * L.h + (i16 >> 2)) * 64 + (16 * ((L.lane >> 4) & 1) + 4 * (i16 & 3)) * 2;
    return L;
}

template <int NDC, int NCH  >
DI void attn_pass(LAS unsigned char* lds, const AttnP& a, const AttnLane& L, const bf16x8* qf, int kc0, f32x16& o0, f32x16& o1, SmState& st) {
    constexpr int NLD = (NCH == 12) ? 3 : 2;
    const int w = L.w, lane = L.lane;
    const bf16_t* ksrc = a.K + (size_t)(a.krow0 + lane) * a.ldk + w * 8;
    const bf16_t* ksrc2 = a.K + (size_t)(a.krow0 + lane) * a.ldk + (w < 4 ? 8 + w : w) * 8;
    const bf16_t* vsrc = a.V + (size_t)(a.krow0 + 16 * (w & 3) + (lane >> 2)) * a.ldv + (w >> 2) * 32 + (lane & 3) * 8;
    const size_t kstep = (size_t)64 * a.ldk, vstep = (size_t)64 * a.ldv;
    const unsigned lds0 = (unsigned)(uintptr_t)lds + (unsigned)(w * 1024);
#define AP_GLDS(g, ldsb) do { unsigned sv_; asm volatile("s_mov_b32 %0, m0\n\ts_mov_b32 m0, %2\n\ts_nop 0\n\tglobal_load_lds_dwordx4 %1, off\n\ts_mov_b32 m0, %0" \
        : "=&s"(sv_) : "v"(g), "s"((unsigned)__builtin_amdgcn_readfirstlane(ldsb)) : "memory"); } while (0)
#define AP_DK(j) do { const unsigned sl_ = lds0 + AT_K0 + (unsigned)(((j) % AT_RING) * AT_KSLOT); \
        AP_GLDS(ksrc + (size_t)(j) * kstep, sl_); \
        if (NCH == 12) AP_GLDS(ksrc2 + (size_t)(j) * kstep, sl_ + (w < 4 ? 8192u : 0u)); } while (0)
#define AP_DV(j) do { AP_GLDS(vsrc + (size_t)(j) * vstep, lds0 + AT_V0 + (unsigned)(((j) % AT_RING) * AT_VSLOT)); } while (0)
#define AP_WAITBAR(N) do { asm volatile("s_waitcnt vmcnt(%0) lgkmcnt(0)" :: "n"(N) : "memory"); __builtin_amdgcn_s_barrier(); asm volatile("" ::: "memory"); } while (0)
#define AP_KF(j) do { LAS unsigned char* kb_ = lds + AT_K0 + ((j) % AT_RING) * AT_KSLOT + L.klane_off + kc0 * 1024; \
        _Pragma("unroll") for (int dc = 0; dc < NDC; ++dc) { kf[2 * dc] = *(LAS bf16x8*)(kb_ + dc * 2048); kf[2 * dc + 1] = *(LAS bf16x8*)(kb_ + dc * 2048 + 512); } } while (0)
#define AP_VF(j) do { LAS unsigned char* vb_ = lds + AT_V0 + ((j) % AT_RING) * AT_VSLOT + L.vlane_off; \
        _Pragma("unroll") for (int ks = 0; ks < 4; ++ks) { \
            { const s16x4 lo = trread(vb_ + ks * 1024), hi = trread(vb_ + ks * 1024 + 512); vf[2 * ks] = __builtin_shufflevector(lo, hi, 0, 1, 2, 3, 4, 5, 6, 7); } \
            { const s16x4 lo = trread(vb_ + 4096 + ks * 1024), hi = trread(vb_ + 4096 + ks * 1024 + 512); vf[2 * ks + 1] = __builtin_shufflevector(lo, hi, 0, 1, 2, 3, 4, 5, 6, 7); } } } while (0)
#define AP_QK(S0, S1) do { S0 = mfma32_c(kf[0], qf[0], st.negm); S1 = mfma32_c(kf[1], qf[0], st.negm); \
        _Pragma("unroll") for (int dc = 1; dc < NDC; ++dc) { S0 = MFMA32(kf[2 * dc], qf[dc], S0); S1 = MFMA32(kf[2 * dc + 1], qf[dc], S1); } } while (0)
    sm_init(st);
#pragma unroll
    for (int i = 0; i < 16; ++i) { o0[i] = 0.f; o1[i] = 0.f; }
    AP_DK(0);
#pragma unroll
    for (int j = 0; j < AT_RING - 1; ++j) { AP_DK(j + 1); AP_DV(j); }
    AP_WAITBAR((AT_RING - 2) * NLD);
    f32x16 sc0, sc1;
    { bf16x8 kf[2 * NDC]; AP_KF(0); AP_QK(sc0, sc1); }
    sm_move(sm_rowmax(sc0, sc1), true, st, o0, o1, sc0, sc1);
    AP_WAITBAR((AT_RING - 2) * NLD);
#define AP_STEP(t, SC0, SC1, SN0, SN1) do { \
        AP_DK((t) + AT_RING); AP_DV((t) + AT_RING - 1); \
        bf16x8 kf[2 * NDC], vf[8]; \
        AP_KF((t) + 1); AP_VF(t); \
        __builtin_amdgcn_sched_barrier(0); \
        bf16x8 pf[4]; \
        AP_QK(SN0, SN1);                                  \
        sm_exp_pack(SC0, SC1, st, pf);                    \
        __builtin_amdgcn_sched_barrier(0); \
        _Pragma("unroll") for (int ks = 0; ks < 4; ++ks) { o0 = MFMA32(vf[2 * ks], pf[ks], o0); o1 = MFMA32(vf[2 * ks + 1], pf[ks], o1); } \
        const float mx_ = sm_rowmax(SN0, SN1); \
        if ((t) + 1 < a.ntiles && __any(mx_ > SM_THR)) sm_move(mx_, false, st, o0, o1, SN0, SN1); \
        AP_WAITBAR((AT_RING - 2) * NLD); } while (0)
    f32x16 sd0, sd1;
#pragma unroll 1
    for (int t = 0; t < a.ntiles; t += 2) {
        AP_STEP(t, sc0, sc1, sd0, sd1);
        AP_STEP(t + 1, sd0, sd1, sc0, sc1);
    }
#undef AP_STEP
    AP_WAITBAR(0);
#undef AP_GLDS
#undef AP_DK
#undef AP_DV
#undef AP_WAITBAR
#undef AP_KF
#undef AP_VF
#undef AP_QK
}

template <int MODE>
DI void attn_q_fix(bf16x8 (&qf)[4], int row, int h, const float* qnw) {
    float x[4][8];
#pragma unroll
    for (int dc = 0; dc < 4; ++dc) { const u32x4 u = __builtin_bit_cast(u32x4, qf[dc]); un8(u, x[dc]); }
    const int b = row / SP, pos = row - b * SP; const bool lat = pos >= NCTX; const int s_ = lat ? pos - NCTX : 0, gr = s_ >> 6, gc = s_ & 63;
    unsigned char* ws = kws();
    if (MODE == M_GQA) {
        float ss = 0.f;
#pragma unroll
        for (int dc = 0; dc < 4; ++dc)
#pragma unroll
            for (int j = 0; j < 8; ++j) ss += x[dc][j] * x[dc][j];
        ss += xor32_f(ss);
        const float rs = rsqrtf(ss * (1.0f / 64.0f) + opq(EPS));
#pragma unroll
        for (int dc = 0; dc < 4; ++dc) { const f32x4 w0 = *(gv4p)(qnw + 16 * dc + 8 * h), w1 = *(gv4p)(qnw + 16 * dc + 8 * h + 4);
#pragma unroll
            for (int j = 0; j < 4; ++j) { x[dc][j] *= rs * w0[j]; x[dc][4 + j] *= rs * w1[j]; } }
    }
    if (MODE == M_DIFF) {
        if (lat) { const float* tb = (const float*)(wso(ws, WS_TAB) + TAB_R32) + ((h == 0 ? gr : gc) * 8) * 2;
            f32x4 t[4];
#pragma unroll
            for (int q = 0; q < 4; ++q) t[q] = *(gv4p)(tb + 4 * q);
#pragma unroll
            for (int j = 0; j < 8; ++j) { const float c_ = t[j >> 1][2 * (j & 1)], s2 = t[j >> 1][2 * (j & 1) + 1];
#pragma unroll
                for (int m = 0; m < 4; m += 2) { const float y1 = x[m][j] * c_ - x[m + 1][j] * s2, y2 = x[m][j] * s2 + x[m + 1][j] * c_; x[m][j] = y1; x[m + 1][j] = y2; } } }
    } else {
        if (lat) {
            f32x4 t[2][4];
#pragma unroll
            for (int dc = 0; dc < 2; ++dc) { const float* tb = (const float*)(wso(ws, WS_TAB) + TAB_R64) + ((dc == 0 ? gr : gc) * 16 + 8 * h) * 2;
#pragma unroll
                for (int q = 0; q < 4; ++q) t[dc][q] = *(gv4p)(tb + 4 * q); }
#pragma unroll
            for (int dc = 0; dc < 2; ++dc)
#pragma unroll
                for (int j = 0; j < 8; ++j) { const float c_ = t[dc][j >> 1][2 * (j & 1)], s2 = t[dc][j >> 1][2 * (j & 1) + 1];
                    const float y1 = x[dc][j] * c_ - x[dc + 2][j] * s2, y2 = x[dc][j] * s2 + x[dc + 2][j] * c_; x[dc][j] = y1; x[dc + 2][j] = y2; } }
    }
    const float scale = MODE == M_DIFF ? 0.17677669529663687f * LOG2E : MODE == M_GQA ? 0.125f * LOG2E : 1.0f;
#pragma unroll
    for (int dc = 0; dc < 4; ++dc) { u32x4 u; u.x = pk2(x[dc][0] * scale, x[dc][1] * scale); u.y = pk2(x[dc][2] * scale, x[dc][3] * scale); u.z = pk2(x[dc][4] * scale, x[dc][5] * scale); u.w = pk2(x[dc][6] * scale, x[dc][7] * scale);
        qf[dc] = __builtin_bit_cast(bf16x8, u); }
}

template <int MODE>
DI void attn_unit(LAS unsigned char* lds, const AttnP& a) {
    const AttnLane L = attn_lane();
    const int lane = L.lane, w = L.w, r = L.r, h = L.h, nq = L.nq;
    uint8_t* orow = a.O + (size_t)(a.qrow0 + nq) * DM;
    const bf16_t* qrow = a.Q + (size_t)(a.qrow0 + nq) * a.ldq + 8 * h;
    if (MODE == M_GQA || MODE == M_MLA) {
        constexpr int NDC = (MODE == M_MLA) ? 6 : 4;
        bf16x8 qf[NDC];
#pragma unroll
        for (int dc = 0; dc < NDC; ++dc) qf[dc] = *(const bf16x8*)(qrow + 16 * dc);
        if constexpr (MODE == M_GQA) attn_q_fix<M_GQA>(qf, a.qrow0 + nq, h, a.qnw);
        f32x16 o0, o1; SmState st;
        attn_pass<NDC, (MODE == M_MLA ? 12 : 8)>(lds, a, L, qf, 0, o0, o1, st);
        const float lt = st.l + __shfl_xor(st.l, 32), inv = 1.0f / lt;
#pragma unroll
        for (int g4 = 0; g4 < 4; ++g4) {
            const float v0[4] = {o0[4 * g4] * inv, o0[4 * g4 + 1] * inv, o0[4 * g4 + 2] * inv, o0[4 * g4 + 3] * inv};
            const float v1[4] = {o1[4 * g4] * inv, o1[4 * g4 + 1] * inv, o1[4 * g4 + 2] * inv, o1[4 * g4 + 3] * inv};
            st4c8(orow + 8 * g4 + 4 * h, v0); st4c8(orow + 32 + 8 * g4 + 4 * h, v1);
        }
    } else if (MODE == M_DIFF) {
        bf16x8 qf[4];
#pragma unroll
        for (int dc = 0; dc < 4; ++dc) qf[dc] = *(const bf16x8*)(qrow + 16 * dc);
        attn_q_fix<M_DIFF>(qf, a.qrow0 + nq, h, nullptr);
        f32x16 p0, p1, o0, o1; SmState st;
        attn_pass<2, 8>(lds, a, L, qf, 0, p0, p1, st);
        { const float i1 = 1.0f / (st.l + __shfl_xor(st.l, 32));
#pragma unroll
          for (int i = 0; i < 16; ++i) { p0[i] *= i1; p1[i] *= i1; } }
        attn_pass<2, 8>(lds, a, L, qf + 2, 4, o0, o1, st);
        const float i2 = a.lam / (st.l + __shfl_xor(st.l, 32));
        float ss = 0.f;
#pragma unroll
        for (int i = 0; i < 16; ++i) { o0[i] = p0[i] - o0[i] * i2; o1[i] = p1[i] - o1[i] * i2; ss += o0[i] * o0[i] + o1[i] * o1[i]; }
        ss += __shfl_xor(ss, 32);
        const float rs = rsqrtf(ss * (1.0f / 64.0f) + opq(EPS)) * a.oml;
#pragma unroll
        for (int g4 = 0; g4 < 4; ++g4) {
            const int e0 = 8 * g4 + 4 * h; const f32x4 w0 = *(const f32x4*)(a.subln + e0), w1 = *(const f32x4*)(a.subln + 32 + e0);
            const float v0[4] = {o0[4 * g4] * rs * w0[0], o0[4 * g4 + 1] * rs * w0[1], o0[4 * g4 + 2] * rs * w0[2], o0[4 * g4 + 3] * rs * w0[3]};
            const float v1[4] = {o1[4 * g4] * rs * w1[0], o1[4 * g4 + 1] * rs * w1[1], o1[4 * g4 + 2] * rs * w1[2], o1[4 * g4 + 3] * rs * w1[3]};
            st4c8(orow + e0, v0); st4c8(orow + 32 + e0, v1);
        }
    } else {
        bf16x8 qf[4];
#pragma unroll
        for (int dc = 0; dc < 4; ++dc) qf[dc] = *(const bf16x8*)(qrow + 16 * dc);
        attn_q_fix<M_RET>(qf, a.qrow0 + nq, h, nullptr);
        const bf16_t* ksrc = a.K + (size_t)(a.krow0 + lane) * a.ldk + w * 8;
        const bf16_t* vsrc = a.V + (size_t)(a.krow0 + 16 * (w & 3) + (lane >> 2)) * a.ldv + (w >> 2) * 32 + (lane & 3) * 8;
        const size_t kstep = (size_t)64 * a.ldk, vstep = (size_t)64 * a.ldv;
        u32x4 kr0, vr;
#define AT_GLOAD(t) do { kr0 = *(const u32x4*)(ksrc + (size_t)(t) * kstep); vr = *(const u32x4*)(vsrc + (size_t)(t) * vstep); } while (0)
#define AT_LSTORE(buf) do { *(LAS u32x4*)(lds + ((buf) ? AT_K1 : AT_K0) + L.sdst) = kr0; *(LAS u32x4*)(lds + ((buf) ? AT_V1 : AT_V0) + L.sdst) = vr; } while (0)
        AT_GLOAD(0);
        f32x16 o0, o1;
#pragma unroll
        for (int i = 0; i < 16; ++i) { o0[i] = 0.f; o1[i] = 0.f; }
        if (a.cj > 0) {
            const float gf256 = __builtin_amdgcn_exp2f(256.0f * a.l2gf), gb256 = __builtin_amdgcn_exp2f(256.0f * a.l2gb);
            const int tid = w * 64 + lane, e = tid >> 3, d0 = (tid & 7) * 8;
            float sf[8], sb[8];
#pragma unroll
            for (int j = 0; j < 8; ++j) { sf[j] = 0.f; sb[j] = 0.f; }
            for (int i = 0; i < a.cj; ++i) { const float* u = a.ust + ((size_t)i * 2 + 0) * 4096 + e * 64 + d0; const f32x4 u0 = *(const f32x4*)u, u1 = *(const f32x4*)(u + 4);
#pragma unroll
                for (int j = 0; j < 4; ++j) { sf[j] = sf[j] * gf256 + u0[j]; sf[4 + j] = sf[4 + j] * gf256 + u1[j]; } }
            { const float* u = a.ust + ((size_t)0 * 2 + 1) * 4096 + e * 64 + d0; const f32x4 u0 = *(const f32x4*)u, u1 = *(const f32x4*)(u + 4);
#pragma unroll
                for (int j = 0; j < 4; ++j) { sb[j] = u0[j]; sb[4 + j] = u1[j]; } }
            for (int i = NCHUNK - 1; i > a.cj; --i) { const float* u = a.ust + ((size_t)i * 2 + 1) * 4096 + e * 64 + d0; const f32x4 u0 = *(const f32x4*)u, u1 = *(const f32x4*)(u + 4);
#pragma unroll
                for (int j = 0; j < 4; ++j) { sb[j] = sb[j] * gb256 + u0[j]; sb[4 + j] = sb[4 + j] * gb256 + u1[j]; } }
            st8l(lds + AT_SF + e * 144 + d0 * 2, sf); st8l(lds + AT_SB + e * 144 + d0 * 2, sb);
        }
        AT_LSTORE(0);
        __syncthreads();
        if (a.cj > 0) {
            f32x16 af0, af1, ab0, ab1;
#pragma unroll
            for (int i = 0; i < 16; ++i) { af0[i] = 0.f; af1[i] = 0.f; ab0[i] = 0.f; ab1[i] = 0.f; }
#pragma unroll
            for (int dc = 0; dc < 4; ++dc) {
                const bf16x8 f0 = *(LAS bf16x8*)(lds + AT_SF + r * 144 + (16 * dc + 8 * h) * 2), f1 = *(LAS bf16x8*)(lds + AT_SF + (32 + r) * 144 + (16 * dc + 8 * h) * 2);
                const bf16x8 b0 = *(LAS bf16x8*)(lds + AT_SB + r * 144 + (16 * dc + 8 * h) * 2), b1 = *(LAS bf16x8*)(lds + AT_SB + (32 + r) * 144 + (16 * dc + 8 * h) * 2);
                af0 = MFMA32(f0, qf[dc], af0); af1 = MFMA32(f1, qf[dc], af1); ab0 = MFMA32(b0, qf[dc], ab0); ab1 = MFMA32(b1, qf[dc], ab1);
            }
            const float xf = __builtin_amdgcn_exp2f(a.l2gf * (float)(nq + 1)), xb = __builtin_amdgcn_exp2f(a.l2gb * (float)(256 - nq));
#pragma unroll
            for (int i = 0; i < 16; ++i) { o0[i] = xf * af0[i] + xb * ab0[i]; o1[i] = xf * af1[i] + xb * ab1[i]; }
        }
#pragma unroll 1
        for (int t = 0; t < a.ntiles; ++t) {
            const int buf = t & 1;
            if (t + 1 < a.ntiles) AT_GLOAD(t + 1);
            LAS unsigned char* kb = lds + (buf ? AT_K1 : AT_K0) + L.klane_off;
            LAS unsigned char* vb = lds + (buf ? AT_V1 : AT_V0) + L.vlane_off;
            f32x16 s0, s1;
#pragma unroll
            for (int i = 0; i < 16; ++i) { s0[i] = 0.f; s1[i] = 0.f; }
#pragma unroll
            for (int dc = 0; dc < 4; ++dc) { s0 = MFMA32(*(LAS bf16x8*)(kb + dc * 2048), qf[dc], s0); s1 = MFMA32(*(LAS bf16x8*)(kb + dc * 2048 + 512), qf[dc], s1); }
#pragma unroll
            for (int i = 0; i < 16; ++i) {
                const int mk = 64 * t + crow(i, h);
                { const int dlt = nq - mk; const float d = dlt > 0 ? __builtin_amdgcn_exp2f(a.l2gf * (float)dlt) : (dlt < 0 ? __builtin_amdgcn_exp2f(a.l2gb * (float)(-dlt)) : 2.0f); s0[i] *= d; }
                { const int dlt = nq - mk - 32; const float d = dlt > 0 ? __builtin_amdgcn_exp2f(a.l2gf * (float)dlt) : (dlt < 0 ? __builtin_amdgcn_exp2f(a.l2gb * (float)(-dlt)) : 2.0f); s1[i] *= d; }
            }
            pv_tile(vb, s0, s1, o0, o1);
            if (t + 1 < a.ntiles) AT_LSTORE(buf ^ 1);
            __syncthreads();
        }
#undef AT_GLOAD
#undef AT_LSTORE
        float sm = 0.f;
#pragma unroll
        for (int i = 0; i < 16; ++i) sm += o0[i] + o1[i];
        sm += __shfl_xor(sm, 32);
        const float mu = sm * (1.0f / 64.0f);
        float vv = 0.f;
#pragma unroll
        for (int i = 0; i < 16; ++i) { o0[i] -= mu; o1[i] -= mu; vv += o0[i] * o0[i] + o1[i] * o1[i]; }
        vv += __shfl_xor(vv, 32);
        const float rs = rsqrtf(vv * (1.0f / 64.0f) + opq(EPS));
        const bf16_t* grow = a.gate + (size_t)(a.qrow0 + nq) * NP;
#pragma unroll
        for (int g4 = 0; g4 < 4; ++g4) {
            const int e0 = 8 * g4 + 4 * h;
            const f32x4 w0 = *(const f32x4*)(a.gnw + e0), w1 = *(const f32x4*)(a.gnw + 32 + e0), b0 = *(const f32x4*)(a.gnb + e0), b1 = *(const f32x4*)(a.gnb + 32 + e0);
            float ga[4], gb[4]; ld4(grow + e0, ga); ld4(grow + 32 + e0, gb);
            float v0[4], v1[4];
#pragma unroll
            for (int j = 0; j < 4; ++j) { v0[j] = (o0[4 * g4 + j] * rs * w0[j] + b0[j]) * silu(ga[j]); v1[j] = (o1[4 * g4 + j] * rs * w1[j] + b1[j]) * silu(gb[j]); }
            st4c8(orow + e0, v0); st4c8(orow + 32 + e0, v1);
        }
    }
    __syncthreads();
}

DI void p_attn(const Args& a, int l, LAS unsigned char* lds) {
    unsigned char* ws = kws();
    const bool last = (l == NL - 1);
    const bf16_t* P = (const bf16_t*)(wso(ws, WS_P));
    uint8_t* YC = (uint8_t*)(wso(ws, WS_YC));
    int it = 0; const int cslot = (obx() >> 3) & 7; bool cdone = false;
    for (int U = obx(); U < 9 * 256; U += gridDim.x, ++it) {
        if (it == cslot) { conv_experts(l, lds); cdone = true; }
        const int rnd = U >> 8, vb = U & 255, b = vb & 7, i = vb >> 3;
        int mode, hd, qt;
        if (rnd < 8) { mode = rnd >> 1; const int u = i + 32 * (rnd & 1); hd = u >> 4; qt = 1 + (u & 15); }
        else { if (last || i >= 16) continue; mode = i >> 2; hd = i & 3; qt = 0; }
        AttnP p{};
        p.qrow0 = b * SP + qt * 256; p.krow0 = b * SP; p.ntiles = qt == 0 ? 4 : SP / 64;
        if (mode == M_DIFF) {
            p.Q = (const bf16_t*)(wso(ws, WS_QD)) + hd * 64; p.ldq = 256; p.K = (const bf16_t*)(wso(ws, WS_KD)) + hd * 64; p.ldk = 256; p.V = P + C_DV + hd * 64; p.ldv = NP; p.O = YC + 256 + hd * 64;
            p.lam = ((const float*)(wso(ws, WS_TAB) + TAB_LAM))[l]; p.oml = 1.0f - (0.8f - 0.6f * __expf(-0.3f * (float)l)); p.subln = kin(I_DSUB) + l * 64;
            attn_unit<M_DIFF>(lds, p);
        } else if (mode == M_MLA) {
            p.Q = (const bf16_t*)(wso(ws, WS_QM)) + hd * 96; p.ldq = 384; p.K = (const bf16_t*)(wso(ws, WS_KM)) + hd * 96; p.ldk = 384; p.V = (const bf16_t*)(wso(ws, WS_VM)) + hd * 64; p.ldv = 256; p.O = YC + 768 + hd * 64;
            attn_unit<M_MLA>(lds, p);
        } else if (mode == M_GQA) {
            p.Q = (const bf16_t*)(wso(ws, WS_QG)) + hd * 64; p.ldq = 256; p.qnw = kin(I_GQKN) + l * 128; p.K = (const bf16_t*)(wso(ws, WS_KG)) + (hd >> 1) * 64; p.ldk = 128; p.V = P + C_GV + (hd >> 1) * 64; p.ldv = NP; p.O = YC + 512 + hd * 64;
            attn_unit<M_GQA>(lds, p);
        } else {
            p.Q = (const bf16_t*)(wso(ws, WS_QRET)) + hd * 64; p.ldq = 256; p.K = (const bf16_t*)(wso(ws, WS_KRET)) + hd * 64; p.ldk = 256; p.V = P + C_RV + hd * 64; p.ldv = NP; p.O = YC + hd * 64;
            p.krow0 = p.qrow0; p.ntiles = 4; p.cj = qt;
            p.gate = P + C_RG + hd * 64; p.gnw = kin(I_RGNW) + l * 256 + hd * 64; p.gnb = kin(I_RGNB) + l * 256 + hd * 64;
            p.l2gf = -__expf(kin(I_RLD)[l * 8 + hd]) * LOG2E; p.l2gb = -__expf(kin(I_RLD)[l * 8 + 4 + hd]) * LOG2E;
            p.ust = (const float*)(wso(ws, WS_UST)) + ((size_t)b * 4 + hd) * NCHUNK * 2 * 4096;
            attn_unit<M_RET>(lds, p);
        }
    }
    if (!cdone) conv_experts(l, lds);
}

constexpr int N_PHASES = 2 + 8 * NL;
__global__ void __launch_bounds__(NTHR, 2) fwd(Args args) {
    extern __shared__ __attribute__((aligned(16))) unsigned char lds_raw[];
    LAS unsigned char* lds = (LAS unsigned char*)lds_raw;
    if (threadIdx.x < 4) ((LAS unsigned*)(lds + LDS_XB))[threadIdx.x] = 0u;
    __syncthreads();
    if (args.ph_hi - args.ph_lo > 1) (void)xcd_barrier_post((unsigned*)(wso(kws(), WS_CTL)), (volatile LAS unsigned*)(lds + LDS_XB));
#define KLO (*(const int CAS*)(karg_base() + 216))
#define KHI (*(const int CAS*)(karg_base() + 220))
#ifdef PH_MASK
#define IN(k) ((((PH_MASK) >> ((k) < 2 ? (k) : 2 + ((k) - 2) % 8)) & 1) && KLO <= (k) && (k) < KHI)
#else
#define IN(k) (KLO <= (k) && (k) < KHI)
#endif
#define SEAM(k) do { if (IN(k) && IN((k) + 1)) { XcdBarrier bar_; bar_.bar = (unsigned*)(wso(kws(), WS_CTL)); bar_.x = xb_xcc_id(); bar_.st = (volatile LAS unsigned*)(lds + LDS_XB); xcd_barrier(bar_); } } while (0)
    if (IN(0)) { p0_prologue(args, lds); if (DUP(0)) { __syncthreads(); p0_prologue(args, lds); } SEAM(0); }
    if (IN(1)) { p_norm0(args); SEAM(1); }
#pragma unroll 1
    for (int l = 0; l < NL; ++l) {
        const int pb = 2 + 8 * l;
        if (IN(pb + 0)) { p_gemm_in8(l, lds); if (DUP(2)) p_gemm_in8(l, lds); SEAM(pb + 0); }
        if (IN(pb + 1)) { p_prep(args, l, lds); if (DUP(3)) p_prep(args, l, lds); SEAM(pb + 1); }
        if (IN(pb + 2)) { p_attn(args, l, lds); if (DUP(4)) p_attn(args, l, lds); SEAM(pb + 2); }
        if (IN(pb + 3)) { p_gemm_out8(l, lds); if (DUP(5)) p_gemm_out8(l, lds); SEAM(pb + 3); }
        if (IN(pb + 4)) { p_rowA(args, l, lds); if (DUP(6)) { __syncthreads(); p_rowA(args, l, lds, true); } SEAM(pb + 4); }
        if (IN(pb + 5)) { p_gemm_moe<1>(args, l, lds); if (DUP(7)) p_gemm_moe<1>(args, l, lds); SEAM(pb + 5); }
        if (IN(pb + 6)) { p_gemm_moe<2>(args, l, lds); if (DUP(8)) p_gemm_moe<2>(args, l, lds); SEAM(pb + 6); }
        if (IN(pb + 7)) { p_rowB(args, l, lds); if (DUP(9)) { __syncthreads(); p_rowB(args, l, lds, true); } SEAM(pb + 7); }
    }
#undef IN
#undef SEAM
}

extern "C" void kernel_launch(void* const* d_in, const int* in_sizes, int n_in, void* d_out, int out_size, void* d_ws, size_t ws_size, hipStream_t stream) {
    static int grid = 0;
    if (grid == 0) {
        if (n_in != 25 || in_sizes[0] != NB * SEQ * DM || out_size != NB * SEQ * DM || ws_size < WS_END) {
            fprintf(stderr, "kernel_launch: unexpected problem (n_in %d, in0 %d, out %d, ws %zu, need %zu); nothing launched\n", n_in, n_in > 0 ? in_sizes[0] : -1, out_size, ws_size, (size_t)WS_END);
            grid = -1; return; }
        int dev = 0, cus = 0, per_cu = 0;
        if (hipGetDevice(&dev) != hipSuccess || hipDeviceGetAttribute(&cus, hipDeviceAttributeMultiprocessorCount, dev) != hipSuccess) { grid = -1; return; }
        if (hipFuncSetAttribute((const void*)fwd, hipFuncAttributeMaxDynamicSharedMemorySize, LDS_BYTES) != hipSuccess) { fprintf(stderr, "kernel_launch: hipFuncSetAttribute failed\n"); grid = -1; return; }
        if (hipOccupancyMaxActiveBlocksPerMultiprocessor(&per_cu, (const void*)fwd, NTHR, LDS_BYTES) != hipSuccess || per_cu < 1) {
            fprintf(stderr, "kernel_launch: occupancy query says %d blocks per CU\n", per_cu); }
        (void)hipGetLastError();
        grid = cus;
    }
    if (grid < 0) return;
    (void)hipMemsetAsync((char*)d_ws + WS_CTL, 0, CTL_BYTES, stream);
    Args a{};
    for (int i = 0; i < 25; ++i) a.in[i] = (const float*)d_in[i];
    a.out = (float*)d_out; a.ws = (unsigned char*)d_ws;
#if MK_LAUNCHES == 1
    a.ph_lo = 0; a.ph_hi = N_PHASES;
    hipLaunchKernelGGL(fwd, dim3(grid), dim3(NTHR), LDS_BYTES, stream, a);
#else
    for (int k = 0; k < N_PHASES; ++k) { a.ph_lo = k; a.ph_hi = k + 1; hipLaunchKernelGGL(fwd, dim3(grid), dim3(NTHR), LDS_BYTES, stream, a); }
#endif
    const hipError_t le = hipPeekAtLastError();
    if (le != hipSuccess) fprintf(stderr, "kernel_launch: launch failed: %s\n", hipGetErrorName(le));
}
```
